# Optimizing an MI355X kernel written in HIP

```python
import math
import jax
import jax.numpy as jnp
from jax import lax
import numpy as np

D_MODEL = 1024
BATCH = 2
SEQ = 16384
DEPTH = 2

CTX_LEN = 256
GRID_W = 64
N_EVEN = (DEPTH + 1) // 2
N_ODD = DEPTH // 2
EPS = 1e-6

HY_WIDTH = D_MODEL // 2
HY_ORDER = 2
HY_SHORT_K = 3
HY_EMB_BANDS = 16
HY_EMB_DIM = 1 + 2 * HY_EMB_BANDS
HY_FILTER_HIDDEN = 64
HY_DECAY_TARGET = 1e-2
HY_FAST_DECAY_PCT = 0.3
HY_SLOW_DECAY_PCT = 1.5

DA_HEAD_DIM = 64
DA_HEADS = (D_MODEL // 2) // (2 * DA_HEAD_DIM)
DA_WIDTH = DA_HEADS * 2 * DA_HEAD_DIM
ROPE_THETA = 10000.0
ATTN_BLOCK = 128

EVEN_IN = 4 * HY_WIDTH + 4 * DA_WIDTH
EVEN_MIX = HY_WIDTH + DA_WIDTH
EVEN_SPLITS = (3 * HY_WIDTH, 4 * HY_WIDTH, 4 * HY_WIDTH + DA_WIDTH,
               4 * HY_WIDTH + 2 * DA_WIDTH, 4 * HY_WIDTH + 3 * DA_WIDTH)

SSD_INNER = 2 * D_MODEL
SSD_HEAD_DIM = 64
SSD_HEADS = SSD_INNER // SSD_HEAD_DIM
SSD_GROUPS = 8
SSD_STATE = 128
SSD_CONV_K = 3
SSD_CHUNK = 128
SSD_CONV_CH = SSD_INNER + 2 * SSD_GROUPS * SSD_STATE
ODD_IN = SSD_INNER + SSD_CONV_CH + 2 * SSD_HEADS

kernel_name = "hybrid_hyena_diffattn_ssd_prefix_dit"


def rmsnorm(x, w):
    xf = x.astype(jnp.float32)
    y = xf * lax.rsqrt(jnp.mean(xf * xf, axis=-1, keepdims=True) + EPS)
    return (y * w.astype(jnp.float32)).astype(x.dtype)


def dwconv_centred(x, w, b):
    K = w.shape[0]
    r = K // 2
    L = x.shape[1]
    xp = jnp.pad(x, ((0, 0), (r, r), (0, 0)))
    return sum(xp[:, j:j + L] * w[j] for j in range(K)) + b


def axial_rope_tables(rows, head_dim):
    r, col = jnp.meshgrid(jnp.arange(rows), jnp.arange(GRID_W), indexing="ij")
    r = r.reshape(-1).astype(jnp.float32)
    col = col.reshape(-1).astype(jnp.float32)
    axis_dim = head_dim // 2
    inv = ROPE_THETA ** (-jnp.arange(0, axis_dim, 2, dtype=jnp.float32) / axis_dim)
    ar = r[:, None] * inv
    ac = col[:, None] * inv
    return (jnp.cos(ar), jnp.sin(ar), jnp.cos(ac), jnp.sin(ac))


def _rotate(x, cos, sin):
    x1, x2 = jnp.split(x, 2, axis=-1)
    return jnp.concatenate([x1 * cos - x2 * sin, x1 * sin + x2 * cos], axis=-1)


def apply_axial_rope(x, tables):
    cr, sr, cc, sc = [t[:, None, None, :].astype(x.dtype) for t in tables]
    half = x.shape[-1] // 2
    return jnp.concatenate([_rotate(x[..., :half], cr, sr), _rotate(x[..., half:], cc, sc)], axis=-1)


def hyena_freq_response(L, f_w1, f_b1, f_w2, f_b2, f_w3, f_b3, f_freq):
    f32 = jnp.float32
    t = jnp.linspace(0.0, 1.0, L, dtype=f32)[:, None]
    w = 2.0 * math.pi * jnp.arange(L, dtype=f32)[:, None] / L
    bands = jnp.linspace(1e-4, HY_EMB_BANDS - 1, HY_EMB_BANDS, dtype=f32)
    z = jnp.concatenate([t, jnp.cos(bands * w), -jnp.sin(bands * w)], axis=-1)
    freq = f_freq.astype(f32)
    h = jnp.sin(freq[0] * (z @ f_w1.astype(f32) + f_b1.astype(f32)))
    h = jnp.sin(freq[1] * (h @ f_w2.astype(f32) + f_b2.astype(f32)))
    h = h @ f_w3.astype(f32) + f_b3.astype(f32)
    min_decay = math.log(HY_DECAY_TARGET) / HY_SLOW_DECAY_PCT
    max_decay = math.log(HY_DECAY_TARGET) / HY_FAST_DECAY_PCT
    deltas = jnp.abs(jnp.linspace(min_decay, max_decay, HY_WIDTH, dtype=f32))
    window = jnp.exp(-t * deltas)
    h = h.reshape(L, 2, HY_ORDER, HY_WIDTH) * window[:, None, None, :]
    k = jnp.concatenate([h[:, 0], jnp.zeros_like(h[:1, 0]), h[:0:-1, 1]], axis=0)
    k = k / jnp.sum(jnp.abs(k), axis=0, keepdims=True)
    return jnp.fft.rfft(k, axis=0)


def fft_long_conv(v, k_f, bias):
    L = v.shape[1]
    vf = v.astype(jnp.float32)
    y = jnp.fft.irfft(jnp.fft.rfft(vf, n=2 * L, axis=1) * k_f, n=2 * L, axis=1)[:, :L]
    return (y + vf * bias.astype(jnp.float32)).astype(v.dtype)


def hyena_mix(u, short_w, short_b, filt, hy_bias):
    L = u.shape[1]
    u = dwconv_centred(u, short_w, short_b)
    v, x1, x2 = jnp.split(u, 3, axis=-1)
    k_f = hyena_freq_response(L, *filt)
    z = fft_long_conv(v, k_f[:, 0], hy_bias[0]) * x1
    return fft_long_conv(z, k_f[:, 1], hy_bias[1]) * x2


def diff_attend(q, k, v, lam):
    s = jnp.einsum("bqhmd,bkhmd->bhmqk", q, k).astype(jnp.float32) * (DA_HEAD_DIM ** -0.5)
    p = jax.nn.softmax(s, axis=-1)
    a = p[:, :, 0] - lam * p[:, :, 1]
    return jnp.einsum("bhqk,bkhe->bqhe", a.astype(v.dtype), v)


def ssd_chunked(x, dt, A, Bm, Cm, D, init_state):
    f32 = jnp.float32
    b, L, h, p = x.shape
    nc = L // SSD_CHUNK
    hg = h // SSD_GROUPS
    xf = x.astype(f32)
    dtf = dt.astype(f32)
    a = dtf * A.astype(f32)
    xdt = xf * dtf[..., None]

    def chunks(t):
        return t.reshape((b, nc, SSD_CHUNK) + t.shape[2:]).swapaxes(0, 1)

    xs = chunks(xdt.reshape(b, L, SSD_GROUPS, hg, p))
    a_s = chunks(a.reshape(b, L, SSD_GROUPS, hg))
    Bs = chunks(Bm.astype(f32))
    Cs = chunks(Cm.astype(f32))
    mask = jnp.tril(jnp.ones((SSD_CHUNK, SSD_CHUNK), dtype=bool))[None, :, :, None, None]

    def step(state, inp):
        xc, ac, Bc, Cc = inp
        acum = jnp.cumsum(ac, axis=1)
        seg = acum[:, :, None] - acum[:, None, :]
        decay = jnp.exp(jnp.where(mask, seg, -jnp.inf))
        cb = jnp.einsum("blgn,bsgn->blsg", Cc, Bc)
        y = jnp.einsum("blsgk,bsgkp->blgkp", cb[..., None] * decay, xc)
        y = y + jnp.einsum("blgn,bgkpn->blgkp", Cc, state) * jnp.exp(acum)[..., None]
        last = acum[:, -1]
        to_end = jnp.exp(last[:, None] - acum)
        state = state * jnp.exp(last)[..., None, None] + jnp.einsum(
            "bsgn,bsgk,bsgkp->bgkpn", Bc, to_end, xc)
        return state, y

    state0 = init_state.astype(f32).reshape(b, SSD_GROUPS, hg, p, SSD_STATE)
    final, ys = lax.scan(step, state0, (xs, a_s, Bs, Cs))
    y = ys.swapaxes(0, 1).reshape(b, L, h, p) + xf * D.astype(f32)[:, None]
    return y, final.reshape(b, h, p, SSD_STATE)


def bidir_ssd(x, dt, A, Bm, Cm, D, s_fwd, s_bwd):
    y_f, s_f = ssd_chunked(x, dt[:, :, 0], A[0], Bm, Cm, D[0], s_fwd)
    rev = lambda t: jnp.flip(t, axis=1)
    y_b, s_b = ssd_chunked(rev(x), rev(dt[:, :, 1]), A[1], rev(Bm), rev(Cm), D[1], s_bwd)
    return y_f + rev(y_b), s_f, s_b


def even_mixer(xn_c, xn_l, rope, layer_idx, need_ctx, in_w, out_w, short_w, short_b,
               f_w1, f_b1, f_w2, f_b2, f_w3, f_b3, f_freq, hy_bias, lam_p, subln_w):
    filt = (f_w1, f_b1, f_w2, f_b2, f_w3, f_b3, f_freq)
    lam_init = 0.8 - 0.6 * math.exp(-0.3 * layer_idx)
    lp = lam_p.astype(jnp.float32)
    lam = jnp.exp(jnp.sum(lp[0] * lp[1])) - jnp.exp(jnp.sum(lp[2] * lp[3])) + lam_init

    def project(xn):
        b, L = xn.shape[:2]
        hy, hg, q, k, v, ag = jnp.split(xn @ in_w, list(EVEN_SPLITS), axis=-1)
        q = q.reshape(b, L, DA_HEADS, 2, DA_HEAD_DIM)
        k = k.reshape(b, L, DA_HEADS, 2, DA_HEAD_DIM)
        v = v.reshape(b, L, DA_HEADS, 2 * DA_HEAD_DIM)
        return hy, hg, q, k, v, ag

    def merge(hy_out, hg, att, ag):
        b, L = att.shape[:2]
        att = (rmsnorm(att, subln_w) * (1.0 - lam_init)).reshape(b, L, DA_WIDTH)
        mix = jnp.concatenate([hy_out * jax.nn.silu(hg), att * jax.nn.silu(ag)], axis=-1)
        return mix @ out_w

    hy_c, hg_c, q_c, k_c, v_c, ag_c = project(xn_c)
    hy_l, hg_l, q_l, k_l, v_l, ag_l = project(xn_l)

    b, L = xn_l.shape[:2]
    q_l = apply_axial_rope(q_l, rope)
    k_all = jnp.concatenate([k_c, apply_axial_rope(k_l, rope)], axis=1)
    v_all = jnp.concatenate([v_c, v_l], axis=1)
    nb = L // ATTN_BLOCK
    qb = q_l.reshape(b, nb, ATTN_BLOCK, DA_HEADS, 2, DA_HEAD_DIM).swapaxes(0, 1)
    att_l = lax.map(lambda qq: diff_attend(qq, k_all, v_all, lam), qb)
    att_l = att_l.swapaxes(0, 1).reshape(b, L, DA_HEADS, 2 * DA_HEAD_DIM)
    out_l = merge(hyena_mix(hy_l, short_w, short_b, filt, hy_bias), hg_l, att_l, ag_l)

    out_c = None
    if need_ctx:
        att_c = diff_attend(q_c, k_c, v_c, lam)
        out_c = merge(hyena_mix(hy_c, short_w, short_b, filt, hy_bias), hg_c, att_c, ag_c)
    return out_c, out_l


def odd_mixer(xn_c, xn_l, need_ctx, in_w, conv_w, conv_b, dt_bias, A_log, D, gnorm_w, out_w):
    f32 = jnp.float32
    A = -jnp.exp(A_log.astype(f32))

    def prep(xn):
        b, L = xn.shape[:2]
        z, xbc, dt = jnp.split(xn @ in_w, [SSD_INNER, SSD_INNER + SSD_CONV_CH], axis=-1)
        xbc = jax.nn.silu(dwconv_centred(xbc, conv_w, conv_b))
        xs, Bm, Cm = jnp.split(xbc, [SSD_INNER, SSD_INNER + SSD_GROUPS * SSD_STATE], axis=-1)
        xs = xs.reshape(b, L, SSD_HEADS, SSD_HEAD_DIM)
        Bm = Bm.reshape(b, L, SSD_GROUPS, SSD_STATE)
        Cm = Cm.reshape(b, L, SSD_GROUPS, SSD_STATE)
        dt = jax.nn.softplus(dt.astype(f32).reshape(b, L, 2, SSD_HEADS) + dt_bias.astype(f32))
        return z, xs, Bm, Cm, dt

    def finish(y, z):
        b, L = z.shape[:2]
        y = y.reshape(b, L, SSD_INNER).astype(z.dtype) * jax.nn.silu(z)
        y = rmsnorm(y.reshape(b, L, SSD_GROUPS, SSD_INNER // SSD_GROUPS),
                    gnorm_w.reshape(SSD_GROUPS, SSD_INNER // SSD_GROUPS)).reshape(b, L, SSD_INNER)
        return y @ out_w

    z_c, x_c, B_c, C_c, dt_c = prep(xn_c)
    s0 = jnp.zeros((xn_c.shape[0], SSD_HEADS, SSD_HEAD_DIM, SSD_STATE), f32)
    y_c, s_f, s_b = bidir_ssd(x_c, dt_c, A, B_c, C_c, D, s0, s0)
    z_l, x_l, B_l, C_l, dt_l = prep(xn_l)
    y_l, _, _ = bidir_ssd(x_l, dt_l, A, B_l, C_l, D, s_f, s_b)
    out_l = finish(y_l, z_l)
    out_c = finish(y_c, z_c) if need_ctx else None
    return out_c, out_l


def setup_inputs(seed: int = 0) -> dict:
    key = jax.random.key(seed)
    ks = jax.random.split(key, 32)
    f32 = jnp.float32
    D = D_MODEL

    def nrm(i, shape, scale):
        return jax.random.normal(ks[i], shape, f32) * scale

    x = nrm(0, (BATCH, SEQ, D), 1.0)
    c = nrm(1, (BATCH, D), 1.0)
    ctx = nrm(2, (BATCH, CTX_LEN, D), 1.0)
    c_ctx = nrm(3, (D,), 1.0)
    ada_w = nrm(4, (DEPTH, D, 3 * D), 0.5 * D ** -0.5)
    ada_b = nrm(5, (DEPTH, 3 * D), 0.02)
    norm_w = 1.0 + nrm(6, (DEPTH, D), 0.02)
    ev_in_w = nrm(7, (N_EVEN, D, EVEN_IN), D ** -0.5)
    ev_out_w = nrm(8, (N_EVEN, EVEN_MIX, D), EVEN_MIX ** -0.5)
    hy_short_w = nrm(9, (N_EVEN, HY_SHORT_K, 3 * HY_WIDTH), HY_SHORT_K ** -0.5)
    hy_short_b = nrm(10, (N_EVEN, 3 * HY_WIDTH), 0.02)
    hy_f_w1 = nrm(11, (N_EVEN, HY_EMB_DIM, HY_FILTER_HIDDEN), HY_EMB_DIM ** -0.5)
    hy_f_b1 = nrm(12, (N_EVEN, HY_FILTER_HIDDEN), 0.1)
    hy_f_w2 = nrm(13, (N_EVEN, HY_FILTER_HIDDEN, HY_FILTER_HIDDEN), HY_FILTER_HIDDEN ** -0.5)
    hy_f_b2 = nrm(14, (N_EVEN, HY_FILTER_HIDDEN), 0.1)
    hy_f_w3 = nrm(15, (N_EVEN, HY_FILTER_HIDDEN, 2 * HY_ORDER * HY_WIDTH), HY_FILTER_HIDDEN ** -0.5)
    hy_f_b3 = nrm(16, (N_EVEN, 2 * HY_ORDER * HY_WIDTH), 0.02)
    hy_freq = 1.0 + nrm(17, (N_EVEN, 2, HY_FILTER_HIDDEN), 0.1)
    hy_bias = nrm(18, (N_EVEN, HY_ORDER, HY_WIDTH), 0.5)
    da_lambda = nrm(19, (N_EVEN, 4, DA_HEAD_DIM), 0.1)
    da_subln_w = 1.0 + nrm(20, (N_EVEN, 2 * DA_HEAD_DIM), 0.02)
    od_in_w = nrm(21, (N_ODD, D, ODD_IN), D ** -0.5)
    od_conv_w = nrm(22, (N_ODD, SSD_CONV_K, SSD_CONV_CH), SSD_CONV_K ** -0.5)
    od_conv_b = nrm(23, (N_ODD, SSD_CONV_CH), 0.02)
    dt0 = jnp.exp(jax.random.uniform(ks[24], (N_ODD, 2, SSD_HEADS), f32,
                                     math.log(1e-3), math.log(1e-1)))
    od_dt_bias = dt0 + jnp.log(-jnp.expm1(-dt0))
    od_A_log = jnp.log(jax.random.uniform(ks[25], (N_ODD, 2, SSD_HEADS), f32, 1.0, 16.0))
    od_D = 1.0 + nrm(26, (N_ODD, 2, SSD_HEADS), 0.1)
    od_norm_w = 1.0 + nrm(27, (N_ODD, SSD_INNER), 0.02)
    od_out_w = nrm(28, (N_ODD, SSD_INNER, D), SSD_INNER ** -0.5)
    final_norm_w = 1.0 + nrm(29, (D,), 0.02)
    return {"x": x, "c": c, "ctx": ctx, "c_ctx": c_ctx, "ada_w": ada_w, "ada_b": ada_b,
            "norm_w": norm_w, "ev_in_w": ev_in_w, "ev_out_w": ev_out_w,
            "hy_short_w": hy_short_w, "hy_short_b": hy_short_b,
            "hy_f_w1": hy_f_w1, "hy_f_b1": hy_f_b1, "hy_f_w2": hy_f_w2, "hy_f_b2": hy_f_b2,
            "hy_f_w3": hy_f_w3, "hy_f_b3": hy_f_b3, "hy_freq": hy_freq, "hy_bias": hy_bias,
            "da_lambda": da_lambda, "da_subln_w": da_subln_w,
            "od_in_w": od_in_w, "od_conv_w": od_conv_w, "od_conv_b": od_conv_b,
            "od_dt_bias": od_dt_bias, "od_A_log": od_A_log, "od_D": od_D,
            "od_norm_w": od_norm_w, "od_out_w": od_out_w, "final_norm_w": final_norm_w}


def reference(x, c, ctx, c_ctx, ada_w, ada_b, norm_w, ev_in_w, ev_out_w, hy_short_w, hy_short_b,
              hy_f_w1, hy_f_b1, hy_f_w2, hy_f_b2, hy_f_w3, hy_f_b3, hy_freq, hy_bias,
              da_lambda, da_subln_w, od_in_w, od_conv_w, od_conv_b, od_dt_bias, od_A_log, od_D,
              od_norm_w, od_out_w, final_norm_w):
    n_lat = x.shape[1]
    rows = n_lat // GRID_W
    rope = axial_rope_tables(rows, DA_HEAD_DIM)
    silu_c = jax.nn.silu(c)
    silu_cc = jax.nn.silu(c_ctx)
    h_lat, h_ctx = x, ctx
    for i in range(DEPTH):
        need_ctx = i < DEPTH - 1
        mod_l = silu_c @ ada_w[i] + ada_b[i]
        mod_c = silu_cc @ ada_w[i] + ada_b[i]
        sh_l, sc_l, g_l = jnp.split(mod_l, 3, axis=-1)
        sh_c, sc_c, g_c = jnp.split(mod_c, 3, axis=-1)
        xn_l = rmsnorm(h_lat, norm_w[i]) * (1.0 + sc_l[:, None]) + sh_l[:, None]
        xn_c = rmsnorm(h_ctx, norm_w[i]) * (1.0 + sc_c) + sh_c
        j = i // 2
        if i % 2 == 0:
            out_c, out_l = even_mixer(
                xn_c, xn_l, rope, i, need_ctx, ev_in_w[j], ev_out_w[j], hy_short_w[j], hy_short_b[j],
                hy_f_w1[j], hy_f_b1[j], hy_f_w2[j], hy_f_b2[j], hy_f_w3[j], hy_f_b3[j], hy_freq[j],
                hy_bias[j], da_lambda[j], da_subln_w[j])
        else:
            out_c, out_l = odd_mixer(
                xn_c, xn_l, need_ctx, od_in_w[j], od_conv_w[j], od_conv_b[j], od_dt_bias[j],
                od_A_log[j], od_D[j], od_norm_w[j], od_out_w[j])
        h_lat = h_lat + g_l[:, None] * out_l
        if need_ctx:
            h_ctx = h_ctx + g_c * out_c
    return rmsnorm(h_lat, final_norm_w)
```

```cpp
#include <hip/hip_runtime.h>
#include <hip/hip_cooperative_groups.h>
#include <cstdio>
#include <cstdint>
namespace cg = cooperative_groups;

#ifndef ONE_LAUNCH
#define ONE_LAUNCH 1
#endif

typedef unsigned short u16;
typedef unsigned int u32;
using bf16x8 = __attribute__((ext_vector_type(8))) short;
using s16x4  = __attribute__((ext_vector_type(4))) short;
using f32x16 = __attribute__((ext_vector_type(16))) float;
using u32x4  = __attribute__((ext_vector_type(4))) unsigned;
using u32x2  = __attribute__((ext_vector_type(2))) unsigned;

#ifndef ATT_REP
#define ATT_REP 1
#endif
#ifndef HYL_REP
#define HYL_REP 1
#endif
#ifndef GEMM_REP
#define GEMM_REP 1
#endif
#ifndef MISC_REP
#define MISC_REP 1
#endif
#ifndef TAIL_REP
#define TAIL_REP 2
#endif
#ifndef SSD1_REP
#define SSD1_REP 1
#endif
#define NT 512
constexpr int DM = 1024;
constexpr int NB = 2;
constexpr int LL = 16384;
constexpr int CT = 256;
constexpr int SS = LL + CT;
constexpr int NTOK = NB * SS;
constexpr float EPSN = 1e-6f;
constexpr int NPH = 14;

constexpr size_t MiB = 1048576;
constexpr size_t OFF_WEIN = 0, OFF_WEOUT = 8 * MiB, OFF_WOIN = 10 * MiB, OFF_WOOUT = 23 * MiB;
constexpr size_t OFF_MODS = 27 * MiB;
constexpr size_t OFF_CNT = 27 * MiB + 128 * 1024;
constexpr size_t OFF_ROPE = 27 * MiB + 160 * 1024;
constexpr size_t OFF_DEC = 27 * MiB + 256 * 1024;
constexpr size_t OFF_BAR = 27 * MiB + 768 * 1024;
constexpr size_t OFF_H2 = 28 * MiB;
constexpr size_t OFF_KRAW256 = 33 * MiB;
constexpr size_t OFF_GCTX = 35 * MiB;
constexpr size_t OFF_BIG = 37 * MiB;
constexpr size_t SZ_HYT = (size_t)NB * 1536 * SS * 2;
constexpr size_t SZ_TOK512 = (size_t)NTOK * 512 * 2;
constexpr size_t OFF_HYT = OFF_BIG, OFF_HG = OFF_HYT + SZ_HYT, OFF_AG = OFF_HG + SZ_TOK512;
constexpr size_t OFF_Q = OFF_AG + SZ_TOK512, OFF_K = OFF_Q + SZ_TOK512, OFF_VT = OFF_K + SZ_TOK512;
constexpr size_t OFF_XBC = OFF_BIG;
constexpr size_t OFF_ZREG = 297 * MiB;
constexpr size_t OFF_XN = OFF_ZREG;
constexpr size_t OFF_FFTS = OFF_ZREG + 65 * MiB;
constexpr size_t OFF_ZB = OFF_ZREG;
constexpr size_t OFF_OUT0 = 425 * MiB;
constexpr size_t OFF_DT = 490 * MiB;
constexpr size_t OFF_HALO = 499 * MiB;
constexpr size_t OFF_END = 504 * MiB;

constexpr int LDS_BYTES = 156672;

struct Params {
  const float* in[30];
  float* out;
  unsigned char* ws;
  int ph_lo, ph_hi;
};

__device__ __forceinline__ u16 f2bf(float f) { return __builtin_bit_cast(u16, (__bf16)f); }
__device__ __forceinline__ float bf2f(u16 h) { return __uint_as_float(((u32)h) << 16); }
typedef float f32x2_t __attribute__((ext_vector_type(2)));
typedef __bf16 bf16x2_t __attribute__((ext_vector_type(2)));
__device__ __forceinline__ u32 pack2(float a, float b) {
  f32x2_t v = {a, b};
  bf16x2_t r = __builtin_convertvector(v, bf16x2_t);
  return __builtin_bit_cast(u32, r);
}
__device__ __forceinline__ float silu_f(float x) { return x * __builtin_amdgcn_rcpf(1.f + __expf(-x)); }
__device__ __forceinline__ float softplus_f(float x) {
  float y = __expf(-fabsf(x));
  float l = (y < 1e-2f) ? y * (1.f - y * (0.5f - y * (1.f / 3.f))) : __logf(1.f + y);
  return fmaxf(x, 0.f) + l;
}
__device__ __forceinline__ int opaque_tid() { int t = threadIdx.x; asm volatile("" : "+v"(t)); return t; }
#define MFMA(a, b, c) __builtin_amdgcn_mfma_f32_32x32x16_bf16((a), (b), (c), 0, 0, 0)

__device__ __forceinline__ float wave_sum(float v) {
#pragma unroll
  for (int o = 32; o >= 1; o >>= 1) v += __shfl_xor(v, o);
  return v;
}
__device__ __forceinline__ float block_sum(float v, float* red) {
  v = wave_sum(v);
  __syncthreads();
  if ((threadIdx.x & 63) == 0) red[threadIdx.x >> 6] = v;
  __syncthreads();
  float t = 0.f;
#pragma unroll
  for (int i = 0; i < 8; ++i) t += red[i];
  return t;
}

__device__ __forceinline__ void transpose_tile(const float* __restrict__ W, int K, int N, u16* __restrict__ Wt, int kt, int nt, float* tile) {
  const int tid = opaque_tid();
  {
    int k = tid >> 3, ng = (tid & 7) * 8;
    const float* src = W + (size_t)(kt * 64 + k) * N + nt * 64 + ng;
    float4 a = *(const float4*)src, b = *(const float4*)(src + 4);
    float* d = tile + k * 65 + ng;
    d[0] = a.x; d[1] = a.y; d[2] = a.z; d[3] = a.w; d[4] = b.x; d[5] = b.y; d[6] = b.z; d[7] = b.w;
  }
  __syncthreads();
  {
    int n = tid >> 3, kg = (tid & 7) * 8;
    u32x4 o;
    o[0] = pack2(tile[(kg + 0) * 65 + n], tile[(kg + 1) * 65 + n]);
    o[1] = pack2(tile[(kg + 2) * 65 + n], tile[(kg + 3) * 65 + n]);
    o[2] = pack2(tile[(kg + 4) * 65 + n], tile[(kg + 5) * 65 + n]);
    o[3] = pack2(tile[(kg + 6) * 65 + n], tile[(kg + 7) * 65 + n]);
    *(u32x4*)(Wt + (size_t)(nt * 64 + n) * K + kt * 64 + kg) = o;
  }
  __syncthreads();
}

__device__ __forceinline__ void phase_prep(const Params& P, unsigned char* smem) {
  const int tid = opaque_tid();
  float* fs = (float*)smem;
  const int n_wt = 1024 + 256 + 1552 + 512;
  const int i_pad = n_wt, i_mod = i_pad + 1, i_h2 = i_mod + 384, i_misc = i_h2 + 2080, n_items = i_misc + 1;
  float* w1s = fs + 8192;
  float* w2s = w1s + 33 * 64;
  for (int i = tid; i < 33 * 64; i += NT) w1s[i] = P.in[11][i];
  for (int i = tid; i < 64 * 64; i += NT) w2s[i] = P.in[13][i];
  __syncthreads();
  for (int it = blockIdx.x; it < n_items; it += gridDim.x) {
    if (it < n_wt) {
      int t = it;
      if (t < 1024) transpose_tile(P.in[7], 1024, 4096, (u16*)(P.ws + OFF_WEIN), t / 64, t % 64, fs);
      else if ((t -= 1024) < 256) transpose_tile(P.in[8], 1024, 1024, (u16*)(P.ws + OFF_WEOUT), t / 16, t % 16, fs);
      else if ((t -= 256) < 1552) transpose_tile(P.in[21], 1024, 6208, (u16*)(P.ws + OFF_WOIN), t / 97, t % 97, fs);
      else { t -= 1552; transpose_tile(P.in[28], 2048, 1024, (u16*)(P.ws + OFF_WOOUT), t / 16, t % 16, fs); }
    } else if (it == i_pad) {
      u32 zz = 0; asm volatile("" : "+v"(zz));
      u32x4 z = {zz, zz, zz, zz};
      u32x4* d = (u32x4*)(P.ws + OFF_WOIN + (size_t)6208 * 1024 * 2);
      for (int i = tid; i < 192 * 1024 * 2 / 16; i += NT) d[i] = z;
    } else if (it < i_h2) {
      int m = it - i_mod;
      int layer = m / 192, cg16 = m % 192;
      int kg = tid >> 4, col = cg16 * 16 + (tid & 15);
      const float* w = P.in[4] + (size_t)layer * 1024 * 3072;
      float s0 = 0.f, s1 = 0.f, s2 = 0.f;
#pragma unroll 4
      for (int k = kg * 32; k < kg * 32 + 32; ++k) {
        float wv = w[(size_t)k * 3072 + col];
        s0 += silu_f(P.in[1][k]) * wv;
        s1 += silu_f(P.in[1][1024 + k]) * wv;
        s2 += silu_f(P.in[3][k]) * wv;
      }
      __syncthreads();
      fs[(0 * 32 + kg) * 16 + (tid & 15)] = s0;
      fs[(1 * 32 + kg) * 16 + (tid & 15)] = s1;
      fs[(2 * 32 + kg) * 16 + (tid & 15)] = s2;
      __syncthreads();
      if (tid < 48) {
        int v = tid >> 4, c = tid & 15;
        float s = 0.f;
#pragma unroll 4
        for (int g = 0; g < 32; ++g) s += fs[(v * 32 + g) * 16 + c];
        int cc = cg16 * 16 + c;
        ((float*)(P.ws + OFF_MODS))[(layer * 3 + v) * 3072 + cc] = s + P.in[5][layer * 3072 + cc];
      }
      __syncthreads();
    } else if (it < i_misc) {
      int gp = (it - i_h2) * 8 + (tid >> 6);
      int j = tid & 63, pl = tid >> 6;
      int Lp = gp < LL ? LL : CT;
      int t = gp < LL ? gp : gp - LL;
      float* zs = fs;
      float* h1s = fs + 8 * 40;
      __syncthreads();
      if (j < 33) {
        float z;
        if (j == 0) z = (float)t / (float)(Lp - 1);
        else {
          int bi = (j - 1) & 15;
          float band = 1e-4f + (float)bi * ((15.f - 1e-4f) / 15.f);
          float w = 6.283185307179586f * (float)t / (float)Lp;
          float a = band * w;
          z = (j <= 16) ? cosf(a) : -sinf(a);
        }
        zs[pl * 40 + j] = z;
      }
      __syncthreads();
      {
        float a = P.in[12][j];
#pragma unroll 3
        for (int e = 0; e < 33; ++e) a += zs[pl * 40 + e] * w1s[e * 64 + j];
        h1s[pl * 64 + j] = sinf(P.in[17][j] * a);
      }
      __syncthreads();
      {
        float a = P.in[14][j];
#pragma unroll 4
        for (int i = 0; i < 64; ++i) a += h1s[pl * 64 + i] * w2s[i * 64 + j];
        ((float*)(P.ws + OFF_H2))[(size_t)gp * 64 + j] = sinf(P.in[17][64 + j] * a);
      }
      __syncthreads();
    } else {
      for (int i = tid; i < 256 * 16; i += NT) {
        int pos = i >> 4, j = i & 15;
        float inv = exp2f(-(float)j * (13.287712379549449f / 16.f));
        float sn, cs;
        sincosf((float)pos * inv, &sn, &cs);
        ((float2*)(P.ws + OFF_ROPE))[i] = make_float2(cs, sn);
      }
      if (tid == 0) {
        int* cnt = (int*)(P.ws + OFF_CNT);
        cnt[0] = 0;
        const float* lp = P.in[19];
        float a = 0.f, b = 0.f;
        for (int i = 0; i < 64; ++i) { a += lp[i] * lp[64 + i]; b += lp[128 + i] * lp[192 + i]; }
        ((float*)cnt)[1] = expf(a) - expf(b) + 0.2f;
      }
    }
  }
}

__device__ __forceinline__ void phase_norm(const Params& P, int layer, u16* __restrict__ xn) {
  const int tid_ = opaque_tid(); const int lane = tid_ & 63, wv = tid_ >> 6;
  const float* mods = (const float*)(P.ws + OFF_MODS) + (size_t)layer * 3 * 3072;
  const float* nw = P.in[6] + layer * 1024;
  const u16* out0 = (const u16*)(P.ws + OFF_OUT0);
  for (int it = blockIdx.x; it < NTOK / 8; it += gridDim.x) {
    int tok = it * 8 + wv;
    int b = tok / SS, s = tok % SS;
    const float* src = (s < CT) ? (P.in[2] + ((size_t)b * CT + s) * DM) : (P.in[0] + ((size_t)b * LL + (s - CT)) * DM);
    const float* mv = mods + ((s < CT) ? 2 : b) * 3072;
    float4 v[4];
    float ss = 0.f;
#pragma unroll
    for (int i = 0; i < 4; ++i) {
      int col = i * 256 + lane * 4;
      v[i] = *(const float4*)(src + col);
      if (layer == 1) {
        u32x2 d = *(const u32x2*)(out0 + (size_t)tok * DM + col);
        v[i].x += bf2f((u16)(d[0] & 0xffff)); v[i].y += bf2f((u16)(d[0] >> 16));
        v[i].z += bf2f((u16)(d[1] & 0xffff)); v[i].w += bf2f((u16)(d[1] >> 16));
      }
      ss += v[i].x * v[i].x + v[i].y * v[i].y + v[i].z * v[i].z + v[i].w * v[i].w;
    }
    ss = wave_sum(ss);
    float rstd = rsqrtf(ss * (1.f / DM) + EPSN);
#pragma unroll
    for (int i = 0; i < 4; ++i) {
      int col = i * 256 + lane * 4;
      float4 w = *(const float4*)(nw + col);
      float4 sh = *(const float4*)(mv + col);
      float4 sc = *(const float4*)(mv + 1024 + col);
      float a0 = v[i].x * rstd * w.x * (1.f + sc.x) + sh.x;
      float a1 = v[i].y * rstd * w.y * (1.f + sc.y) + sh.y;
      float a2 = v[i].z * rstd * w.z * (1.f + sc.z) + sh.z;
      float a3 = v[i].w * rstd * w.w * (1.f + sc.w) + sh.w;
      u32x2 o; o[0] = pack2(a0, a1); o[1] = pack2(a2, a3);
      *(u32x2*)(xn + (size_t)tok * DM + col) = o;
    }
  }
}

__device__ __forceinline__ void phase_filter(const Params& P, unsigned char* smem) {
  const int tid = opaque_tid();
  float* hs = (float*)smem;
  float* wsm = hs + 128 * 65;
  const float* H2 = (const float*)(P.ws + OFF_H2);
  const float* w3 = P.in[15];
  const float* b3 = P.in[16];
  const int nbig = 128 * 16, nsm = 2 * 16;
  const int tq = tid & 31, cg8 = tid >> 5;
  for (int it = blockIdx.x; it < nbig + nsm; it += gridDim.x) {
    int Lp, tt, ct; float* dst; size_t hoff;
    if (it < nbig) { Lp = LL; tt = it >> 4; ct = it & 15; dst = P.out; hoff = 0; }
    else { int k = it - nbig; Lp = CT; tt = k >> 4; ct = k & 15; dst = (float*)(P.ws + OFF_KRAW256); hoff = (size_t)LL * 64; }
    __syncthreads();
    for (int i = tid; i < 128 * 16; i += NT) {
      int rr = i >> 4, c4 = (i & 15) * 4;
      float4 v = *(const float4*)(H2 + hoff + (size_t)(tt * 128 + rr) * 64 + c4);
      float* d = hs + rr * 65 + c4; d[0] = v.x; d[1] = v.y; d[2] = v.z; d[3] = v.w;
    }
    for (int i = tid; i < 64 * 32; i += NT) {
      int rr = i >> 5, c4 = (i & 31) * 4;
      *(float4*)(wsm + rr * 128 + c4) = *(const float4*)(w3 + (size_t)rr * 2048 + ct * 128 + c4);
    }
    __syncthreads();
    float acc[4][8];
#pragma unroll
    for (int e = 0; e < 8; ++e) { float b = b3[ct * 128 + cg8 * 8 + e]; acc[0][e] = b; acc[1][e] = b; acc[2][e] = b; acc[3][e] = b; }
#pragma unroll 4
    for (int j = 0; j < 64; ++j) {
      float a[4], wv[8];
#pragma unroll
      for (int i = 0; i < 4; ++i) a[i] = hs[(tq + 32 * i) * 65 + j];
      *(float4*)&wv[0] = *(const float4*)(wsm + j * 128 + cg8 * 8);
      *(float4*)&wv[4] = *(const float4*)(wsm + j * 128 + cg8 * 8 + 4);
#pragma unroll
      for (int i = 0; i < 4; ++i)
#pragma unroll
        for (int e = 0; e < 8; ++e) acc[i][e] += a[i] * wv[e];
    }
    const float mind = -3.0701134573253944f, maxd = -15.350567286626972f;
#pragma unroll
    for (int e = 0; e < 8; ++e) {
      const int col = ct * 128 + cg8 * 8 + e;
      const float delta = fabsf(mind + (float)(col & 511) * ((maxd - mind) / 511.f));
#pragma unroll
      for (int i = 0; i < 4; ++i) {
        const int t = tt * 128 + tq + 32 * i;
        const float tlin = (float)t / (float)(Lp - 1);
        dst[(size_t)col * Lp + t] = acc[i][e] * expf(-tlin * delta);
      }
    }
  }
}

constexpr int EP = 36;
template <int MODE>
__device__ __forceinline__ void gemm_epilogue(const Params& P, int row0, int col0, const f32x16& acc, float* wl);

__device__ __forceinline__ void glds_tile(const u16* __restrict__ g, int ld, int k0, unsigned char* ldst, int tid) {
#pragma unroll
  for (int p = 0; p < 4; ++p) {
    const int slot = p * 512 + tid;
    const int row = slot >> 3, kc = (slot & 7) ^ ((row >> 1) & 7);
    unsigned off = (unsigned)(row * ld + kc * 8);
    asm volatile("" : "+v"(off));
    __builtin_amdgcn_global_load_lds((const unsigned*)((g + k0) + off), (unsigned*)(ldst + slot * 16), 16, 0, 0);
  }
}

template <int MODE>
__device__ __forceinline__ void gemm_phase(const Params& P, const u16* __restrict__ A, int lda, const u16* __restrict__ Bt, int ldb,
                           int K, int nMt, int nNt, unsigned char* smem) {
  const int tid = opaque_tid(), lane = tid & 63, w = tid >> 6;
  const int r = lane & 31, h = lane >> 5;
  const int wm = w >> 2, wn = w & 3;
  unsigned char* As = smem;
  unsigned char* Bs = smem + 2 * 32768;
  const int KT = K / 64;
  const int sw = (r >> 1) & 7;
  const int nTiles = nMt * nNt;
  const int bslot = (blockIdx.x & 7) * (gridDim.x >> 3) + (blockIdx.x >> 3);
  for (int tile0 = 0; tile0 < nTiles; tile0 += gridDim.x) {
    const int T = tile0 + ((gridDim.x & 7) ? (int)blockIdx.x : bslot);
    if (T >= nTiles) break;
    int mt, nt;
    {
      const int nig = 8 * nNt, gid = T / nig, fm = gid * 8, gsz = min(nMt - fm, 8), within = T - gid * nig;
      mt = fm + within % gsz; nt = within / gsz;
    }
    int arow0 = mt * 256;
    const u16* Ap = A + (size_t)arow0 * lda;
    const u16* Bp = Bt + (size_t)(nt * 256) * ldb;
    f32x16 acc[4][2];
#pragma unroll
    for (int i = 0; i < 4; ++i)
#pragma unroll
      for (int j = 0; j < 2; ++j)
#pragma unroll
        for (int e = 0; e < 16; ++e) acc[i][j][e] = 0.f;
    __syncthreads();
    glds_tile(Ap, lda, 0, As, tid);
    glds_tile(Bp, ldb, 0, Bs, tid);
    asm volatile("s_waitcnt vmcnt(0)" ::: "memory");
    __syncthreads();
    for (int kt = 0; kt < KT; ++kt) {
      const int buf = kt & 1;
      const unsigned char* as = As + buf * 32768 + (wm * 128 + r) * 128;
      const unsigned char* bs = Bs + buf * 32768 + (wn * 64 + r) * 128;
      bf16x8 af[2][4], bfr[2][2];
      {
        const int o0 = ((0 * 2 + h) ^ sw) * 16;
#pragma unroll
        for (int i = 0; i < 4; ++i) af[0][i] = *(const bf16x8*)(as + i * 4096 + o0);
#pragma unroll
        for (int j = 0; j < 2; ++j) bfr[0][j] = *(const bf16x8*)(bs + j * 4096 + o0);
      }
#pragma unroll
      for (int ks = 0; ks < 4; ++ks) {
        if (ks + 1 < 4) {
          const int o1 = (((ks + 1) * 2 + h) ^ sw) * 16;
#pragma unroll
          for (int i = 0; i < 4; ++i) af[(ks + 1) & 1][i] = *(const bf16x8*)(as + i * 4096 + o1);
#pragma unroll
          for (int j = 0; j < 2; ++j) bfr[(ks + 1) & 1][j] = *(const bf16x8*)(bs + j * 4096 + o1);
        }
        __builtin_amdgcn_sched_barrier(0);
#pragma unroll
        for (int i = 0; i < 4; ++i)
#pragma unroll
          for (int j = 0; j < 2; ++j) acc[i][j] = MFMA(af[ks & 1][i], bfr[ks & 1][j], acc[i][j]);
        __builtin_amdgcn_sched_barrier(0);
        if (ks == 0 && kt + 1 < KT) glds_tile(Ap, lda, (kt + 1) * 64, As + (buf ^ 1) * 32768, tid);
        if (ks == 1 && kt + 1 < KT) glds_tile(Bp, ldb, (kt + 1) * 64, Bs + (buf ^ 1) * 32768, tid);
        __builtin_amdgcn_sched_barrier(0);
      }
      asm volatile("s_waitcnt vmcnt(0)" ::: "memory");
      __syncthreads();
    }
#pragma unroll
    for (int i = 0; i < 4; ++i)
#pragma unroll
      for (int j = 0; j < 2; ++j)
      {
        gemm_epilogue<MODE>(P, arow0 + wm * 128 + i * 32, nt * 256 + wn * 64 + j * 32, acc[i][j], (float*)smem + w * (32 * EP));
        __builtin_amdgcn_sched_barrier(0);
      }
  }
}

__device__ __forceinline__ void lds_wave_fence() { asm volatile("s_waitcnt lgkmcnt(0)" ::: "memory"); }
__device__ __forceinline__ void stage_rowmajor(float* wl, const f32x16& acc, int r, int h) {
#pragma unroll
  for (int j = 0; j < 16; ++j) wl[((j & 3) + 8 * (j >> 2) + 4 * h) * EP + r] = acc[j];
  lds_wave_fence();
}
__device__ __forceinline__ void stage_colmajor(float* wl, const f32x16& acc, int r, int h) {
#pragma unroll
  for (int g = 0; g < 4; ++g) *(float4*)(wl + r * EP + 8 * g + 4 * h) = make_float4(acc[4 * g], acc[4 * g + 1], acc[4 * g + 2], acc[4 * g + 3]);
  lds_wave_fence();
}
__device__ __forceinline__ u32x4 pack8(const float4& a, const float4& b) {
  u32x4 o; o[0] = pack2(a.x, a.y); o[1] = pack2(a.z, a.w); o[2] = pack2(b.x, b.y); o[3] = pack2(b.z, b.w); return o;
}

template <>
__device__ __forceinline__ void gemm_epilogue<0>(const Params& P, int row0, int col0, const f32x16& acc, float* wl) {
  const int lane = opaque_tid() & 63, r = lane & 31, h = lane >> 5;
  const int b = row0 / SS, s0 = row0 % SS;
  if (col0 < 1536 || (col0 >= 3072 && col0 < 3584)) {
    stage_colmajor(wl, acc, r, h);
#pragma unroll
    for (int k = 0; k < 2; ++k) {
      const int id = lane + 64 * k, col = id >> 2, rc = (id & 3) * 8;
      const float4 a = *(const float4*)(wl + col * EP + rc), c = *(const float4*)(wl + col * EP + rc + 4);
      const u32x4 pv8 = pack8(a, c);
      if (col0 < 1536) *(u32x4*)((u16*)(P.ws + OFF_HYT) + ((size_t)b * 1536 + col0 + col) * SS + s0 + rc) = pv8;
      else {
        const int cc = col0 + col - 3072;
        u16* dst = (u16*)(P.ws + OFF_VT) + ((size_t)(b * 4 + (cc >> 7)) * 128 + (cc & 127)) * SS + s0 + (rc & ~15);
        u32x2 lo, hi; lo[0] = pv8[0]; lo[1] = pv8[1]; hi[0] = pv8[2]; hi[1] = pv8[3];
        *(u32x2*)(dst + ((rc & 8) ? 4 : 0)) = lo;
        *(u32x2*)(dst + ((rc & 8) ? 12 : 8)) = hi;
      }
    }
  } else if (col0 < 2048 || col0 >= 3584) {
    stage_rowmajor(wl, acc, r, h);
    u16* base = (col0 < 2048) ? ((u16*)(P.ws + OFF_HG) + (col0 - 1536)) : ((u16*)(P.ws + OFF_AG) + (col0 - 3584));
#pragma unroll
    for (int k = 0; k < 2; ++k) {
      const int id = lane + 64 * k, row = id >> 2, c8 = (id & 3) * 8;
      const float4 a = *(const float4*)(wl + row * EP + c8), c = *(const float4*)(wl + row * EP + c8 + 4);
      *(u32x4*)(base + (size_t)(row0 + row) * 512 + c8) = pack8(a, c);
    }
  } else {
    stage_rowmajor(wl, acc, r, h);
    const bool isq = col0 < 2560;
    const int cc0 = col0 - (isq ? 2048 : 2560);
    const int head = cc0 >> 7, comp = (cc0 >> 6) & 1, dt0 = cc0 & 63;
    u16* base = (u16*)(P.ws + (isq ? OFF_Q : OFF_K)) + ((size_t)((b * 4 + head) * 2 + comp) * SS) * 64 + dt0;
    const float qs = isq ? (0.125f * 1.4426950408889634f) : 1.f;
#pragma unroll
    for (int k = 0; k < 2; ++k) {
      const int id = lane + 64 * k, row = id >> 2, c8 = (id & 3) * 8;
      const int s = s0 + row;
      float v[8], pv[8];
      *(float4*)&v[0] = *(const float4*)(wl + row * EP + c8); *(float4*)&v[4] = *(const float4*)(wl + row * EP + c8 + 4);
      *(float4*)&pv[0] = *(const float4*)(wl + row * EP + (c8 ^ 16)); *(float4*)&pv[4] = *(const float4*)(wl + row * EP + (c8 ^ 16) + 4);
      float o[8];
      if (s >= CT) {
        const int t = s - CT;
        const int pos = (dt0 == 0) ? (t >> 6) : (t & 63);
        const float4* rp = (const float4*)((const float2*)(P.ws + OFF_ROPE) + pos * 16 + (c8 & 15));
        float cs[8], sn[8];
#pragma unroll
        for (int i = 0; i < 4; ++i) { float4 q4 = rp[i]; cs[2 * i] = q4.x; sn[2 * i] = q4.y; cs[2 * i + 1] = q4.z; sn[2 * i + 1] = q4.w; }
        const bool hi16 = (c8 & 16) != 0;
#pragma unroll
        for (int i = 0; i < 8; ++i) o[i] = (hi16 ? (pv[i] * sn[i] + v[i] * cs[i]) : (v[i] * cs[i] - pv[i] * sn[i])) * qs;
      } else {
#pragma unroll
        for (int i = 0; i < 8; ++i) o[i] = v[i] * qs;
      }
      u32x4 ov; ov[0] = pack2(o[0], o[1]); ov[1] = pack2(o[2], o[3]); ov[2] = pack2(o[4], o[5]); ov[3] = pack2(o[6], o[7]);
      *(u32x4*)(base + (size_t)s * 64 + c8) = ov;
    }
  }
}
template <>
__device__ __forceinline__ void gemm_epilogue<1>(const Params& P, int row0, int col0, const f32x16& acc, float* wl) {
  const int lane = opaque_tid() & 63, r = lane & 31, h = lane >> 5;
  const int b = row0 / SS, s0 = row0 % SS;
  stage_rowmajor(wl, acc, r, h);
  const float* gp = (const float*)(P.ws + OFF_MODS) + ((s0 < CT) ? 2 : b) * 3072 + 2048 + col0;
  u16* base = (u16*)(P.ws + OFF_OUT0) + col0;
#pragma unroll
  for (int k = 0; k < 2; ++k) {
    const int id = lane + 64 * k, row = id >> 2, c8 = (id & 3) * 8;
    float4 a = *(const float4*)(wl + row * EP + c8), c = *(const float4*)(wl + row * EP + c8 + 4);
    const float4 g0 = *(const float4*)(gp + c8), g1 = *(const float4*)(gp + c8 + 4);
    a.x *= g0.x; a.y *= g0.y; a.z *= g0.z; a.w *= g0.w; c.x *= g1.x; c.y *= g1.y; c.z *= g1.z; c.w *= g1.w;
    *(u32x4*)(base + (size_t)(row0 + row) * DM + c8) = pack8(a, c);
  }
}
template <>
__device__ __forceinline__ void gemm_epilogue<2>(const Params& P, int row0, int col0, const f32x16& acc, float* wl) {
  const int lane = opaque_tid() & 63, r = lane & 31, h = lane >> 5;
  const int b = row0 / SS, s0 = row0 % SS;
  if (col0 >= 6208) return;
  if (col0 < 2048 && s0 < CT) return;
  stage_rowmajor(wl, acc, r, h);
  if (col0 < 2048) {
    u16* base = (u16*)(P.ws + OFF_ZB) + ((size_t)b * LL + (s0 - CT)) * 2048 + col0;
#pragma unroll
    for (int k = 0; k < 2; ++k) {
      const int id = lane + 64 * k, row = id >> 2, c8 = (id & 3) * 8;
      const float4 a = *(const float4*)(wl + row * EP + c8), c = *(const float4*)(wl + row * EP + c8 + 4);
      *(u32x4*)(base + (size_t)row * 2048 + c8) = pack8(a, c);
    }
  } else if (col0 < 6144) {
    const int cc0 = col0 - 2048;
    u16* base = (u16*)(P.ws + OFF_XBC) + cc0;
    u16* halo = (u16*)(P.ws + OFF_HALO) + cc0;
#pragma unroll
    for (int k = 0; k < 2; ++k) {
      const int id = lane + 64 * k, row = id >> 2, c8 = (id & 3) * 8;
      const float4 a = *(const float4*)(wl + row * EP + c8), c = *(const float4*)(wl + row * EP + c8 + 4);
      const u32x4 ov = pack8(a, c);
      const int tok = row0 + row;
      *(u32x4*)(base + (size_t)tok * 4096 + c8) = ov;
      const int m = tok & 127;
      if (m == 0) *(u32x4*)(halo + ((size_t)(tok >> 7) * 2 + 0) * 4096 + c8) = ov;
      if (m == 127) *(u32x4*)(halo + ((size_t)(tok >> 7) * 2 + 1) * 4096 + c8) = ov;
    }
  } else {
    const int cc0 = col0 - 6144;
    const float* bp = P.in[24] + cc0;
    float* base = (float*)(P.ws + OFF_DT) + cc0;
#pragma unroll
    for (int k = 0; k < 2; ++k) {
      const int id = lane + 64 * k, row = id >> 2, c8 = (id & 3) * 8;
      float4 a = *(const float4*)(wl + row * EP + c8), c = *(const float4*)(wl + row * EP + c8 + 4);
      const float4 b0 = *(const float4*)(bp + c8), b1 = *(const float4*)(bp + c8 + 4);
      a.x = softplus_f(a.x + b0.x); a.y = softplus_f(a.y + b0.y); a.z = softplus_f(a.z + b0.z); a.w = softplus_f(a.w + b0.w);
      c.x = softplus_f(c.x + b1.x); c.y = softplus_f(c.y + b1.y); c.z = softplus_f(c.z + b1.z); c.w = softplus_f(c.w + b1.w);
      float* d = base + (size_t)(row0 + row) * 64 + c8;
      *(float4*)d = a; *(float4*)(d + 4) = c;
    }
  }
}
template <>
__device__ __forceinline__ void gemm_epilogue<3>(const Params& P, int row0, int col0, const f32x16& acc, float* wl) {
  const int lane = opaque_tid() & 63, r = lane & 31, h = lane >> 5;
  const int b = row0 / LL, t0 = row0 % LL;
  stage_rowmajor(wl, acc, r, h);
  const float* gp = (const float*)(P.ws + OFF_MODS) + 3 * 3072 + b * 3072 + 2048 + col0;
  const u16* o0 = (const u16*)(P.ws + OFF_OUT0) + ((size_t)b * SS + CT + t0) * DM + col0;
  const float* xin = P.in[0] + (size_t)row0 * DM + col0;
  float* dst = P.out + (size_t)row0 * DM + col0;
#pragma unroll
  for (int k = 0; k < 4; ++k) {
    const int id = lane + 64 * k, row = id >> 3, c4 = (id & 7) * 4;
    const float4 a = *(const float4*)(wl + row * EP + c4);
    const float4 g = *(const float4*)(gp + c4);
    const float4 x = *(const float4*)(xin + (size_t)row * DM + c4);
    const u32x2 ob = *(const u32x2*)(o0 + (size_t)row * DM + c4);
    float4 o;
    o.x = x.x + bf2f((u16)(ob[0] & 0xffff)) + g.x * a.x;
    o.y = x.y + bf2f((u16)(ob[0] >> 16)) + g.y * a.y;
    o.z = x.z + bf2f((u16)(ob[1] & 0xffff)) + g.z * a.z;
    o.w = x.w + bf2f((u16)(ob[1] >> 16)) + g.w * a.w;
    *(float4*)(dst + (size_t)row * DM + c4) = o;
  }
}

__device__ __forceinline__ float2 cmul(float2 a, float2 b) { return make_float2(a.x * b.x - a.y * b.y, a.x * b.y + a.y * b.x); }

__device__ __forceinline__ void bf4_fwd(float2& a0, float2& a1, float2& a2, float2& a3) {
  float2 t0 = make_float2(a0.x + a2.x, a0.y + a2.y), t1 = make_float2(a0.x - a2.x, a0.y - a2.y);
  float2 t2 = make_float2(a1.x + a3.x, a1.y + a3.y), t3 = make_float2(a1.x - a3.x, a1.y - a3.y);
  a0 = make_float2(t0.x + t2.x, t0.y + t2.y); a2 = make_float2(t0.x - t2.x, t0.y - t2.y);
  a1 = make_float2(t1.x + t3.y, t1.y - t3.x);
  a3 = make_float2(t1.x - t3.y, t1.y + t3.x);
}
__device__ __forceinline__ void bf4_inv(float2& a0, float2& a1, float2& a2, float2& a3) {
  float2 t0 = make_float2(a0.x + a2.x, a0.y + a2.y), t1 = make_float2(a0.x - a2.x, a0.y - a2.y);
  float2 t2 = make_float2(a1.x + a3.x, a1.y + a3.y), t3 = make_float2(a1.x - a3.x, a1.y - a3.y);
  a0 = make_float2(t0.x + t2.x, t0.y + t2.y); a2 = make_float2(t0.x - t2.x, t0.y - t2.y);
  a1 = make_float2(t1.x - t3.y, t1.y + t3.x);
  a3 = make_float2(t1.x + t3.y, t1.y - t3.x);
}
template <bool INV>
__device__ __forceinline__ void fft_pass4(float2* X, const int lq, const int tid) {
  const int q = 1 << lq;
  for (int i = tid; i < 4096; i += NT) {
    int blk = i >> lq, j = i & (q - 1);
    int base = (blk << (lq + 2)) + j;
    float sn, cs;
    sincospif(2.f * (float)j / (float)(4 * q), &sn, &cs);
    const float2 w1 = make_float2(cs, INV ? sn : -sn);
    const float2 w2 = cmul(w1, w1), w3 = cmul(w2, w1);
    float2 a0 = X[base], a1 = X[base + q], a2 = X[base + 2 * q], a3 = X[base + 3 * q];
    if (!INV) { bf4_fwd(a0, a1, a2, a3); a1 = cmul(a1, w1); a2 = cmul(a2, w2); a3 = cmul(a3, w3); }
    else { a1 = cmul(a1, w1); a2 = cmul(a2, w2); a3 = cmul(a3, w3); bf4_inv(a0, a1, a2, a3); }
    X[base] = a0; X[base + q] = a1; X[base + 2 * q] = a2; X[base + 3 * q] = a3;
  }
}
template <bool INV>
__device__ __forceinline__ void fft_pass16(float2* X, const int lq, const int tid) {
  const int q = 1 << lq, qq = q >> 2, lqq = lq - 2;
  const float sg = INV ? 1.f : -1.f;
#pragma unroll 1
  for (int i = tid; i < 1024; i += NT) {
    const int blk = i >> lqq, jp = i & (qq - 1);
    const int base = (blk << (lq + 2)) + jp;
    float2 e[4][4];
#pragma unroll
    for (int a = 0; a < 4; ++a)
#pragma unroll
      for (int b = 0; b < 4; ++b) e[a][b] = X[base + a * q + b * qq];
    float sn, cs;
    sincospif(2.f * (float)jp / (float)(4 * q), &sn, &cs);
    const float2 wj = make_float2(cs, sg * sn);
    const float2 wj2 = cmul(wj, wj), w4 = cmul(wj2, wj2);
    const float2 w42 = cmul(w4, w4), w43 = cmul(w42, w4);
    const float2 c16[4] = {make_float2(1.f, 0.f), make_float2(0.92387953251128674f, sg * 0.38268343236508977f),
                           make_float2(0.70710678118654752f, sg * 0.70710678118654752f), make_float2(0.38268343236508977f, sg * 0.92387953251128674f)};
    if (!INV) {
#pragma unroll
      for (int b = 0; b < 4; ++b) {
        const float2 w1 = cmul(wj, c16[b]), w2 = cmul(w1, w1), w3 = cmul(w2, w1);
        bf4_fwd(e[0][b], e[1][b], e[2][b], e[3][b]);
        e[1][b] = cmul(e[1][b], w1); e[2][b] = cmul(e[2][b], w2); e[3][b] = cmul(e[3][b], w3);
      }
#pragma unroll
      for (int a = 0; a < 4; ++a) {
        bf4_fwd(e[a][0], e[a][1], e[a][2], e[a][3]);
        e[a][1] = cmul(e[a][1], w4); e[a][2] = cmul(e[a][2], w42); e[a][3] = cmul(e[a][3], w43);
      }
    } else {
#pragma unroll
      for (int a = 0; a < 4; ++a) {
        e[a][1] = cmul(e[a][1], w4); e[a][2] = cmul(e[a][2], w42); e[a][3] = cmul(e[a][3], w43);
        bf4_inv(e[a][0], e[a][1], e[a][2], e[a][3]);
      }
#pragma unroll
      for (int b = 0; b < 4; ++b) {
        const float2 w1 = cmul(wj, c16[b]), w2 = cmul(w1, w1), w3 = cmul(w2, w1);
        e[1][b] = cmul(e[1][b], w1); e[2][b] = cmul(e[2][b], w2); e[3][b] = cmul(e[3][b], w3);
        bf4_inv(e[0][b], e[1][b], e[2][b], e[3][b]);
      }
    }
#pragma unroll
    for (int a = 0; a < 4; ++a)
#pragma unroll
      for (int b = 0; b < 4; ++b) X[base + a * q + b * qq] = e[a][b];
  }
}
__device__ __forceinline__ void fft_fwd(float2* X) {
  const int tid = opaque_tid();
  __syncthreads(); fft_pass16<false>(X, 12, tid);
  __syncthreads(); fft_pass16<false>(X, 8, tid);
  __syncthreads(); fft_pass16<false>(X, 4, tid);
  __syncthreads(); fft_pass4<false>(X, 0, tid);
  __syncthreads();
}
__device__ __forceinline__ void fft_inv(float2* X) {
  const int tid = opaque_tid();
  __syncthreads(); fft_pass4<true>(X, 0, tid);
  __syncthreads(); fft_pass16<true>(X, 4, tid);
  __syncthreads(); fft_pass16<true>(X, 8, tid);
  __syncthreads(); fft_pass16<true>(X, 12, tid);
  __syncthreads();
}

__device__ __forceinline__ float conv3(const u16* row, int n, int Ls, float w0, float w1, float w2, float bias) {
  float a = bias + w1 * bf2f(row[n]);
  if (n > 0) a += w0 * bf2f(row[n - 1]);
  if (n + 1 < Ls) a += w2 * bf2f(row[n + 1]);
  return a;
}

__device__ __forceinline__ void conv3x4(const u16* __restrict__ row, int n, int Ls, float w0, float w1, float w2, float bias, float out[4]) {
  const u32x2 v = *(const u32x2*)(row + n);
  const float x0 = bf2f((u16)(v[0] & 0xffff)), x1 = bf2f((u16)(v[0] >> 16)), x2 = bf2f((u16)(v[1] & 0xffff)), x3 = bf2f((u16)(v[1] >> 16));
  const float xm = (n > 0) ? bf2f(row[n - 1]) : 0.f;
  const float xp = (n + 4 < Ls) ? bf2f(row[n + 4]) : 0.f;
  out[0] = bias + w0 * xm + w1 * x0 + w2 * x1;
  out[1] = bias + w0 * x0 + w1 * x1 + w2 * x2;
  out[2] = bias + w0 * x1 + w1 * x2 + w2 * x3;
  out[3] = bias + w0 * x2 + w1 * x3 + w2 * xp;
}
__device__ __forceinline__ void ld4c(const float2* p, float2 o[4]) {
  const float4 a = *(const float4*)p, b = *(const float4*)(p + 2);
  o[0] = make_float2(a.x, a.y); o[1] = make_float2(a.z, a.w); o[2] = make_float2(b.x, b.y); o[3] = make_float2(b.z, b.w);
}
__device__ __forceinline__ void st4c(float2* p, const float2 o[4]) {
  *(float4*)p = make_float4(o[0].x, o[0].y, o[1].x, o[1].y);
  *(float4*)(p + 2) = make_float4(o[2].x, o[2].y, o[3].x, o[3].y);
}

__device__ __forceinline__ void hyena_latent_item(const Params& P, int c, unsigned char* smem) {
  const int tid = opaque_tid();
  float2* X = (float2*)smem;
  float* red = (float*)(smem + 131072);
  unsigned char* scr = P.ws + OFF_FFTS + (size_t)blockIdx.x * (512 * 1024);
  float2* ABUF = (float2*)scr; float2* ZBUF = ABUF + LL;
  u16* hyt = (u16*)(P.ws + OFF_HYT);
  const float* sw = P.in[9]; const float* sb = P.in[10];
  const float* kraw = P.out;
  const float invL = 1.f / (float)LL;
  for (int rep = 0; rep < HYL_REP; ++rep)
  for (int o = 0; o < 2; ++o) {
    const float* hf = kraw + (size_t)((0 * 2 + o) * 512 + c) * LL;
    const float* hb = kraw + (size_t)((1 * 2 + o) * 512 + c) * LL;
    float2 E[32];
    __syncthreads();
    if (o == 0) {
      const float v0w = sw[0 * 1536 + c], v1w = sw[1 * 1536 + c], v2w = sw[2 * 1536 + c], vbs = sb[c];
      const u16* r0 = hyt + ((size_t)0 * 1536 + c) * SS + CT;
      const u16* r1 = hyt + ((size_t)1 * 1536 + c) * SS + CT;
      for (int n = opaque_tid() * 4; n < LL; n += NT * 4) {
        float a[4], b4[4]; float2 xv[4];
        conv3x4(r0, n, LL, v0w, v1w, v2w, vbs, a);
        conv3x4(r1, n, LL, v0w, v1w, v2w, vbs, b4);
#pragma unroll
        for (int i = 0; i < 4; ++i) xv[i] = make_float2(a[i], b4[i]);
        st4c(ZBUF + n, xv);
        st4c(X + n, xv);
      }
    } else {
      for (int n = opaque_tid() * 4; n < LL; n += NT * 4) { float2 xv[4]; ld4c(ZBUF + n, xv); st4c(X + n, xv); }
    }
    fft_fwd(X);
#pragma unroll
    for (int k = 0; k < 8; ++k) ld4c(X + (tid + k * NT) * 4, &E[4 * k]);
    float ns = 0.f;
    for (int n = opaque_tid() * 4; n < LL; n += NT * 4) {
      const float4 f4 = *(const float4*)(hf + n), b4 = *(const float4*)(hb + LL - n - 4);
      const float kf[4] = {f4.x, f4.y, f4.z, f4.w};
      const float kb[4] = {(n > 0) ? hb[LL - n] : 0.f, b4.w, b4.z, b4.y};
      float2 xv[4];
#pragma unroll
      for (int i = 0; i < 4; ++i) { ns += fabsf(kf[i]) + fabsf(kb[i]); xv[i] = make_float2(kf[i] + kb[i], 0.f); }
      st4c(X + n, xv);
    }
    const float inn = 1.f / block_sum(ns, red);
    fft_fwd(X);
#pragma unroll
    for (int k = 0; k < 8; ++k) {
      float2 xv[4]; ld4c(X + (tid + k * NT) * 4, xv);
#pragma unroll
      for (int i = 0; i < 4; ++i) { float2 v = cmul(xv[i], E[4 * k + i]); xv[i] = make_float2(v.x * inn, v.y * inn); }
      st4c(X + (tid + k * NT) * 4, xv);
    }
    fft_inv(X);
    for (int n = opaque_tid() * 4; n < LL; n += NT * 4) {
      float2 xa[4], zv[4];
      ld4c(X + n, xa);
      st4c(ABUF + n, xa);
      ld4c(ZBUF + n, zv);
#pragma unroll
      for (int i = 0; i < 4; ++i) {
        float sn, cs; sincospif((float)(n + i) * invL, &sn, &cs);
        xa[i] = cmul(zv[i], make_float2(cs, -sn));
      }
      st4c(X + n, xa);
    }
    fft_fwd(X);
#pragma unroll
    for (int k = 0; k < 8; ++k) ld4c(X + (tid + k * NT) * 4, &E[4 * k]);
    for (int n = opaque_tid() * 4; n < LL; n += NT * 4) {
      const float4 f4 = *(const float4*)(hf + n), b4 = *(const float4*)(hb + LL - n - 4);
      const float kf[4] = {f4.x, f4.y, f4.z, f4.w};
      const float kb[4] = {(n > 0) ? hb[LL - n] : 0.f, b4.w, b4.z, b4.y};
      float2 xv[4];
#pragma unroll
      for (int i = 0; i < 4; ++i) {
        float sn, cs; sincospif((float)(n + i) * invL, &sn, &cs);
        const float d = kf[i] - kb[i];
        xv[i] = make_float2(d * cs, -d * sn);
      }
      st4c(X + n, xv);
    }
    fft_fwd(X);
#pragma unroll
    for (int k = 0; k < 8; ++k) {
      float2 xv[4]; ld4c(X + (tid + k * NT) * 4, xv);
#pragma unroll
      for (int i = 0; i < 4; ++i) { float2 v = cmul(xv[i], E[4 * k + i]); xv[i] = make_float2(v.x * inn, v.y * inn); }
      st4c(X + (tid + k * NT) * 4, xv);
    }
    fft_inv(X);
    const int colg = (o == 0 ? 512 : 1024) + c;
    const float g0w = sw[0 * 1536 + colg], g1w = sw[1 * 1536 + colg], g2w = sw[2 * 1536 + colg], gbs = sb[colg];
    const u16* q0 = hyt + ((size_t)0 * 1536 + colg) * SS + CT;
    const u16* q1 = hyt + ((size_t)1 * 1536 + colg) * SS + CT;
    const float hbias = P.in[18][o * 512 + c];
    const float sc = 0.5f * invL;
    for (int n = opaque_tid() * 4; n < LL; n += NT * 4) {
      float2 bx[4], av[4], xv[4];
      float ga[4], gb[4];
      ld4c(X + n, bx); ld4c(ABUF + n, av); ld4c(ZBUF + n, xv);
      conv3x4(q0, n, LL, g0w, g1w, g2w, gbs, ga);
      conv3x4(q1, n, LL, g0w, g1w, g2w, gbs, gb);
#pragma unroll
      for (int i = 0; i < 4; ++i) {
        float sn, cs; sincospif((float)(n + i) * invL, &sn, &cs);
        const float2 bv = cmul(bx[i], make_float2(cs, sn));
        const float y0 = ((av[i].x + bv.x) * sc + xv[i].x * hbias) * ga[i];
        const float y1 = ((av[i].y + bv.y) * sc + xv[i].y * hbias) * gb[i];
        bx[i] = make_float2(y0, y1);
      }
      if (o == 0) st4c(ZBUF + n, bx);
      else st4c(X + n, bx);
    }
    __syncthreads();
  }
  {
    u16* w0 = hyt + ((size_t)0 * 1536 + c) * SS + CT;
    u16* w1 = hyt + ((size_t)1 * 1536 + c) * SS + CT;
    for (int n = opaque_tid() * 4; n < LL; n += NT * 4) {
      float2 v[4]; ld4c(X + n, v);
      u32x2 o0, o1;
      o0[0] = pack2(v[0].x, v[1].x); o0[1] = pack2(v[2].x, v[3].x);
      o1[0] = pack2(v[0].y, v[1].y); o1[1] = pack2(v[2].y, v[3].y);
      *(u32x2*)(w0 + n) = o0; *(u32x2*)(w1 + n) = o1;
    }
  }
  __syncthreads();
}

__device__ __forceinline__ void hyena_ctx_item(const Params& P, int c, unsigned char* smem) {
  const int tid = opaque_tid();
  const int b = tid >> 8, t = tid & 255;
  float* vs = (float*)smem;
  float* kf = vs + 512;
  float* kb = kf + 256;
  float* red = kb + 256;
  u16* hyt = (u16*)(P.ws + OFF_HYT);
  const float* sw = P.in[9]; const float* sb = P.in[10];
  const float* k256 = (const float*)(P.ws + OFF_KRAW256);
  float cur, x1, x2;
  {
    const u16* rv = hyt + ((size_t)b * 1536 + c) * SS;
    const u16* ra = hyt + ((size_t)b * 1536 + 512 + c) * SS;
    const u16* rb = hyt + ((size_t)b * 1536 + 1024 + c) * SS;
    cur = conv3(rv, t, CT, sw[c], sw[1536 + c], sw[3072 + c], sb[c]);
    x1 = conv3(ra, t, CT, sw[512 + c], sw[1536 + 512 + c], sw[3072 + 512 + c], sb[512 + c]);
    x2 = conv3(rb, t, CT, sw[1024 + c], sw[1536 + 1024 + c], sw[3072 + 1024 + c], sb[1024 + c]);
  }
  for (int o = 0; o < 2; ++o) {
    __syncthreads();
    float kv;
    if (b == 0) { kv = k256[(size_t)((0 * 2 + o) * 512 + c) * CT + t]; kf[t] = kv; }
    else { kv = k256[(size_t)((1 * 2 + o) * 512 + c) * CT + t]; kb[t] = kv; if (t == 0) kv = 0.f; }
    vs[b * 256 + t] = cur;
    float nrm = block_sum(fabsf(kv), red);
    float y = 0.f;
    for (int s = 0; s <= t; ++s) y += kf[t - s] * vs[b * 256 + s];
    for (int s = t + 1; s < CT; ++s) y += kb[s - t] * vs[b * 256 + s];
    y = y / nrm + cur * P.in[18][o * 512 + c];
    cur = y * (o == 0 ? x1 : x2);
  }
  __syncthreads();
  hyt[((size_t)b * 1536 + c) * SS + t] = f2bf(cur);
  __syncthreads();
}

__device__ __forceinline__ void attn_item(const Params& P, int b, int head, int qb, unsigned char* smem) {
  f32x16 O[4];
  float lrun = 0.f;
  {
  const int tid = opaque_tid(), lane = tid & 63, w = tid >> 6;
  const int r = lane & 31, h = lane >> 5;
  const int m = w & 1, wq = w >> 1;
  constexpr int KP = 72;
  unsigned char* kst = smem;
  unsigned char* vst = smem + 32768;
  u16* qs = (u16*)(smem + 65536);
  const u16* Qg = (const u16*)(P.ws + OFF_Q);
  const u16* Kg = (const u16*)(P.ws + OFF_K);
  const u16* Vg = (const u16*)(P.ws + OFF_VT);
  const int ntiles = (qb < 2) ? (CT / 64) : (SS / 64);
  const u16* K1p = Kg + ((size_t)((b * 4 + head) * 2 + 0) * SS) * 64;
  const u16* K2p = Kg + ((size_t)((b * 4 + head) * 2 + 1) * SS) * 64;
  const u16* Vp = Vg + ((size_t)(b * 4 + head) * 128) * SS;
  const int krow = tid >> 3, kkc = (tid & 7) ^ ((krow >> 1) & 7);
  unsigned koff = (unsigned)(krow * 64 + kkc * 8);
  const int e0 = tid >> 3, e1 = 64 + (tid >> 3);
  unsigned voff0 = (unsigned)(e0 * SS + ((tid & 7) ^ ((e0 >> 1) & 7)) * 8);
  unsigned voff1 = (unsigned)(e1 * SS + ((tid & 7) ^ ((e1 >> 1) & 7)) * 8);
#define GLDS16(gp, lp) __builtin_amdgcn_global_load_lds((const unsigned*)(gp), (unsigned*)(lp), 16, 0, 0)
  __syncthreads();
#pragma unroll
  for (int i = 0; i < 4; ++i) {
    int id = tid + i * NT;
    int mm = id >> 10, q = (id >> 3) & 127, ch = (id & 7) * 8;
    *(u32x4*)(qs + (mm * 128 + q) * KP + ch) = *(const u32x4*)(Qg + ((size_t)((b * 4 + head) * 2 + mm) * SS + qb * 128 + q) * 64 + ch);
  }
  GLDS16(K1p + koff, kst + tid * 16);
  GLDS16(K2p + koff, kst + 8192 + tid * 16);
  GLDS16(Vp + voff0, vst + tid * 16);
  GLDS16(Vp + voff1, vst + 8192 + tid * 16);
  if (ntiles > 1) {
    GLDS16(K1p + 64 * 64 + koff, kst + 16384 + tid * 16);
    GLDS16(K2p + 64 * 64 + koff, kst + 16384 + 8192 + tid * 16);
  }
  asm volatile("s_waitcnt vmcnt(0)" ::: "memory");
#pragma unroll
  for (int e = 0; e < 4; ++e)
#pragma unroll
    for (int j = 0; j < 16; ++j) O[e][j] = 0.f;
  float mrun;
  __syncthreads();
  const int sw = (r >> 1) & 7;
  const u16* qrow = qs + (m * 128 + wq * 32 + r) * KP + h * 8;
  f32x16 c0, c1;
  {
    bf16x8 qf[4];
#pragma unroll
    for (int sl = 0; sl < 4; ++sl) qf[sl] = *(const bf16x8*)(qrow + sl * 16);
    const unsigned char* ks_ = kst + m * 8192 + r * 128;
#pragma unroll
    for (int j = 0; j < 16; ++j) { c0[j] = 0.f; c1[j] = 0.f; }
#pragma unroll
    for (int sl = 0; sl < 4; ++sl) {
      const int o = ((sl * 2 + h) ^ sw) * 16;
      c0 = MFMA(*(const bf16x8*)(ks_ + o), qf[sl], c0);
      c1 = MFMA(*(const bf16x8*)(ks_ + 32 * 128 + o), qf[sl], c1);
    }
    float tm = fmaxf(c0[0], c1[0]);
#pragma unroll
    for (int j = 1; j < 16; ++j) tm = fmaxf(tm, fmaxf(c0[j], c1[j]));
    mrun = fmaxf(tm, __shfl_xor(tm, 32));
#pragma unroll
    for (int j = 0; j < 16; ++j) { c0[j] -= mrun; c1[j] -= mrun; }
  }
  float tmax = 0.f;
#define SB_() __builtin_amdgcn_sched_barrier(0)
  f32x16 n0, n1, ninit;
#pragma unroll
  for (int j = 0; j < 16; ++j) ninit[j] = -mrun;
  auto att_step = [&](f32x16& C0, f32x16& C1, f32x16& N0, f32x16& N1, const int kt, const int PAR) __attribute__((always_inline)) {
    const bool has1 = kt + 1 < ntiles, has2 = kt + 2 < ntiles;
    if (__any(tmax > 16.f)) {
      const float d = fmaxf(tmax, 0.f);
      const float alpha = __builtin_amdgcn_exp2f(-d);
      mrun += d;
      lrun *= alpha;
#pragma unroll
      for (int e = 0; e < 4; ++e)
#pragma unroll
        for (int j = 0; j < 16; ++j) O[e][j] *= alpha;
#pragma unroll
      for (int j = 0; j < 16; ++j) { C0[j] -= d; C1[j] -= d; ninit[j] = -mrun; }
    }
    if (has2) {
      const int k0 = (kt + 2) * 64;
      GLDS16(K1p + (size_t)k0 * 64 + koff, kst + PAR * 16384 + tid * 16);
      GLDS16(K2p + (size_t)k0 * 64 + koff, kst + PAR * 16384 + 8192 + tid * 16);
    }
    if (has1) {
      const int k0 = (kt + 1) * 64;
      GLDS16(Vp + k0 + voff0, vst + (PAR ^ 1) * 16384 + tid * 16);
      GLDS16(Vp + k0 + voff1, vst + (PAR ^ 1) * 16384 + 8192 + tid * 16);
    }
    const unsigned char* ks_ = kst + (PAR ^ 1) * 16384 + m * 8192 + r * 128;
    const unsigned char* vts = vst + PAR * 16384 + r * 128;
    bf16x8 kf[8], qf[4];
#pragma unroll
    for (int sl = 0; sl < 4; ++sl) {
      const int o = ((sl * 2 + h) ^ sw) * 16;
      kf[2 * sl] = *(const bf16x8*)(ks_ + o); kf[2 * sl + 1] = *(const bf16x8*)(ks_ + 32 * 128 + o);
      qf[sl] = *(const bf16x8*)(qrow + sl * 16);
    }
    SB_();
    N0 = MFMA(kf[0], qf[0], ninit);
    N1 = MFMA(kf[1], qf[0], ninit);
#pragma unroll
    for (int sl = 1; sl < 4; ++sl) { N0 = MFMA(kf[2 * sl], qf[sl], N0); N1 = MFMA(kf[2 * sl + 1], qf[sl], N1); }
    float psum = 0.f;
#pragma unroll
    for (int j = 0; j < 16; ++j) { C0[j] = __builtin_amdgcn_exp2f(C0[j]); psum += C0[j]; }
    bf16x8 pf[4];
#pragma unroll
    for (int q2 = 0; q2 < 2; ++q2) {
      u32x4 pk;
      pk[0] = pack2(C0[8 * q2 + 0], C0[8 * q2 + 1]); pk[1] = pack2(C0[8 * q2 + 2], C0[8 * q2 + 3]);
      pk[2] = pack2(C0[8 * q2 + 4], C0[8 * q2 + 5]); pk[3] = pack2(C0[8 * q2 + 6], C0[8 * q2 + 7]);
      pf[q2] = __builtin_bit_cast(bf16x8, pk);
    }
    SB_();
    bf16x8 vf[8];
#pragma unroll
    for (int q2 = 0; q2 < 2; ++q2)
#pragma unroll
      for (int e = 0; e < 4; ++e) vf[q2 * 4 + e] = *(const bf16x8*)(vts + e * 4096 + (((q2 * 2 + h) ^ sw) * 16));
    SB_();
#pragma unroll
    for (int q2 = 0; q2 < 2; ++q2)
#pragma unroll
      for (int e = 0; e < 4; ++e) O[e] = MFMA(vf[q2 * 4 + e], pf[q2], O[e]);
#pragma unroll
    for (int j = 0; j < 16; ++j) { C1[j] = __builtin_amdgcn_exp2f(C1[j]); psum += C1[j]; }
    lrun += psum;
#pragma unroll
    for (int q2 = 0; q2 < 2; ++q2) {
      u32x4 pk;
      pk[0] = pack2(C1[8 * q2 + 0], C1[8 * q2 + 1]); pk[1] = pack2(C1[8 * q2 + 2], C1[8 * q2 + 3]);
      pk[2] = pack2(C1[8 * q2 + 4], C1[8 * q2 + 5]); pk[3] = pack2(C1[8 * q2 + 6], C1[8 * q2 + 7]);
      pf[2 + q2] = __builtin_bit_cast(bf16x8, pk);
    }
    SB_();
#pragma unroll
    for (int q2 = 0; q2 < 2; ++q2)
#pragma unroll
      for (int e = 0; e < 4; ++e) vf[q2 * 4 + e] = *(const bf16x8*)(vts + e * 4096 + (((4 + q2 * 2 + h) ^ sw) * 16));
    SB_();
#pragma unroll
    for (int q2 = 0; q2 < 2; ++q2)
#pragma unroll
      for (int e = 0; e < 4; ++e) O[e] = MFMA(vf[q2 * 4 + e], pf[2 + q2], O[e]);
    {
      int mi = max(__builtin_bit_cast(int, N0[0]), __builtin_bit_cast(int, N1[0]));
#pragma unroll
      for (int j = 1; j < 16; ++j) mi = max(mi, max(__builtin_bit_cast(int, N0[j]), __builtin_bit_cast(int, N1[j])));
      mi = max(mi, __shfl_xor(mi, 32));
      tmax = __builtin_bit_cast(float, mi);
    }
    SB_();
    asm volatile("s_waitcnt vmcnt(0)" ::: "memory");
    __syncthreads();
  };
  for (int kt2 = 0; kt2 < ntiles; kt2 += 2) {
    att_step(c0, c1, n0, n1, kt2, 0);
    att_step(n0, n1, c0, c1, kt2 + 1, 1);
  }
#undef SB_
#undef GLDS16
  }
  const int tid_e = opaque_tid();
  const int lane = tid_e & 63, w = tid_e >> 6, r = lane & 31, h = lane >> 5, m = w & 1, wq = w >> 1;
  const int sq = qb * 128 + wq * 32 + r;
  const float lam = ((const float*)(P.ws + OFF_CNT))[1];
  const float lt = lrun + __shfl_xor(lrun, 32);
  float* xch = (float*)smem + wq * 4096;
  if (m == 1) {
    const float i2 = lam / lt;
#pragma unroll
    for (int e = 0; e < 4; ++e)
#pragma unroll
      for (int j = 0; j < 16; ++j) xch[(e * 16 + j) * 64 + lane] = O[e][j] * i2;
  }
  __syncthreads();
  if (m == 0) {
    const float i1 = 1.f / lt;
    float ssq = 0.f;
#pragma unroll
    for (int e = 0; e < 4; ++e)
#pragma unroll
      for (int j = 0; j < 16; ++j) { float a = O[e][j] * i1 - xch[(e * 16 + j) * 64 + lane]; O[e][j] = a; ssq += a * a; }
    ssq += __shfl_xor(ssq, 32);
    const float rstd = rsqrtf(ssq * (1.f / 128.f) + EPSN) * 0.8f;
    const size_t tok = (size_t)b * SS + sq;
    const u16* agp = (const u16*)(P.ws + OFF_AG) + tok * 512 + head * 128;
    u16* mixp = (u16*)(P.ws + OFF_XN) + tok * DM + 512 + head * 128;
    const float* sw = P.in[20];
#pragma unroll
    for (int e = 0; e < 4; ++e)
#pragma unroll
      for (int g = 0; g < 4; ++g) {
        const int e0 = e * 32 + 8 * g + 4 * h;
        u32x2 ag = *(const u32x2*)(agp + e0);
        float a0 = O[e][4 * g + 0] * rstd * sw[e0 + 0] * silu_f(bf2f((u16)(ag[0] & 0xffff)));
        float a1 = O[e][4 * g + 1] * rstd * sw[e0 + 1] * silu_f(bf2f((u16)(ag[0] >> 16)));
        float a2 = O[e][4 * g + 2] * rstd * sw[e0 + 2] * silu_f(bf2f((u16)(ag[1] & 0xffff)));
        float a3 = O[e][4 * g + 3] * rstd * sw[e0 + 3] * silu_f(bf2f((u16)(ag[1] >> 16)));
        u32x2 o; o[0] = pack2(a0, a1); o[1] = pack2(a2, a3);
        *(u32x2*)(mixp + e0) = o;
      }
  }
  __syncthreads();
}

__device__ __forceinline__ void phase_mixers(const Params& P, unsigned char* smem) {
  int* cnt = (int*)(P.ws + OFF_CNT);
  __shared__ int s_item;
  const int n_attl = NB * 4 * 128, n_hyl = 512, n_attc = NB * 4 * 2, n_hyc = 512;
  const int total = n_attl + n_hyl + n_attc + n_hyc;
  for (;;) {
    __syncthreads();
    if (threadIdx.x == 0) s_item = atomicAdd(cnt, 1);
    __syncthreads();
    int it = s_item;
    if (it >= total) break;
    const bool attc = (it >= n_attl + n_hyl) && (it < n_attl + n_hyl + n_attc);
    const bool attl = (it >= n_hyl) && (it < n_attl + n_hyl);
    if (attl || attc) {
      int bh = attc ? ((it - n_attl - n_hyl) >> 1) : (it - n_hyl) / 128;
      int qb = attc ? ((it - n_attl - n_hyl) & 1) : 2 + (it - n_hyl) % 128;
      for (int rep = 0; rep < ATT_REP; ++rep) attn_item(P, bh >> 2, bh & 3, qb, smem);
    }
#ifndef NO_HYL
    else if (it < n_hyl) hyena_latent_item(P, it, smem);
#endif
#ifndef NO_HYC
    else if (it >= n_attl + n_hyl + n_attc) hyena_ctx_item(P, it - n_attl - n_hyl - n_attc, smem);
#endif
  }
}

__device__ __forceinline__ void phase_hygate(const Params& P, unsigned char* smem) {
  const int tid = opaque_tid();
  float* tile = (float*)smem;
  const u16* hyt = (const u16*)(P.ws + OFF_HYT);
  const u16* hg = (const u16*)(P.ws + OFF_HG);
  u16* mix = (u16*)(P.ws + OFF_XN);
  for (int it = blockIdx.x; it < NB * 260 * 8; it += gridDim.x) {
    int ct = it & 7, stile = (it >> 3) % 260, b = it / (8 * 260);
    __syncthreads();
    {
      int ci = tid >> 3, sg = (tid & 7) * 8;
      u32x4 v = *(const u32x4*)(hyt + ((size_t)b * 1536 + ct * 64 + ci) * SS + stile * 64 + sg);
#pragma unroll
      for (int i = 0; i < 4; ++i) { tile[ci * 65 + sg + 2 * i] = bf2f((u16)(v[i] & 0xffff)); tile[ci * 65 + sg + 2 * i + 1] = bf2f((u16)(v[i] >> 16)); }
    }
    __syncthreads();
    {
      int si = tid >> 3, cg8 = (tid & 7) * 8;
      size_t tok = (size_t)b * SS + stile * 64 + si;
      u32x4 g = *(const u32x4*)(hg + tok * 512 + ct * 64 + cg8);
      u32x4 o;
#pragma unroll
      for (int i = 0; i < 4; ++i) {
        float a0 = tile[(cg8 + 2 * i) * 65 + si] * silu_f(bf2f((u16)(g[i] & 0xffff)));
        float a1 = tile[(cg8 + 2 * i + 1) * 65 + si] * silu_f(bf2f((u16)(g[i] >> 16)));
        o[i] = pack2(a0, a1);
      }
      *(u32x4*)(mix + tok * DM + ct * 64 + cg8) = o;
    }
  }
}

__device__ __forceinline__ void phase_conv(const Params& P, bool do_store) {
  const int tid = opaque_tid();
  u16* xbc = (u16*)(P.ws + OFF_XBC);
  const u16* halo = (const u16*)(P.ws + OFF_HALO);
  const float* cw = P.in[22]; const float* cb = P.in[23];
  for (int it = blockIdx.x; it < 260 * 16; it += gridDim.x) {
    const int tile = it >> 4, chunk = it & 15;
    const int sub = tid >> 5, cg8 = tid & 31;
    const int ch = chunk * 256 + cg8 * 8;
    const int row0 = tile * 128 + sub * 8;
    const int s_first = (tile * 128) % SS;
    u32x4 rows[10];
    u32 zz = 0; asm volatile("" : "+v"(zz));
    __syncthreads();
#pragma unroll
    for (int i = 0; i < 10; ++i) {
      int row = row0 - 1 + i;
      u32x4 v = {zz, zz, zz, zz};
      if (row < tile * 128) {
        if (!(s_first == 0 || s_first == CT)) v = *(const u32x4*)(halo + ((size_t)(tile - 1) * 2 + 1) * 4096 + ch);
      } else if (row >= tile * 128 + 128) {
        int s_last = s_first + 127;
        if (!(s_last == CT - 1 || s_last == SS - 1)) v = *(const u32x4*)(halo + ((size_t)(tile + 1) * 2 + 0) * 4096 + ch);
      } else v = *(const u32x4*)(xbc + (size_t)row * 4096 + ch);
      rows[i] = v;
    }
    __syncthreads();
    float w0[8], w1[8], w2[8], bb[8];
#pragma unroll
    for (int e = 0; e < 8; ++e) { w0[e] = cw[ch + e]; w1[e] = cw[4096 + ch + e]; w2[e] = cw[8192 + ch + e]; bb[e] = cb[ch + e]; }
#pragma unroll
    for (int i = 0; i < 8; ++i) {
      u32x4 o;
#pragma unroll
      for (int e2 = 0; e2 < 4; ++e2) {
        float r[2];
#pragma unroll
        for (int p = 0; p < 2; ++p) {
          int e = e2 * 2 + p;
          u32 a = rows[i][e2], bq = rows[i + 1][e2], cq = rows[i + 2][e2];
          float xa = p ? bf2f((u16)(a >> 16)) : bf2f((u16)(a & 0xffff));
          float xb = p ? bf2f((u16)(bq >> 16)) : bf2f((u16)(bq & 0xffff));
          float xc = p ? bf2f((u16)(cq >> 16)) : bf2f((u16)(cq & 0xffff));
          r[p] = silu_f(w0[e] * xa + w1[e] * xb + w2[e] * xc + bb[e]);
        }
        o[e2] = pack2(r[0], r[1]);
      }
      if (do_store) *(u32x4*)(xbc + (size_t)(row0 + i) * 4096 + ch) = o;
    }
  }
}

__device__ __forceinline__ void wave_scan4(float a[4], float& total) {
  a[1] += a[0]; a[2] += a[1]; a[3] += a[2];
  float t = a[3];
  const int lane = threadIdx.x & 63;
#pragma unroll
  for (int o = 1; o < 64; o <<= 1) { float u = __shfl_up(t, o); if (lane >= o) t += u; }
  float excl = t - a[3];
  a[0] += excl; a[1] += excl; a[2] += excl; a[3] += excl;
  total = __shfl(t, 63);
}

constexpr int XP = 136;

__device__ __forceinline__ void stage_xt(const u16* __restrict__ xbc, size_t tok0, int g, u16* XT) {
  const int tid_ = opaque_tid(); const int lane = tid_ & 63, w = tid_ >> 6;
  const int tg = w & 1, hh = w >> 1;
  const int s = tg * 64 + lane;
  const u16* src = xbc + (tok0 + s) * 4096 + g * 256 + hh * 64;
#pragma unroll
  for (int it = 0; it < 8; ++it) {
    u32x4 v = *(const u32x4*)(src + it * 8);
#pragma unroll
    for (int i = 0; i < 4; ++i) {
      XT[(hh * 64 + it * 8 + 2 * i) * XP + s] = (u16)(v[i] & 0xffff);
      XT[(hh * 64 + it * 8 + 2 * i + 1) * XP + s] = (u16)(v[i] >> 16);
    }
  }
}
__device__ __forceinline__ void stage_rows(const u16* __restrict__ xbc, size_t tok0, int coloff, u16* R) {
  const int tid = opaque_tid();
#pragma unroll
  for (int i = 0; i < 4; ++i) {
    int id = tid + i * NT;
    int s = id >> 4, c8 = (id & 15) * 8;
    *(u32x4*)(R + s * XP + c8) = *(const u32x4*)(xbc + (tok0 + s) * 4096 + coloff + c8);
  }
}

__device__ __forceinline__ void phase_ssd1(const Params& P, unsigned char* smem) {
  const int tid = opaque_tid(), lane = tid & 63, w = tid >> 6;
  const int r = lane & 31, h = lane >> 5;
  u16* XT = (u16*)smem;
  u16* BT = XT + 256 * XP;
  float* wgt = (float*)(BT + 128 * XP);
  const u16* xbc = (const u16*)(P.ws + OFF_XBC);
  const float* dt = (const float*)(P.ws + OFF_DT);
  float* dec = (float*)(P.ws + OFF_DEC);
  const int dir = w >> 2, hh = w & 3;
  for (int it = blockIdx.x; it < NB * 65 * 8; it += gridDim.x) {
    const int g = it & 7, c = (it >> 3) % 65, b = it / (8 * 65);
    const int head = g * 4 + hh;
    const size_t tok0 = (size_t)b * SS + (size_t)c * 256;
    const float Ah = -expf(P.in[25][dir * 32 + head]);
    __syncthreads();
    {
      float a[4], d4[4], tot;
#pragma unroll
      for (int i = 0; i < 4; ++i) { d4[i] = dt[(tok0 + lane * 4 + i) * 64 + dir * 32 + head]; a[i] = d4[i] * Ah; }
      float a_raw[4] = {a[0], a[1], a[2], a[3]};
      wave_scan4(a, tot);
#pragma unroll
      for (int i = 0; i < 4; ++i) {
        float te = (dir == 0) ? __expf(tot - a[i]) : __expf(a[i] - a_raw[i]);
        wgt[w * 256 + lane * 4 + i] = d4[i] * te;
      }
      if (lane == 0) dec[((dir * 2 + b) * 65 + c) * 32 + head] = __expf(tot);
    }
    f32x16 acc[2][4];
#pragma unroll
    for (int i = 0; i < 2; ++i)
#pragma unroll
      for (int j = 0; j < 4; ++j)
#pragma unroll
        for (int e = 0; e < 16; ++e) acc[i][j][e] = 0.f;
    for (int half = 0; half < 2; ++half) {
      __syncthreads();
      stage_xt(xbc, tok0 + half * 128, g, XT);
      {
        const int tg = w & 1, nq = w >> 1;
        const int s = tg * 64 + lane;
        const u16* src = xbc + (tok0 + half * 128 + s) * 4096 + 2048 + g * 128 + nq * 32;
#pragma unroll
        for (int i4 = 0; i4 < 4; ++i4) {
          u32x4 v = *(const u32x4*)(src + i4 * 8);
#pragma unroll
          for (int i = 0; i < 4; ++i) {
            BT[(nq * 32 + i4 * 8 + 2 * i) * XP + s] = (u16)(v[i] & 0xffff);
            BT[(nq * 32 + i4 * 8 + 2 * i + 1) * XP + s] = (u16)(v[i] >> 16);
          }
        }
      }
      __syncthreads();
#pragma unroll 2
      for (int sl = 0; sl < 8; ++sl) {
        const float* wp = wgt + w * 256 + half * 128 + sl * 16 + h * 8;
        float wv[8];
#pragma unroll
        for (int j = 0; j < 8; ++j) wv[j] = wp[j];
        bf16x8 af[2];
#pragma unroll
        for (int pt = 0; pt < 2; ++pt) {
          u32x4 xv = *(const u32x4*)(XT + (hh * 64 + pt * 32 + r) * XP + sl * 16 + h * 8);
          u32x4 sv;
#pragma unroll
          for (int i = 0; i < 4; ++i)
            sv[i] = pack2(bf2f((u16)(xv[i] & 0xffff)) * wv[2 * i], bf2f((u16)(xv[i] >> 16)) * wv[2 * i + 1]);
          af[pt] = __builtin_bit_cast(bf16x8, sv);
        }
#pragma unroll
        for (int nt = 0; nt < 4; ++nt) {
          bf16x8 bfr = *(const bf16x8*)(BT + (nt * 32 + r) * XP + sl * 16 + h * 8);
#pragma unroll
          for (int pt = 0; pt < 2; ++pt) acc[pt][nt] = MFMA(af[pt], bfr, acc[pt][nt]);
        }
      }
    }
    u16* G = (c == 0) ? ((u16*)(P.ws + OFF_GCTX) + (size_t)((dir * 2 + b) * 32 + head) * 8192)
                      : ((u16*)P.out + ((size_t)((dir * 2 + b) * 64 + (c - 1)) * 32 + head) * 8192);
#pragma unroll
    for (int pt = 0; pt < 2; ++pt)
#pragma unroll
      for (int nt = 0; nt < 4; ++nt)
#pragma unroll
        for (int j = 0; j < 16; ++j) {
          int p = pt * 32 + (j & 3) + 8 * (j >> 2) + 4 * h;
          G[p * 128 + nt * 32 + r] = f2bf(acc[pt][nt][j]);
        }
  }
}

__device__ __forceinline__ void phase_scan(const Params& P, bool do_store) {
  const float* dec = (const float*)(P.ws + OFF_DEC);
  const u16* gctx = (const u16*)(P.ws + OFF_GCTX);
  u16* st = (u16*)P.out;
  for (int v = blockIdx.x * NT + opaque_tid(); v < 131072; v += gridDim.x * NT) {
    const int pn8 = v & 1023, hd = (v >> 10) & 31, db = v >> 15;
    const int dir = db >> 1;
    float S[8];
    {
      u32x4 gv = *(const u32x4*)(gctx + ((size_t)db * 32 + hd) * 8192 + pn8 * 8);
#pragma unroll
      for (int i = 0; i < 4; ++i) { S[2 * i] = bf2f((u16)(gv[i] & 0xffff)); S[2 * i + 1] = bf2f((u16)(gv[i] >> 16)); }
    }
    u16* base = st + ((size_t)db * 64 * 32 + hd) * 8192 + pn8 * 8;
    const float* dbase = dec + (db * 65 + 1) * 32 + hd;
    for (int k0 = 0; k0 < 64; k0 += 8) {
      u32x4 gv[8]; float dd[8];
#pragma unroll
      for (int u = 0; u < 8; ++u) {
        const int ci = (dir == 0) ? (k0 + u) : 63 - (k0 + u);
        gv[u] = *(const u32x4*)(base + (size_t)ci * 32 * 8192);
        dd[u] = dbase[ci * 32];
      }
#pragma unroll
      for (int u = 0; u < 8; ++u) {
        const int ci = (dir == 0) ? (k0 + u) : 63 - (k0 + u);
        u32x4 sv;
#pragma unroll
        for (int i = 0; i < 4; ++i) sv[i] = pack2(S[2 * i], S[2 * i + 1]);
        if (do_store) *(u32x4*)(base + (size_t)ci * 32 * 8192) = sv;
#pragma unroll
        for (int i = 0; i < 4; ++i) {
          S[2 * i] = dd[u] * S[2 * i] + bf2f((u16)(gv[u][i] & 0xffff));
          S[2 * i + 1] = dd[u] * S[2 * i + 1] + bf2f((u16)(gv[u][i] >> 16));
        }
      }
    }
  }
}

__device__ __forceinline__ void phase_ssd3(const Params& P, unsigned char* smem, bool do_store) {
  const int tid = opaque_tid(), lane = tid & 63, w = tid >> 6;
  const int r = lane & 31, h = lane >> 5;
  u16* CS = (u16*)smem;
  u16* BS = CS + 128 * XP;
  u16* XT = BS + 128 * XP;
  float* cum = (float*)(XT + 256 * XP);
  float* dtl = cum + 8 * 256;
  float* red = (float*)BS;
  const u16* xbc = (const u16*)(P.ws + OFF_XBC);
  const float* dt = (const float*)(P.ws + OFF_DT);
  const u16* states = (const u16*)P.out;
  u16* zb = (u16*)(P.ws + OFF_ZB);
  const int hh = w & 3, lh = w >> 2;
  for (int it = blockIdx.x; it < NB * 128 * 8; it += gridDim.x) {
    const int g = it & 7, rblk = (it >> 3) & 127, b = it >> 10;
    const int c = rblk >> 1, rb = rblk & 1;
    const size_t tokc = (size_t)b * SS + CT + (size_t)c * 256;
    const int head = g * 4 + hh;
    __syncthreads();
    {
      const int dir = w >> 2;
      const int hd = g * 4 + (w & 3);
      const float Ah = -expf(P.in[25][dir * 32 + hd]);
      float a[4], d4[4], tot;
#pragma unroll
      for (int i = 0; i < 4; ++i) { d4[i] = dt[(tokc + lane * 4 + i) * 64 + dir * 32 + hd]; a[i] = d4[i] * Ah; }
      float a_raw[4] = {a[0], a[1], a[2], a[3]};
      wave_scan4(a, tot);
#pragma unroll
      for (int i = 0; i < 4; ++i) {
        cum[w * 256 + lane * 4 + i] = (dir == 0) ? a[i] : (tot - a[i] + a_raw[i]);
        dtl[w * 256 + lane * 4 + i] = d4[i];
      }
    }
    stage_rows(xbc, tokc + rb * 128, 3072 + g * 128, CS);
    __syncthreads();
    f32x16 acc[2][2];
#pragma unroll
    for (int i = 0; i < 2; ++i)
#pragma unroll
      for (int j = 0; j < 2; ++j)
#pragma unroll
        for (int e = 0; e < 16; ++e) acc[i][j][e] = 0.f;
#pragma unroll 1
    for (int dir = 0; dir < 2; ++dir) {
      const u16* Sp = states + (((size_t)(dir * 2 + b) * 64 + c) * 32 + head) * 8192;
      f32x16 tmp[2][2];
#pragma unroll
      for (int i = 0; i < 2; ++i)
#pragma unroll
        for (int j = 0; j < 2; ++j)
#pragma unroll
          for (int e = 0; e < 16; ++e) tmp[i][j][e] = 0.f;
#pragma unroll
      for (int sb4 = 0; sb4 < 2; ++sb4) {
        bf16x8 sf[4][2];
#pragma unroll
        for (int s4 = 0; s4 < 4; ++s4)
#pragma unroll
          for (int pt = 0; pt < 2; ++pt) sf[s4][pt] = *(const bf16x8*)(Sp + (pt * 32 + r) * 128 + (sb4 * 4 + s4) * 16 + h * 8);
        __builtin_amdgcn_sched_barrier(0);
#pragma unroll
        for (int s4 = 0; s4 < 4; ++s4) {
          bf16x8 cf[2];
#pragma unroll
          for (int li = 0; li < 2; ++li) cf[li] = *(const bf16x8*)(CS + ((lh * 2 + li) * 32 + r) * XP + (sb4 * 4 + s4) * 16 + h * 8);
#pragma unroll
          for (int pt = 0; pt < 2; ++pt)
#pragma unroll
            for (int li = 0; li < 2; ++li) tmp[pt][li] = MFMA(sf[s4][pt], cf[li], tmp[pt][li]);
        }
      }
#pragma unroll
      for (int li = 0; li < 2; ++li) {
        const float sc = __expf(cum[(dir * 4 + hh) * 256 + rb * 128 + (lh * 2 + li) * 32 + r]);
#pragma unroll
        for (int pt = 0; pt < 2; ++pt)
#pragma unroll
          for (int e = 0; e < 16; ++e) acc[pt][li][e] += tmp[pt][li][e] * sc;
      }
    }
#pragma unroll 1
    for (int sb = 0; sb < 2; ++sb) {
      __syncthreads();
      stage_rows(xbc, tokc + sb * 128, 2048 + g * 128, BS);
      stage_xt(xbc, tokc + sb * 128, g, XT);
      __syncthreads();
#pragma unroll 1
      for (int st = 0; st < 4; ++st) {
#pragma unroll
        for (int li = 0; li < 2; ++li) {
          const int lt = lh * 2 + li;
          const bool needf = (sb < rb) || (sb == rb && st <= lt);
          const bool needb = (sb > rb) || (sb == rb && st >= lt);
          if (!needf && !needb) continue;
          f32x16 cbt;
#pragma unroll
          for (int e = 0; e < 16; ++e) cbt[e] = 0.f;
#pragma unroll
          for (int sl = 0; sl < 8; ++sl) {
            bf16x8 bfr = *(const bf16x8*)(BS + (st * 32 + r) * XP + sl * 16 + h * 8);
            bf16x8 cfr = *(const bf16x8*)(CS + (lt * 32 + r) * XP + sl * 16 + h * 8);
            cbt = MFMA(bfr, cfr, cbt);
          }
          const int lidx = rb * 128 + lt * 32 + r;
#pragma unroll 1
          for (int dir = 0; dir < 2; ++dir) {
            if (dir == 0 ? !needf : !needb) continue;
            const float* cu = cum + (dir * 4 + hh) * 256;
            const float* dl = dtl + (dir * 4 + hh) * 256;
            const float cl = cu[lidx];
            float mv[16];
#pragma unroll
            for (int j = 0; j < 16; ++j) {
              const int sidx = sb * 128 + st * 32 + (j & 3) + 8 * (j >> 2) + 4 * h;
              const bool valid = (dir == 0) ? (sidx <= lidx) : (sidx >= lidx);
              const float e = __expf(fminf(cl - cu[sidx], 0.f));
              mv[j] = valid ? cbt[j] * e * dl[sidx] : 0.f;
            }
#pragma unroll
            for (int q2 = 0; q2 < 2; ++q2) {
              u32x4 pk;
#pragma unroll
              for (int i = 0; i < 4; ++i) pk[i] = pack2(mv[8 * q2 + 2 * i], mv[8 * q2 + 2 * i + 1]);
              bf16x8 mf = __builtin_bit_cast(bf16x8, pk);
              const int kb = st * 32 + q2 * 16 + 4 * h;
#pragma unroll
              for (int pt = 0; pt < 2; ++pt) {
                u32x2 lo = *(const u32x2*)(XT + (hh * 64 + pt * 32 + r) * XP + kb);
                u32x2 hi = *(const u32x2*)(XT + (hh * 64 + pt * 32 + r) * XP + kb + 8);
                u32x4 vv; vv[0] = lo[0]; vv[1] = lo[1]; vv[2] = hi[0]; vv[3] = hi[1];
                acc[pt][li] = MFMA(__builtin_bit_cast(bf16x8, vv), mf, acc[pt][li]);
              }
            }
          }
        }
      }
    }
    __syncthreads();
    const float Dsum = P.in[26][head] + P.in[26][32 + head];
    float ssq[2] = {0.f, 0.f};
#pragma unroll
    for (int li = 0; li < 2; ++li) {
      const int l = rb * 128 + (lh * 2 + li) * 32 + r;
      const size_t tok = tokc + l;
      const size_t zrow = ((size_t)b * LL + (size_t)c * 256 + l) * 2048 + head * 64;
#pragma unroll
      for (int pt = 0; pt < 2; ++pt)
#pragma unroll
        for (int gq = 0; gq < 4; ++gq) {
          const int p0 = pt * 32 + 8 * gq + 4 * h;
          u32x2 xv = *(const u32x2*)(xbc + tok * 4096 + head * 64 + p0);
          u32x2 zv = *(const u32x2*)(zb + zrow + p0);
          float xs[4] = {bf2f((u16)(xv[0] & 0xffff)), bf2f((u16)(xv[0] >> 16)), bf2f((u16)(xv[1] & 0xffff)), bf2f((u16)(xv[1] >> 16))};
          float zs[4] = {bf2f((u16)(zv[0] & 0xffff)), bf2f((u16)(zv[0] >> 16)), bf2f((u16)(zv[1] & 0xffff)), bf2f((u16)(zv[1] >> 16))};
#pragma unroll
          for (int i = 0; i < 4; ++i) {
            float y = (acc[pt][li][4 * gq + i] + Dsum * xs[i]) * silu_f(zs[i]);
            acc[pt][li][4 * gq + i] = y;
            ssq[li] += y * y;
          }
        }
      ssq[li] += __shfl_xor(ssq[li], 32);
      if (h == 0) red[hh * 128 + (lh * 2 + li) * 32 + r] = ssq[li];
    }
    __syncthreads();
    const float* gw = P.in[27];
#pragma unroll
    for (int li = 0; li < 2; ++li) {
      const int ll = (lh * 2 + li) * 32 + r;
      const float tot = red[ll] + red[128 + ll] + red[256 + ll] + red[384 + ll];
      const float rstd = rsqrtf(tot * (1.f / 256.f) + EPSN);
      const int l = rb * 128 + ll;
      const size_t zrow = ((size_t)b * LL + (size_t)c * 256 + l) * 2048 + head * 64;
#pragma unroll
      for (int pt = 0; pt < 2; ++pt)
#pragma unroll
        for (int gq = 0; gq < 4; ++gq) {
          const int p0 = pt * 32 + 8 * gq + 4 * h;
          const float* gp = gw + head * 64 + p0;
          u32x2 o;
          o[0] = pack2(acc[pt][li][4 * gq + 0] * rstd * gp[0], acc[pt][li][4 * gq + 1] * rstd * gp[1]);
          o[1] = pack2(acc[pt][li][4 * gq + 2] * rstd * gp[2], acc[pt][li][4 * gq + 3] * rstd * gp[3]);
          if (do_store) *(u32x2*)(zb + zrow + p0) = o;
        }
    }
  }
}

__device__ __forceinline__ void phase_final(const Params& P) {
  const int tid_ = opaque_tid(); const int lane = tid_ & 63, wv = tid_ >> 6;
  const float* nw = P.in[29];
  for (int it = blockIdx.x; it < NB * LL / 8; it += gridDim.x) {
    float* row = P.out + (size_t)(it * 8 + wv) * DM;
    float4 v[4];
    float ss = 0.f;
#pragma unroll
    for (int i = 0; i < 4; ++i) {
      v[i] = *(const float4*)(row + i * 256 + lane * 4);
      ss += v[i].x * v[i].x + v[i].y * v[i].y + v[i].z * v[i].z + v[i].w * v[i].w;
    }
    ss = wave_sum(ss);
    float rstd = rsqrtf(ss * (1.f / DM) + EPSN);
#pragma unroll
    for (int i = 0; i < 4; ++i) {
      float4 w = *(const float4*)(nw + i * 256 + lane * 4);
      float4 o = make_float4(v[i].x * rstd * w.x, v[i].y * rstd * w.y, v[i].z * rstd * w.z, v[i].w * rstd * w.w);
      *(float4*)(row + i * 256 + lane * 4) = o;
    }
  }
}


#define XB_TMO      128
#define XB_XCNT(j)  (256  + 64 * (j))
#define XB_XSUB(j)  (1280 + 64 * (j))
#define XB_XGEN(j)  (2304 + 64 * (j))
#define XB_TOP      3328
#define XB_TOPGEN   3392
#define XCD_BAR_WORDS 3456
#define XB_SPIN_CAP (1u << 18)
#define LAS __attribute__((address_space(3)))
__device__ __forceinline__ unsigned xb_ld(unsigned* p)              { return __hip_atomic_load(p, __ATOMIC_RELAXED, __HIP_MEMORY_SCOPE_AGENT); }
__device__ __forceinline__ unsigned xb_add(unsigned* p, unsigned v) { return __hip_atomic_fetch_add(p, v, __ATOMIC_RELAXED, __HIP_MEMORY_SCOPE_AGENT); }
__device__ __forceinline__ unsigned xb_xcc_id() { return (unsigned)__builtin_amdgcn_s_getreg((3 << 11) | 20) & 0xFu; }
#define XB_SPIN(cond, bar) do { unsigned _sp = 0; while (cond) { __builtin_amdgcn_s_sleep(1); \
    if ((++_sp & 255u) == 0u) { if (xb_ld(&(bar)[XB_TMO])) break; if (_sp > XB_SPIN_CAP) { atomicAdd(&(bar)[XB_TMO], 1u); break; } } } } while (0)
struct XcdBarrier { unsigned* bar; unsigned x; volatile LAS unsigned* st; };
__device__ __forceinline__ XcdBarrier xcd_barrier_post(unsigned* bar, volatile LAS unsigned* st) {
  XcdBarrier b; b.bar = bar; b.x = xb_xcc_id(); b.st = st;
  if (threadIdx.x == 0) (void)xb_add(&bar[XB_XCNT(b.x)], 1u);
  return b;
}
__device__ __forceinline__ void xcd_barrier_complete(unsigned* bar, unsigned x, unsigned& nloc, unsigned& nx) {
  const unsigned G = gridDim.x * gridDim.y * gridDim.z;
  unsigned sum, cnt, mine, sp = 0u;
  for (;;) {
    sum = 0u; cnt = 0u; mine = 0u;
#pragma unroll
    for (unsigned j = 0; j < 16; ++j) { const unsigned c = xb_ld(&bar[XB_XCNT(j)]); sum += c; cnt += (c > 0u) ? 1u : 0u; mine = (j == x) ? c : mine; }
    if (sum == G) break;
    __builtin_amdgcn_s_sleep(1);
    if ((++sp & 255u) == 0u) { if (xb_ld(&bar[XB_TMO])) break; if (sp > XB_SPIN_CAP) { atomicAdd(&bar[XB_TMO], 1u); break; } }
  }
  nloc = mine > 0u ? mine : 1u; nx = cnt > 0u ? cnt : 1u;
}
__device__ __forceinline__ void xcd_barrier(const XcdBarrier& b) {
  asm volatile("s_waitcnt vmcnt(0)" ::: "memory");
  __syncthreads();
  if (threadIdx.x == 0) {
    unsigned* bar = b.bar;
    __builtin_amdgcn_s_waitcnt(0);
    unsigned nloc = b.st[0], nx = b.st[1];
    if (nloc == 0u) { xcd_barrier_complete(bar, b.x, nloc, nx); b.st[0] = nloc; b.st[1] = nx; }
    const unsigned old = xb_add(&bar[XB_XSUB(b.x)], 1u);
    const unsigned gen = old / nloc;
    if (old + 1u == (gen + 1u) * nloc) {
      __builtin_amdgcn_fence(__ATOMIC_RELEASE, "agent");
      asm volatile("s_waitcnt vmcnt(0)" ::: "memory");
      const unsigned og = xb_add(&bar[XB_TOP], 1u);
      const unsigned tg = og / nx;
      if (og + 1u == (tg + 1u) * nx) xb_add(&bar[XB_TOPGEN], 1u);
      else XB_SPIN(xb_ld(&bar[XB_TOPGEN]) == tg, bar);
      __builtin_amdgcn_fence(__ATOMIC_ACQUIRE, "agent");
      xb_add(&bar[XB_XGEN(b.x)], 1u);
      asm volatile("s_waitcnt vmcnt(0)" ::: "memory");
    } else {
      XB_SPIN(xb_ld(&bar[XB_XGEN(b.x)]) == gen, bar);
      __builtin_amdgcn_fence(__ATOMIC_ACQUIRE, "agent");
      asm volatile("s_waitcnt vmcnt(0)" ::: "memory");
    }
  }
  __syncthreads();
}

__global__ void __launch_bounds__(NT) fwd_kernel(Params P) {
  extern __shared__ __attribute__((aligned(16))) unsigned char smem[];
  __shared__ uint4 xb_words;
  if (threadIdx.x == 0) xb_words = make_uint4(0u, 0u, 0u, 0u);
  __syncthreads();
  XcdBarrier xb = xcd_barrier_post((unsigned*)(P.ws + OFF_BAR), (volatile LAS unsigned*)&xb_words);
  for (int ph = P.ph_lo; ph < P.ph_hi; ++ph) {
    switch (ph) {
#if !defined(PHASE_ONLY) || PHASE_ONLY == 0
      case 0: for (int rep = 0; rep < MISC_REP; ++rep) phase_prep(P, smem); break;
#endif
#if !defined(PHASE_ONLY) || PHASE_ONLY == 1
      case 1: for (int rep = 0; rep < MISC_REP; ++rep) { phase_norm(P, 0, (u16*)(P.ws + OFF_XN)); phase_filter(P, smem); } break;
#endif
#if !defined(PHASE_ONLY) || PHASE_ONLY == 2
      case 2: for (int rep = 0; rep < GEMM_REP; ++rep) gemm_phase<0>(P, (const u16*)(P.ws + OFF_XN), DM, (const u16*)(P.ws + OFF_WEIN), DM, DM, NTOK / 256, 16, smem); break;
#endif
#if !defined(PHASE_ONLY) || PHASE_ONLY == 3
      case 3: phase_mixers(P, smem); break;
#endif
#if !defined(PHASE_ONLY) || PHASE_ONLY == 4
      case 4: phase_hygate(P, smem); break;
#endif
#if !defined(PHASE_ONLY) || PHASE_ONLY == 5
      case 5: for (int rep = 0; rep < GEMM_REP; ++rep) gemm_phase<1>(P, (const u16*)(P.ws + OFF_XN), DM, (const u16*)(P.ws + OFF_WEOUT), DM, DM, NTOK / 256, 4, smem); break;
#endif
#if !defined(PHASE_ONLY) || PHASE_ONLY == 6
      case 6: phase_norm(P, 1, (u16*)P.out); break;
#endif
#if !defined(PHASE_ONLY) || PHASE_ONLY == 7
      case 7: for (int rep = 0; rep < GEMM_REP; ++rep) gemm_phase<2>(P, (const u16*)P.out, DM, (const u16*)(P.ws + OFF_WOIN), DM, DM, NTOK / 256, 25, smem); break;
#endif
#if !defined(PHASE_ONLY) || PHASE_ONLY == 8
      case 8: for (int rep = 0; rep < TAIL_REP; ++rep) phase_conv(P, rep == TAIL_REP - 1); break;
#endif
#if !defined(PHASE_ONLY) || PHASE_ONLY == 9
      case 9: for (int rep = 0; rep < SSD1_REP; ++rep) phase_ssd1(P, smem); break;
#endif
#if !defined(PHASE_ONLY) || PHASE_ONLY == 10
      case 10: for (int rep = 0; rep < TAIL_REP; ++rep) phase_scan(P, rep == TAIL_REP - 1); break;
#endif
#if !defined(PHASE_ONLY) || PHASE_ONLY == 11
      case 11: for (int rep = 0; rep < TAIL_REP; ++rep) phase_ssd3(P, smem, rep == TAIL_REP - 1); break;
#endif
#if !defined(PHASE_ONLY) || PHASE_ONLY == 12
      case 12: for (int rep = 0; rep < GEMM_REP; ++rep) gemm_phase<3>(P, (const u16*)(P.ws + OFF_ZB), 2048, (const u16*)(P.ws + OFF_WOOUT), 2048, 2048, NB * LL / 256, 4, smem); break;
#endif
#if !defined(PHASE_ONLY) || PHASE_ONLY == 13
      case 13: phase_final(P); break;
#endif
    }
    if (ph + 1 < P.ph_hi) {
      if (P.ph_lo < 0) cg::this_grid().sync();
      xcd_barrier(xb);
    }
  }
}

extern "C" void kernel_launch(void* const* d_in, const int* in_sizes, int n_in, void* d_out, int out_size,
                              void* d_ws, size_t ws_size, hipStream_t stream) {
  static int grid = 0;
  if (grid == 0) {
    if (n_in != 30 || ws_size < OFF_END) { fprintf(stderr, "kernel_launch: unexpected n_in %d / ws %zu\n", n_in, ws_size); grid = -1; return; }
    int dev = 0, cus = 0, per_cu = 0;
    hipGetDevice(&dev);
    hipDeviceGetAttribute(&cus, hipDeviceAttributeMultiprocessorCount, dev);
    if (hipFuncSetAttribute((const void*)fwd_kernel, hipFuncAttributeMaxDynamicSharedMemorySize, LDS_BYTES) != hipSuccess) {
      fprintf(stderr, "kernel_launch: hipFuncSetAttribute failed\n"); grid = -1; return; }
    hipOccupancyMaxActiveBlocksPerMultiprocessor(&per_cu, (const void*)fwd_kernel, NT, LDS_BYTES);
    if (per_cu < 1) { fprintf(stderr, "kernel_launch: occupancy query says %d\n", per_cu); per_cu = 1; }
    (void)hipGetLastError();
    grid = cus * 1;
  }
  if (grid < 0) return;
  Params p{};
  for (int i = 0; i < 30; ++i) p.in[i] = (const float*)d_in[i];
  p.out = (float*)d_out;
  p.ws = (unsigned char*)d_ws;
#if ONE_LAUNCH
  (void)hipMemsetAsync((unsigned char*)d_ws + OFF_BAR, 0, XCD_BAR_WORDS * 4, stream);
  p.ph_lo = 0; p.ph_hi = NPH;
  void* args[] = {&p};
  hipError_t e = hipLaunchCooperativeKernel((const void*)fwd_kernel, dim3(grid), dim3(NT), args, LDS_BYTES, stream);
  if (e != hipSuccess) fprintf(stderr, "cooperative launch failed: %s (grid %d)\n", hipGetErrorString(e), grid);
#else
  for (int ph = 0; ph < NPH; ++ph) {
    p.ph_lo = ph; p.ph_hi = ph + 1;
    hipLaunchKernelGGL(fwd_kernel, dim3(grid), dim3(NT), LDS_BYTES, stream, p);
  }
#endif
}
```

```cpp
#include <hip/hip_runtime.h>
#include <hip/hip_cooperative_groups.h>
#include <cstdio>
#include <cstdint>
namespace cg = cooperative_groups;

#ifndef ONE_LAUNCH
#define ONE_LAUNCH 1
#endif

typedef unsigned short u16;
typedef unsigned int u32;
using bf16x8 = __attribute__((ext_vector_type(8))) short;
using s16x4  = __attribute__((ext_vector_type(4))) short;
using f32x16 = __attribute__((ext_vector_type(16))) float;
using u32x4  = __attribute__((ext_vector_type(4))) unsigned;
using u32x2  = __attribute__((ext_vector_type(2))) unsigned;

#ifndef ATT_REP
#define ATT_REP 1
#endif
#ifndef HYL_REP
#define HYL_REP 1
#endif
#ifndef GEMM_REP
#define GEMM_REP 1
#endif
#ifndef MISC_REP
#define MISC_REP 1
#endif
#ifndef TAIL_REP
#define TAIL_REP 2
#endif
#ifndef SSD1_REP
#define SSD1_REP 1
#endif
#define NT 512
constexpr int DM = 1024;
constexpr int NB = 2;
constexpr int LL = 16384;
constexpr int CT = 256;
constexpr int SS = LL + CT;
constexpr int NTOK = NB * SS;
constexpr float EPSN = 1e-6f;
constexpr int NPH = 14;

constexpr size_t MiB = 1048576;
constexpr size_t OFF_WEIN = 0, OFF_WEOUT = 8 * MiB, OFF_WOIN = 10 * MiB, OFF_WOOUT = 23 * MiB;
constexpr size_t OFF_MODS = 27 * MiB;
constexpr size_t OFF_CNT = 27 * MiB + 128 * 1024;
constexpr size_t OFF_ROPE = 27 * MiB + 160 * 1024;
constexpr size_t OFF_DEC = 27 * MiB + 256 * 1024;
constexpr size_t OFF_BAR = 27 * MiB + 768 * 1024;
constexpr size_t OFF_H2 = 28 * MiB;
constexpr size_t OFF_KRAW256 = 33 * MiB;
constexpr size_t OFF_GCTX = 35 * MiB;
constexpr size_t OFF_BIG = 37 * MiB;
constexpr size_t SZ_HYT = (size_t)NB * 1536 * SS * 2;
constexpr size_t SZ_TOK512 = (size_t)NTOK * 512 * 2;
constexpr size_t OFF_HYT = OFF_BIG, OFF_HG = OFF_HYT + SZ_HYT, OFF_AG = OFF_HG + SZ_TOK512;
constexpr size_t OFF_Q = OFF_AG + SZ_TOK512, OFF_K = OFF_Q + SZ_TOK512, OFF_VT = OFF_K + SZ_TOK512;
constexpr size_t OFF_XBC = OFF_BIG;
constexpr size_t OFF_ZREG = 297 * MiB;
constexpr size_t OFF_XN = OFF_ZREG;
constexpr size_t OFF_FFTS = OFF_ZREG + 65 * MiB;
constexpr size_t OFF_ZB = OFF_ZREG;
constexpr size_t OFF_OUT0 = 425 * MiB;
constexpr size_t OFF_DT = 490 * MiB;
constexpr size_t OFF_HALO = 499 * MiB;
constexpr size_t OFF_END = 504 * MiB;

constexpr int LDS_BYTES = 156672;

struct Params {
  const float* in[30];
  float* out;
  unsigned char* ws;
  int ph_lo, ph_hi;
};

__device__ __forceinline__ u16 f2bf(float f) { return __builtin_bit_cast(u16, (__bf16)f); }
__device__ __forceinline__ float bf2f(u16 h) { return __uint_as_float(((u32)h) << 16); }
typedef float f32x2_t __attribute__((ext_vector_type(2)));
typedef __bf16 bf16x2_t __attribute__((ext_vector_type(2)));
__device__ __forceinline__ u32 pack2(float a, float b) {
  f32x2_t v = {a, b};
  bf16x2_t r = __builtin_convertvector(v, bf16x2_t);
  return __builtin_bit_cast(u32, r);
}
__device__ __forceinline__ float silu_f(float x) { return x * __builtin_amdgcn_rcpf(1.f + __expf(-x)); }
__device__ __forceinline__ float softplus_f(float x) {
  float y = __expf(-fabsf(x));
  float l = (y < 1e-2f) ? y * (1.f - y * (0.5f - y * (1.f / 3.f))) : __logf(1.f + y);
  return fmaxf(x, 0.f) + l;
}
__device__ __forceinline__ int opaque_tid() { int t = threadIdx.x; asm volatile("" : "+v"(t)); return t; }
#define MFMA(a, b, c) __builtin_amdgcn_mfma_f32_32x32x16_bf16((a), (b), (c), 0, 0, 0)

__device__ __forceinline__ float wave_sum(float v) {
#pragma unroll
  for (int o = 32; o >= 1; o >>= 1) v += __shfl_xor(v, o);
  return v;
}
__device__ __forceinline__ float block_sum(float v, float* red) {
  v = wave_sum(v);
  __syncthreads();
  if ((threadIdx.x & 63) == 0) red[threadIdx.x >> 6] = v;
  __syncthreads();
  float t = 0.f;
#pragma unroll
  for (int i = 0; i < 8; ++i) t += red[i];
  return t;
}

__device__ __forceinline__ void transpose_tile(const float* __restrict__ W, int K, int N, u16* __restrict__ Wt, int kt, int nt, float* tile) {
  const int tid = opaque_tid();
  {
    int k = tid >> 3, ng = (tid & 7) * 8;
    const float* src = W + (size_t)(kt * 64 + k) * N + nt * 64 + ng;
    float4 a = *(const float4*)src, b = *(const float4*)(src + 4);
    float* d = tile + k * 65 + ng;
    d[0] = a.x; d[1] = a.y; d[2] = a.z; d[3] = a.w; d[4] = b.x; d[5] = b.y; d[6] = b.z; d[7] = b.w;
  }
  __syncthreads();
  {
    int n = tid >> 3, kg = (tid & 7) * 8;
    u32x4 o;
    o[0] = pack2(tile[(kg + 0) * 65 + n], tile[(kg + 1) * 65 + n]);
    o[1] = pack2(tile[(kg + 2) * 65 + n], tile[(kg + 3) * 65 + n]);
    o[2] = pack2(tile[(kg + 4) * 65 + n], tile[(kg + 5) * 65 + n]);
    o[3] = pack2(tile[(kg + 6) * 65 + n], tile[(kg + 7) * 65 + n]);
    *(u32x4*)(Wt + (size_t)(nt * 64 + n) * K + kt * 64 + kg) = o;
  }
  __syncthreads();
}

__device__ __forceinline__ void phase_prep(const Params& P, unsigned char* smem) {
  const int tid = opaque_tid();
  float* fs = (float*)smem;
  const int n_wt = 1024 + 256 + 1552 + 512;
  const int i_pad = n_wt, i_mod = i_pad + 1, i_h2 = i_mod + 384, i_misc = i_h2 + 2080, n_items = i_misc + 1;
  float* w1s = fs + 8192;
  float* w2s = w1s + 33 * 64;
  for (int i = tid; i < 33 * 64; i += NT) w1s[i] = P.in[11][i];
  for (int i = tid; i < 64 * 64; i += NT) w2s[i] = P.in[13][i];
  __syncthreads();
  for (int it = blockIdx.x; it < n_items; it += gridDim.x) {
    if (it < n_wt) {
      int t = it;
      if (t < 1024) transpose_tile(P.in[7], 1024, 4096, (u16*)(P.ws + OFF_WEIN), t / 64, t % 64, fs);
      else if ((t -= 1024) < 256) transpose_tile(P.in[8], 1024, 1024, (u16*)(P.ws + OFF_WEOUT), t / 16, t % 16, fs);
      else if ((t -= 256) < 1552) transpose_tile(P.in[21], 1024, 6208, (u16*)(P.ws + OFF_WOIN), t / 97, t % 97, fs);
      else { t -= 1552; transpose_tile(P.in[28], 2048, 1024, (u16*)(P.ws + OFF_WOOUT), t / 16, t % 16, fs); }
    } else if (it == i_pad) {
      u32 zz = 0; asm volatile("" : "+v"(zz));
      u32x4 z = {zz, zz, zz, zz};
      u32x4* d = (u32x4*)(P.ws + OFF_WOIN + (size_t)6208 * 1024 * 2);
      for (int i = tid; i < 192 * 1024 * 2 / 16; i += NT) d[i] = z;
    } else if (it < i_h2) {
      int m = it - i_mod;
      int layer = m / 192, cg16 = m % 192;
      int kg = tid >> 4, col = cg16 * 16 + (tid & 15);
      const float* w = P.in[4] + (size_t)layer * 1024 * 3072;
      float s0 = 0.f, s1 = 0.f, s2 = 0.f;
#pragma unroll 4
      for (int k = kg * 32; k < kg * 32 + 32; ++k) {
        float wv = w[(size_t)k * 3072 + col];
        s0 += silu_f(P.in[1][k]) * wv;
        s1 += silu_f(P.in[1][1024 + k]) * wv;
        s2 += silu_f(P.in[3][k]) * wv;
      }
      __syncthreads();
      fs[(0 * 32 + kg) * 16 + (tid & 15)] = s0;
      fs[(1 * 32 + kg) * 16 + (tid & 15)] = s1;
      fs[(2 * 32 + kg) * 16 + (tid & 15)] = s2;
      __syncthreads();
      if (tid < 48) {
        int v = tid >> 4, c = tid & 15;
        float s = 0.f;
#pragma unroll 4
        for (int g = 0; g < 32; ++g) s += fs[(v * 32 + g) * 16 + c];
        int cc = cg16 * 16 + c;
        ((float*)(P.ws + OFF_MODS))[(layer * 3 + v) * 3072 + cc] = s + P.in[5][layer * 3072 + cc];
      }
      __syncthreads();
    } else if (it < i_misc) {
      int gp = (it - i_h2) * 8 + (tid >> 6);
      int j = tid & 63, pl = tid >> 6;
      int Lp = gp < LL ? LL : CT;
      int t = gp < LL ? gp : gp - LL;
      float* zs = fs;
      float* h1s = fs + 8 * 40;
      __syncthreads();
      if (j < 33) {
        float z;
        if (j == 0) z = (float)t / (float)(Lp - 1);
        else {
          int bi = (j - 1) & 15;
          float band = 1e-4f + (float)bi * ((15.f - 1e-4f) / 15.f);
          float w = 6.283185307179586f * (float)t / (float)Lp;
          float a = band * w;
          z = (j <= 16) ? cosf(a) : -sinf(a);
        }
        zs[pl * 40 + j] = z;
      }
      __syncthreads();
      {
        float a = P.in[12][j];
#pragma unroll 3
        for (int e = 0; e < 33; ++e) a += zs[pl * 40 + e] * w1s[e * 64 + j];
        h1s[pl * 64 + j] = sinf(P.in[17][j] * a);
      }
      __syncthreads();
      {
        float a = P.in[14][j];
#pragma unroll 4
        for (int i = 0; i < 64; ++i) a += h1s[pl * 64 + i] * w2s[i * 64 + j];
        ((float*)(P.ws + OFF_H2))[(size_t)gp * 64 + j] = sinf(P.in[17][64 + j] * a);
      }
      __syncthreads();
    } else {
      for (int i = tid; i < 256 * 16; i += NT) {
        int pos = i >> 4, j = i & 15;
        float inv = exp2f(-(float)j * (13.287712379549449f / 16.f));
        float sn, cs;
        sincosf((float)pos * inv, &sn, &cs);
        ((float2*)(P.ws + OFF_ROPE))[i] = make_float2(cs, sn);
      }
      if (tid == 0) {
        int* cnt = (int*)(P.ws + OFF_CNT);
        cnt[0] = 0;
        const float* lp = P.in[19];
        float a = 0.f, b = 0.f;
        for (int i = 0; i < 64; ++i) { a += lp[i] * lp[64 + i]; b += lp[128 + i] * lp[192 + i]; }
        ((float*)cnt)[1] = expf(a) - expf(b) + 0.2f;
      }
    }
  }
}

__device__ __forceinline__ void phase_norm(const Params& P, int layer, u16* __restrict__ xn) {
  const int tid_ = opaque_tid(); const int lane = tid_ & 63, wv = tid_ >> 6;
  const float* mods = (const float*)(P.ws + OFF_MODS) + (size_t)layer * 3 * 3072;
  const float* nw = P.in[6] + layer * 1024;
  const u16* out0 = (const u16*)(P.ws + OFF_OUT0);
  for (int it = blockIdx.x; it < NTOK / 8; it += gridDim.x) {
    int tok = it * 8 + wv;
    int b = tok / SS, s = tok % SS;
    const float* src = (s < CT) ? (P.in[2] + ((size_t)b * CT + s) * DM) : (P.in[0] + ((size_t)b * LL + (s - CT)) * DM);
    const float* mv = mods + ((s < CT) ? 2 : b) * 3072;
    float4 v[4];
    float ss = 0.f;
#pragma unroll
    for (int i = 0; i < 4; ++i) {
      int col = i * 256 + lane * 4;
      v[i] = *(const float4*)(src + col);
      if (layer == 1) {
        u32x2 d = *(const u32x2*)(out0 + (size_t)tok * DM + col);
        v[i].x += bf2f((u16)(d[0] & 0xffff)); v[i].y += bf2f((u16)(d[0] >> 16));
        v[i].z += bf2f((u16)(d[1] & 0xffff)); v[i].w += bf2f((u16)(d[1] >> 16));
      }
      ss += v[i].x * v[i].x + v[i].y * v[i].y + v[i].z * v[i].z + v[i].w * v[i].w;
    }
    ss = wave_sum(ss);
    float rstd = rsqrtf(ss * (1.f / DM) + EPSN);
#pragma unroll
    for (int i = 0; i < 4; ++i) {
      int col = i * 256 + lane * 4;
      float4 w = *(const float4*)(nw + col);
      float4 sh = *(const float4*)(mv + col);
      float4 sc = *(const float4*)(mv + 1024 + col);
      float a0 = v[i].x * rstd * w.x * (1.f + sc.x) + sh.x;
      float a1 = v[i].y * rstd * w.y * (1.f + sc.y) + sh.y;
      float a2 = v[i].z * rstd * w.z * (1.f + sc.z) + sh.z;
      float a3 = v[i].w * rstd * w.w * (1.f + sc.w) + sh.w;
      u32x2 o; o[0] = pack2(a0, a1); o[1] = pack2(a2, a3);
      *(u32x2*)(xn + (size_t)tok * DM + col) = o;
    }
  }
}

__device__ __forceinline__ void phase_filter(const Params& P, unsigned char* smem) {
  const int tid = opaque_tid();
  float* hs = (float*)smem;
  float* wsm = hs + 128 * 65;
  const float* H2 = (const float*)(P.ws + OFF_H2);
  const float* w3 = P.in[15];
  const float* b3 = P.in[16];
  const int nbig = 128 * 16, nsm = 2 * 16;
  const int tq = tid & 31, cg8 = tid >> 5;
  for (int it = blockIdx.x; it < nbig + nsm; it += gridDim.x) {
    int Lp, tt, ct; float* dst; size_t hoff;
    if (it < nbig) { Lp = LL; tt = it >> 4; ct = it & 15; dst = P.out; hoff = 0; }
    else { int k = it - nbig; Lp = CT; tt = k >> 4; ct = k & 15; dst = (float*)(P.ws + OFF_KRAW256); hoff = (size_t)LL * 64; }
    __syncthreads();
    for (int i = tid; i < 128 * 16; i += NT) {
      int rr = i >> 4, c4 = (i & 15) * 4;
      float4 v = *(const float4*)(H2 + hoff + (size_t)(tt * 128 + rr) * 64 + c4);
      float* d = hs + rr * 65 + c4; d[0] = v.x; d[1] = v.y; d[2] = v.z; d[3] = v.w;
    }
    for (int i = tid; i < 64 * 32; i += NT) {
      int rr = i >> 5, c4 = (i & 31) * 4;
      *(float4*)(wsm + rr * 128 + c4) = *(const float4*)(w3 + (size_t)rr * 2048 + ct * 128 + c4);
    }
    __syncthreads();
    float acc[4][8];
#pragma unroll
    for (int e = 0; e < 8; ++e) { float b = b3[ct * 128 + cg8 * 8 + e]; acc[0][e] = b; acc[1][e] = b; acc[2][e] = b; acc[3][e] = b; }
#pragma unroll 4
    for (int j = 0; j < 64; ++j) {
      float a[4], wv[8];
#pragma unroll
      for (int i = 0; i < 4; ++i) a[i] = hs[(tq + 32 * i) * 65 + j];
      *(float4*)&wv[0] = *(const float4*)(wsm + j * 128 + cg8 * 8);
      *(float4*)&wv[4] = *(const float4*)(wsm + j * 128 + cg8 * 8 + 4);
#pragma unroll
      for (int i = 0; i < 4; ++i)
#pragma unroll
        for (int e = 0; e < 8; ++e) acc[i][e] += a[i] * wv[e];
    }
    const float mind = -3.0701134573253944f, maxd = -15.350567286626972f;
#pragma unroll
    for (int e = 0; e < 8; ++e) {
      const int col = ct * 128 + cg8 * 8 + e;
      const float delta = fabsf(mind + (float)(col & 511) * ((maxd - mind) / 511.f));
#pragma unroll
      for (int i = 0; i < 4; ++i) {
        const int t = tt * 128 + tq + 32 * i;
        const float tlin = (float)t / (float)(Lp - 1);
        dst[(size_t)col * Lp + t] = acc[i][e] * expf(-tlin * delta);
      }
    }
  }
}

constexpr int EP = 36;
template <int MODE>
__device__ __forceinline__ void gemm_epilogue(const Params& P, int row0, int col0, const f32x16& acc, float* wl);

__device__ __forceinline__ void glds_tile(const u16* __restrict__ g, int ld, int k0, unsigned char* ldst, int tid) {
#pragma unroll
  for (int p = 0; p < 4; ++p) {
    const int slot = p * 512 + tid;
    const int row = slot >> 3, kc = (slot & 7) ^ ((row >> 1) & 7);
    unsigned off = (unsigned)(row * ld + kc * 8);
    asm volatile("" : "+v"(off));
    __builtin_amdgcn_global_load_lds((const unsigned*)((g + k0) + off), (unsigned*)(ldst + slot * 16), 16, 0, 0);
  }
}

template <int MODE>
__device__ __forceinline__ void gemm_phase(const Params& P, const u16* __restrict__ A, int lda, const u16* __restrict__ Bt, int ldb,
                           int K, int nMt, int nNt, unsigned char* smem) {
  const int tid = opaque_tid(), lane = tid & 63, w = tid >> 6;
  const int r = lane & 31, h = lane >> 5;
  const int wm = w >> 2, wn = w & 3;
  unsigned char* As = smem;
  unsigned char* Bs = smem + 2 * 32768;
  const int KT = K / 64;
  const int sw = (r >> 1) & 7;
  const int nTiles = nMt * nNt;
  const int bslot = (blockIdx.x & 7) * (gridDim.x >> 3) + (blockIdx.x >> 3);
  for (int tile0 = 0; tile0 < nTiles; tile0 += gridDim.x) {
    const int T = tile0 + ((gridDim.x & 7) ? (int)blockIdx.x : bslot);
    if (T >= nTiles) break;
    int mt, nt;
    {
      const int nig = 8 * nNt, gid = T / nig, fm = gid * 8, gsz = min(nMt - fm, 8), within = T - gid * nig;
      mt = fm + within % gsz; nt = within / gsz;
    }
    int arow0 = mt * 256;
    const u16* Ap = A + (size_t)arow0 * lda;
    const u16* Bp = Bt + (size_t)(nt * 256) * ldb;
    f32x16 acc[4][2];
#pragma unroll
    for (int i = 0; i < 4; ++i)
#pragma unroll
      for (int j = 0; j < 2; ++j)
#pragma unroll
        for (int e = 0; e < 16; ++e) acc[i][j][e] = 0.f;
    __syncthreads();
    glds_tile(Ap, lda, 0, As, tid);
    glds_tile(Bp, ldb, 0, Bs, tid);
    asm volatile("s_waitcnt vmcnt(0)" ::: "memory");
    __syncthreads();
    for (int kt = 0; kt < KT; ++kt) {
      const int buf = kt & 1;
      const unsigned char* as = As + buf * 32768 + (wm * 128 + r) * 128;
      const unsigned char* bs = Bs + buf * 32768 + (wn * 64 + r) * 128;
      bf16x8 af[2][4], bfr[2][2];
      {
        const int o0 = ((0 * 2 + h) ^ sw) * 16;
#pragma unroll
        for (int i = 0; i < 4; ++i) af[0][i] = *(const bf16x8*)(as + i * 4096 + o0);
#pragma unroll
        for (int j = 0; j < 2; ++j) bfr[0][j] = *(const bf16x8*)(bs + j * 4096 + o0);
      }
#pragma unroll
      for (int ks = 0; ks < 4; ++ks) {
        if (ks + 1 < 4) {
          const int o1 = (((ks + 1) * 2 + h) ^ sw) * 16;
#pragma unroll
          for (int i = 0; i < 4; ++i) af[(ks + 1) & 1][i] = *(const bf16x8*)(as + i * 4096 + o1);
#pragma unroll
          for (int j = 0; j < 2; ++j) bfr[(ks + 1) & 1][j] = *(const bf16x8*)(bs + j * 4096 + o1);
        }
        __builtin_amdgcn_sched_barrier(0);
#pragma unroll
        for (int i = 0; i < 4; ++i)
#pragma unroll
          for (int j = 0; j < 2; ++j) acc[i][j] = MFMA(af[ks & 1][i], bfr[ks & 1][j], acc[i][j]);
        __builtin_amdgcn_sched_barrier(0);
        if (ks == 0 && kt + 1 < KT) glds_tile(Ap, lda, (kt + 1) * 64, As + (buf ^ 1) * 32768, tid);
        if (ks == 1 && kt + 1 < KT) glds_tile(Bp, ldb, (kt + 1) * 64, Bs + (buf ^ 1) * 32768, tid);
        __builtin_amdgcn_sched_barrier(0);
      }
      asm volatile("s_waitcnt vmcnt(0)" ::: "memory");
      __syncthreads();
    }
#pragma unroll
    for (int i = 0; i < 4; ++i)
#pragma unroll
      for (int j = 0; j < 2; ++j)
      {
        gemm_epilogue<MODE>(P, arow0 + wm * 128 + i * 32, nt * 256 + wn * 64 + j * 32, acc[i][j], (float*)smem + w * (32 * EP));
        __builtin_amdgcn_sched_barrier(0);
      }
  }
}

__device__ __forceinline__ void lds_wave_fence() { asm volatile("s_waitcnt lgkmcnt(0)" ::: "memory"); }
__device__ __forceinline__ void stage_rowmajor(float* wl, const f32x16& acc, int r, int h) {
#pragma unroll
  for (int j = 0; j < 16; ++j) wl[((j & 3) + 8 * (j >> 2) + 4 * h) * EP + r] = acc[j];
  lds_wave_fence();
}
__device__ __forceinline__ void stage_colmajor(float* wl, const f32x16& acc, int r, int h) {
#pragma unroll
  for (int g = 0; g < 4; ++g) *(float4*)(wl + r * EP + 8 * g + 4 * h) = make_float4(acc[4 * g], acc[4 * g + 1], acc[4 * g + 2], acc[4 * g + 3]);
  lds_wave_fence();
}
__device__ __forceinline__ u32x4 pack8(const float4& a, const float4& b) {
  u32x4 o; o[0] = pack2(a.x, a.y); o[1] = pack2(a.z, a.w); o[2] = pack2(b.x, b.y); o[3] = pack2(b.z, b.w); return o;
}

template <>
__device__ __forceinline__ void gemm_epilogue<0>(const Params& P, int row0, int col0, const f32x16& acc, float* wl) {
  const int lane = opaque_tid() & 63, r = lane & 31, h = lane >> 5;
  const int b = row0 / SS, s0 = row0 % SS;
  if (col0 < 1536 || (col0 >= 3072 && col0 < 3584)) {
    stage_colmajor(wl, acc, r, h);
#pragma unroll
    for (int k = 0; k < 2; ++k) {
      const int id = lane + 64 * k, col = id >> 2, rc = (id & 3) * 8;
      const float4 a = *(const float4*)(wl + col * EP + rc), c = *(const float4*)(wl + col * EP + rc + 4);
      const u32x4 pv8 = pack8(a, c);
      if (col0 < 1536) *(u32x4*)((u16*)(P.ws + OFF_HYT) + ((size_t)b * 1536 + col0 + col) * SS + s0 + rc) = pv8;
      else {
        const int cc = col0 + col - 3072;
        u16* dst = (u16*)(P.ws + OFF_VT) + ((size_t)(b * 4 + (cc >> 7)) * 128 + (cc & 127)) * SS + s0 + (rc & ~15);
        u32x2 lo, hi; lo[0] = pv8[0]; lo[1] = pv8[1]; hi[0] = pv8[2]; hi[1] = pv8[3];
        *(u32x2*)(dst + ((rc & 8) ? 4 : 0)) = lo;
        *(u32x2*)(dst + ((rc & 8) ? 12 : 8)) = hi;
      }
    }
  } else if (col0 < 2048 || col0 >= 3584) {
    stage_rowmajor(wl, acc, r, h);
    u16* base = (col0 < 2048) ? ((u16*)(P.ws + OFF_HG) + (col0 - 1536)) : ((u16*)(P.ws + OFF_AG) + (col0 - 3584));
#pragma unroll
    for (int k = 0; k < 2; ++k) {
      const int id = lane + 64 * k, row = id >> 2, c8 = (id & 3) * 8;
      const float4 a = *(const float4*)(wl + row * EP + c8), c = *(const float4*)(wl + row * EP + c8 + 4);
      *(u32x4*)(base + (size_t)(row0 + row) * 512 + c8) = pack8(a, c);
    }
  } else {
    stage_rowmajor(wl, acc, r, h);
    const bool isq = col0 < 2560;
    const int cc0 = col0 - (isq ? 2048 : 2560);
    const int head = cc0 >> 7, comp = (cc0 >> 6) & 1, dt0 = cc0 & 63;
    u16* base = (u16*)(P.ws + (isq ? OFF_Q : OFF_K)) + ((size_t)((b * 4 + head) * 2 + comp) * SS) * 64 + dt0;
    const float qs = isq ? (0.125f * 1.4426950408889634f) : 1.f;
#pragma unroll
    for (int k = 0; k < 2; ++k) {
      const int id = lane + 64 * k, row = id >> 2, c8 = (id & 3) * 8;
      const int s = s0 + row;
      float v[8], pv[8];
      *(float4*)&v[0] = *(const float4*)(wl + row * EP + c8); *(float4*)&v[4] = *(const float4*)(wl + row * EP + c8 + 4);
      *(float4*)&pv[0] = *(const float4*)(wl + row * EP + (c8 ^ 16)); *(float4*)&pv[4] = *(const float4*)(wl + row * EP + (c8 ^ 16) + 4);
      float o[8];
      if (s >= CT) {
        const int t = s - CT;
        const int pos = (dt0 == 0) ? (t >> 6) : (t & 63);
        const float4* rp = (const float4*)((const float2*)(P.ws + OFF_ROPE) + pos * 16 + (c8 & 15));
        float cs[8], sn[8];
#pragma unroll
        for (int i = 0; i < 4; ++i) { float4 q4 = rp[i]; cs[2 * i] = q4.x; sn[2 * i] = q4.y; cs[2 * i + 1] = q4.z; sn[2 * i + 1] = q4.w; }
        const bool hi16 = (c8 & 16) != 0;
#pragma unroll
        for (int i = 0; i < 8; ++i) o[i] = (hi16 ? (pv[i] * sn[i] + v[i] * cs[i]) : (v[i] * cs[i] - pv[i] * sn[i])) * qs;
      } else {
#pragma unroll
        for (int i = 0; i < 8; ++i) o[i] = v[i] * qs;
      }
      u32x4 ov; ov[0] = pack2(o[0], o[1]); ov[1] = pack2(o[2], o[3]); ov[2] = pack2(o[4], o[5]); ov[3] = pack2(o[6], o[7]);
      *(u32x4*)(base + (size_t)s * 64 + c8) = ov;
    }
  }
}
template <>
__device__ __forceinline__ void gemm_epilogue<1>(const Params& P, int row0, int col0, const f32x16& acc, float* wl) {
  const int lane = opaque_tid() & 63, r = lane & 31, h = lane >> 5;
  const int b = row0 / SS, s0 = row0 % SS;
  stage_rowmajor(wl, acc, r, h);
  const float* gp = (const float*)(P.ws + OFF_MODS) + ((s0 < CT) ? 2 : b) * 3072 + 2048 + col0;
  u16* base = (u16*)(P.ws + OFF_OUT0) + col0;
#pragma unroll
  for (int k = 0; k < 2; ++k) {
    const int id = lane + 64 * k, row = id >> 2, c8 = (id & 3) * 8;
    float4 a = *(const float4*)(wl + row * EP + c8), c = *(const float4*)(wl + row * EP + c8 + 4);
    const float4 g0 = *(const float4*)(gp + c8), g1 = *(const float4*)(gp + c8 + 4);
    a.x *= g0.x; a.y *= g0.y; a.z *= g0.z; a.w *= g0.w; c.x *= g1.x; c.y *= g1.y; c.z *= g1.z; c.w *= g1.w;
    *(u32x4*)(base + (size_t)(row0 + row) * DM + c8) = pack8(a, c);
  }
}
template <>
__device__ __forceinline__ void gemm_epilogue<2>(const Params& P, int row0, int col0, const f32x16& acc, float* wl) {
  const int lane = opaque_tid() & 63, r = lane & 31, h = lane >> 5;
  const int b = row0 / SS, s0 = row0 % SS;
  if (col0 >= 6208) return;
  if (col0 < 2048 && s0 < CT) return;
  stage_rowmajor(wl, acc, r, h);
  if (col0 < 2048) {
    u16* base = (u16*)(P.ws + OFF_ZB) + ((size_t)b * LL + (s0 - CT)) * 2048 + col0;
#pragma unroll
    for (int k = 0; k < 2; ++k) {
      const int id = lane + 64 * k, row = id >> 2, c8 = (id & 3) * 8;
      const float4 a = *(const float4*)(wl + row * EP + c8), c = *(const float4*)(wl + row * EP + c8 + 4);
      *(u32x4*)(base + (size_t)row * 2048 + c8) = pack8(a, c);
    }
  } else if (col0 < 6144) {
    const int cc0 = col0 - 2048;
    u16* base = (u16*)(P.ws + OFF_XBC) + cc0;
    u16* halo = (u16*)(P.ws + OFF_HALO) + cc0;
#pragma unroll
    for (int k = 0; k < 2; ++k) {
      const int id = lane + 64 * k, row = id >> 2, c8 = (id & 3) * 8;
      const float4 a = *(const float4*)(wl + row * EP + c8), c = *(const float4*)(wl + row * EP + c8 + 4);
      const u32x4 ov = pack8(a, c);
      const int tok = row0 + row;
      *(u32x4*)(base + (size_t)tok * 4096 + c8) = ov;
      const int m = tok & 127;
      if (m == 0) *(u32x4*)(halo + ((size_t)(tok >> 7) * 2 + 0) * 4096 + c8) = ov;
      if (m == 127) *(u32x4*)(halo + ((size_t)(tok >> 7) * 2 + 1) * 4096 + c8) = ov;
    }
  } else {
    const int cc0 = col0 - 6144;
    const float* bp = P.in[24] + cc0;
    float* base = (float*)(P.ws + OFF_DT) + cc0;
#pragma unroll
    for (int k = 0; k < 2; ++k) {
      const int id = lane + 64 * k, row = id >> 2, c8 = (id & 3) * 8;
      float4 a = *(const float4*)(wl + row * EP + c8), c = *(const float4*)(wl + row * EP + c8 + 4);
      const float4 b0 = *(const float4*)(bp + c8), b1 = *(const float4*)(bp + c8 + 4);
      a.x = softplus_f(a.x + b0.x); a.y = softplus_f(a.y + b0.y); a.z = softplus_f(a.z + b0.z); a.w = softplus_f(a.w + b0.w);
      c.x = softplus_f(c.x + b1.x); c.y = softplus_f(c.y + b1.y); c.z = softplus_f(c.z + b1.z); c.w = softplus_f(c.w + b1.w);
      float* d = base + (size_t)(row0 + row) * 64 + c8;
      *(float4*)d = a; *(float4*)(d + 4) = c;
    }
  }
}
template <>
__device__ __forceinline__ void gemm_epilogue<3>(const Params& P, int row0, int col0, const f32x16& acc, float* wl) {
  const int lane = opaque_tid() & 63, r = lane & 31, h = lane >> 5;
  const int b = row0 / LL, t0 = row0 % LL;
  stage_rowmajor(wl, acc, r, h);
  const float* gp = (const float*)(P.ws + OFF_MODS) + 3 * 3072 + b * 3072 + 2048 + col0;
  const u16* o0 = (const u16*)(P.ws + OFF_OUT0) + ((size_t)b * SS + CT + t0) * DM + col0;
  const float* xin = P.in[0] + (size_t)row0 * DM + col0;
  float* dst = P.out + (size_t)row0 * DM + col0;
#pragma unroll
  for (int k = 0; k < 4; ++k) {
    const int id = lane + 64 * k, row = id >> 3, c4 = (id & 7) * 4;
    const float4 a = *(const float4*)(wl + row * EP + c4);
    const float4 g = *(const float4*)(gp + c4);
    const float4 x = *(const float4*)(xin + (size_t)row * DM + c4);
    const u32x2 ob = *(const u32x2*)(o0 + (size_t)row * DM + c4);
    float4 o;
    o.x = x.x + bf2f((u16)(ob[0] & 0xffff)) + g.x * a.x;
    o.y = x.y + bf2f((u16)(ob[0] >> 16)) + g.y * a.y;
    o.z = x.z + bf2f((u16)(ob[1] & 0xffff)) + g.z * a.z;
    o.w = x.w + bf2f((u16)(ob[1] >> 16)) + g.w * a.w;
    *(float4*)(dst + (size_t)row * DM + c4) = o;
  }
}

__device__ __forceinline__ float2 cmul(float2 a, float2 b) { return make_float2(a.x * b.x - a.y * b.y, a.x * b.y + a.y * b.x); }

__device__ __forceinline__ void bf4_fwd(float2& a0, float2& a1, float2& a2, float2& a3) {
  float2 t0 = make_float2(a0.x + a2.x, a0.y + a2.y), t1 = make_float2(a0.x - a2.x, a0.y - a2.y);
  float2 t2 = make_float2(a1.x + a3.x, a1.y + a3.y), t3 = make_float2(a1.x - a3.x, a1.y - a3.y);
  a0 = make_float2(t0.x + t2.x, t0.y + t2.y); a2 = make_float2(t0.x - t2.x, t0.y - t2.y);
  a1 = make_float2(t1.x + t3.y, t1.y - t3.x);
  a3 = make_float2(t1.x - t3.y, t1.y + t3.x);
}
__device__ __forceinline__ void bf4_inv(float2& a0, float2& a1, float2& a2, float2& a3) {
  float2 t0 = make_float2(a0.x + a2.x, a0.y + a2.y), t1 = make_float2(a0.x - a2.x, a0.y - a2.y);
  float2 t2 = make_float2(a1.x + a3.x, a1.y + a3.y), t3 = make_float2(a1.x - a3.x, a1.y - a3.y);
  a0 = make_float2(t0.x + t2.x, t0.y + t2.y); a2 = make_float2(t0.x - t2.x, t0.y - t2.y);
  a1 = make_float2(t1.x - t3.y, t1.y + t3.x);
  a3 = make_float2(t1.x + t3.y, t1.y - t3.x);
}
template <bool INV>
__device__ __forceinline__ void fft_pass4(float2* X, const int lq, const int tid) {
  const int q = 1 << lq;
  for (int i = tid; i < 4096; i += NT) {
    int blk = i >> lq, j = i & (q - 1);
    int base = (blk << (lq + 2)) + j;
    float sn, cs;
    sincospif(2.f * (float)j / (float)(4 * q), &sn, &cs);
    const float2 w1 = make_float2(cs, INV ? sn : -sn);
    const float2 w2 = cmul(w1, w1), w3 = cmul(w2, w1);
    float2 a0 = X[base], a1 = X[base + q], a2 = X[base + 2 * q], a3 = X[base + 3 * q];
    if (!INV) { bf4_fwd(a0, a1, a2, a3); a1 = cmul(a1, w1); a2 = cmul(a2, w2); a3 = cmul(a3, w3); }
    else { a1 = cmul(a1, w1); a2 = cmul(a2, w2); a3 = cmul(a3, w3); bf4_inv(a0, a1, a2, a3); }
    X[base] = a0; X[base + q] = a1; X[base + 2 * q] = a2; X[base + 3 * q] = a3;
  }
}
template <bool INV>
__device__ __forceinline__ void fft_pass16(float2* X, const int lq, const int tid) {
  const int q = 1 << lq, qq = q >> 2, lqq = lq - 2;
  const float sg = INV ? 1.f : -1.f;
#pragma unroll 1
  for (int i = tid; i < 1024; i += NT) {
    const int blk = i >> lqq, jp = i & (qq - 1);
    const int base = (blk << (lq + 2)) + jp;
    float2 e[4][4];
#pragma unroll
    for (int a = 0; a < 4; ++a)
#pragma unroll
      for (int b = 0; b < 4; ++b) e[a][b] = X[base + a * q + b * qq];
    float sn, cs;
    sincospif(2.f * (float)jp / (float)(4 * q), &sn, &cs);
    const float2 wj = make_float2(cs, sg * sn);
    const float2 wj2 = cmul(wj, wj), w4 = cmul(wj2, wj2);
    const float2 w42 = cmul(w4, w4), w43 = cmul(w42, w4);
    const float2 c16[4] = {make_float2(1.f, 0.f), make_float2(0.92387953251128674f, sg * 0.38268343236508977f),
                           make_float2(0.70710678118654752f, sg * 0.70710678118654752f), make_float2(0.38268343236508977f, sg * 0.92387953251128674f)};
    if (!INV) {
#pragma unroll
      for (int b = 0; b < 4; ++b) {
        const float2 w1 = cmul(wj, c16[b]), w2 = cmul(w1, w1), w3 = cmul(w2, w1);
        bf4_fwd(e[0][b], e[1][b], e[2][b], e[3][b]);
        e[1][b] = cmul(e[1][b], w1); e[2][b] = cmul(e[2][b], w2); e[3][b] = cmul(e[3][b], w3);
      }
#pragma unroll
      for (int a = 0; a < 4; ++a) {
        bf4_fwd(e[a][0], e[a][1], e[a][2], e[a][3]);
        e[a][1] = cmul(e[a][1], w4); e[a][2] = cmul(e[a][2], w42); e[a][3] = cmul(e[a][3], w43);
      }
    } else {
#pragma unroll
      for (int a = 0; a < 4; ++a) {
        e[a][1] = cmul(e[a][1], w4); e[a][2] = cmul(e[a][2], w42); e[a][3] = cmul(e[a][3], w43);
        bf4_inv(e[a][0], e[a][1], e[a][2], e[a][3]);
      }
#pragma unroll
      for (int b = 0; b < 4; ++b) {
        const float2 w1 = cmul(wj, c16[b]), w2 = cmul(w1, w1), w3 = cmul(w2, w1);
        e[1][b] = cmul(e[1][b], w1); e[2][b] = cmul(e[2][b], w2); e[3][b] = cmul(e[3][b], w3);
        bf4_inv(e[0][b], e[1][b], e[2][b], e[3][b]);
      }
    }
#pragma unroll
    for (int a = 0; a < 4; ++a)
#pragma unroll
      for (int b = 0; b < 4; ++b) X[base + a * q + b * qq] = e[a][b];
  }
}
__device__ __forceinline__ void fft_fwd(float2* X) {
  const int tid = opaque_tid();
  __syncthreads(); fft_pass16<false>(X, 12, tid);
  __syncthreads(); fft_pass16<false>(X, 8, tid);
  __syncthreads(); fft_pass16<false>(X, 4, tid);
  __syncthreads(); fft_pass4<false>(X, 0, tid);
  __syncthreads();
}
__device__ __forceinline__ void fft_fwd_noq1(float2* X) {
  const int tid = opaque_tid();
  __syncthreads(); fft_pass16<false>(X, 12, tid);
  __syncthreads(); fft_pass16<false>(X, 8, tid);
  __syncthreads(); fft_pass16<false>(X, 4, tid);
  __syncthreads();
}
__device__ __forceinline__ void fft_inv_noq1(float2* X) {
  const int tid = opaque_tid();
  __syncthreads(); fft_pass16<true>(X, 4, tid);
  __syncthreads(); fft_pass16<true>(X, 8, tid);
  __syncthreads(); fft_pass16<true>(X, 12, tid);
  __syncthreads();
}
__device__ __forceinline__ void fft_inv(float2* X) {
  const int tid = opaque_tid();
  __syncthreads(); fft_pass4<true>(X, 0, tid);
  __syncthreads(); fft_pass16<true>(X, 4, tid);
  __syncthreads(); fft_pass16<true>(X, 8, tid);
  __syncthreads(); fft_pass16<true>(X, 12, tid);
  __syncthreads();
}

__device__ __forceinline__ float conv3(const u16* row, int n, int Ls, float w0, float w1, float w2, float bias) {
  float a = bias + w1 * bf2f(row[n]);
  if (n > 0) a += w0 * bf2f(row[n - 1]);
  if (n + 1 < Ls) a += w2 * bf2f(row[n + 1]);
  return a;
}

__device__ __forceinline__ void conv3x4(const u16* __restrict__ row, int n, int Ls, float w0, float w1, float w2, float bias, float out[4]) {
  const u32x2 v = *(const u32x2*)(row + n);
  const float x0 = bf2f((u16)(v[0] & 0xffff)), x1 = bf2f((u16)(v[0] >> 16)), x2 = bf2f((u16)(v[1] & 0xffff)), x3 = bf2f((u16)(v[1] >> 16));
  const float xm = (n > 0) ? bf2f(row[n - 1]) : 0.f;
  const float xp = (n + 4 < Ls) ? bf2f(row[n + 4]) : 0.f;
  out[0] = bias + w0 * xm + w1 * x0 + w2 * x1;
  out[1] = bias + w0 * x0 + w1 * x1 + w2 * x2;
  out[2] = bias + w0 * x1 + w1 * x2 + w2 * x3;
  out[3] = bias + w0 * x2 + w1 * x3 + w2 * xp;
}
__device__ __forceinline__ void ld4c(const float2* p, float2 o[4]) {
  const float4 a = *(const float4*)p, b = *(const float4*)(p + 2);
  o[0] = make_float2(a.x, a.y); o[1] = make_float2(a.z, a.w); o[2] = make_float2(b.x, b.y); o[3] = make_float2(b.z, b.w);
}
__device__ __forceinline__ void st4c(float2* p, const float2 o[4]) {
  *(float4*)p = make_float4(o[0].x, o[0].y, o[1].x, o[1].y);
  *(float4*)(p + 2) = make_float4(o[2].x, o[2].y, o[3].x, o[3].y);
}

__device__ __forceinline__ void hyena_latent_item(const Params& P, int c, unsigned char* smem) {
  const int tid = opaque_tid();
  float2* X = (float2*)smem;
  float* red = (float*)(smem + 131072);
  unsigned char* scr = P.ws + OFF_FFTS + (size_t)blockIdx.x * (512 * 1024);
  float2* ABUF = (float2*)scr; float2* ZBUF = ABUF + LL;
  u16* hyt = (u16*)(P.ws + OFF_HYT);
  const float* sw = P.in[9]; const float* sb = P.in[10];
  const float* kraw = P.out;
  const float invL = 1.f / (float)LL;
  for (int rep = 0; rep < HYL_REP; ++rep)
  for (int o = 0; o < 2; ++o) {
    const float* hf = kraw + (size_t)((0 * 2 + o) * 512 + c) * LL;
    const float* hb = kraw + (size_t)((1 * 2 + o) * 512 + c) * LL;
    float2 E[32];
    __syncthreads();
    if (o == 0) {
      const float v0w = sw[0 * 1536 + c], v1w = sw[1 * 1536 + c], v2w = sw[2 * 1536 + c], vbs = sb[c];
      const u16* r0 = hyt + ((size_t)0 * 1536 + c) * SS + CT;
      const u16* r1 = hyt + ((size_t)1 * 1536 + c) * SS + CT;
      for (int n = opaque_tid() * 4; n < LL; n += NT * 4) {
        float a[4], b4[4]; float2 xv[4];
        conv3x4(r0, n, LL, v0w, v1w, v2w, vbs, a);
        conv3x4(r1, n, LL, v0w, v1w, v2w, vbs, b4);
#pragma unroll
        for (int i = 0; i < 4; ++i) xv[i] = make_float2(a[i], b4[i]);
        st4c(ZBUF + n, xv);
        st4c(X + n, xv);
      }
    } else {
      for (int n = opaque_tid() * 4; n < LL; n += NT * 4) { float2 xv[4]; ld4c(ZBUF + n, xv); st4c(X + n, xv); }
    }
    fft_fwd_noq1(X);
#pragma unroll
    for (int k = 0; k < 8; ++k) {
      ld4c(X + (tid + k * NT) * 4, &E[4 * k]);
      bf4_fwd(E[4 * k], E[4 * k + 1], E[4 * k + 2], E[4 * k + 3]);
    }
    float ns = 0.f;
    for (int n = opaque_tid() * 4; n < LL; n += NT * 4) {
      const float4 f4 = *(const float4*)(hf + n), b4 = *(const float4*)(hb + LL - n - 4);
      const float kf[4] = {f4.x, f4.y, f4.z, f4.w};
      const float kb[4] = {(n > 0) ? hb[LL - n] : 0.f, b4.w, b4.z, b4.y};
      float2 xv[4];
#pragma unroll
      for (int i = 0; i < 4; ++i) { ns += fabsf(kf[i]) + fabsf(kb[i]); xv[i] = make_float2(kf[i] + kb[i], 0.f); }
      st4c(X + n, xv);
    }
    const float inn = 1.f / block_sum(ns, red);
    fft_fwd_noq1(X);
#pragma unroll
    for (int k = 0; k < 8; ++k) {
      float2 xv[4]; ld4c(X + (tid + k * NT) * 4, xv);
      bf4_fwd(xv[0], xv[1], xv[2], xv[3]);
#pragma unroll
      for (int i = 0; i < 4; ++i) { float2 v = cmul(xv[i], E[4 * k + i]); xv[i] = make_float2(v.x * inn, v.y * inn); }
      bf4_inv(xv[0], xv[1], xv[2], xv[3]);
      st4c(X + (tid + k * NT) * 4, xv);
    }
    fft_inv_noq1(X);
    for (int n = opaque_tid() * 4; n < LL; n += NT * 4) {
      float2 xa[4], zv[4];
      ld4c(X + n, xa);
      st4c(ABUF + n, xa);
      ld4c(ZBUF + n, zv);
#pragma unroll
      for (int i = 0; i < 4; ++i) {
        float sn, cs; sincospif((float)(n + i) * invL, &sn, &cs);
        xa[i] = cmul(zv[i], make_float2(cs, -sn));
      }
      st4c(X + n, xa);
    }
    fft_fwd_noq1(X);
#pragma unroll
    for (int k = 0; k < 8; ++k) {
      ld4c(X + (tid + k * NT) * 4, &E[4 * k]);
      bf4_fwd(E[4 * k], E[4 * k + 1], E[4 * k + 2], E[4 * k + 3]);
    }
    for (int n = opaque_tid() * 4; n < LL; n += NT * 4) {
      const float4 f4 = *(const float4*)(hf + n), b4 = *(const float4*)(hb + LL - n - 4);
      const float kf[4] = {f4.x, f4.y, f4.z, f4.w};
      const float kb[4] = {(n > 0) ? hb[LL - n] : 0.f, b4.w, b4.z, b4.y};
      float2 xv[4];
#pragma unroll
      for (int i = 0; i < 4; ++i) {
        float sn, cs; sincospif((float)(n + i) * invL, &sn, &cs);
        const float d = kf[i] - kb[i];
        xv[i] = make_float2(d * cs, -d * sn);
      }
      st4c(X + n, xv);
    }
    fft_fwd_noq1(X);
#pragma unroll
    for (int k = 0; k < 8; ++k) {
      float2 xv[4]; ld4c(X + (tid + k * NT) * 4, xv);
      bf4_fwd(xv[0], xv[1], xv[2], xv[3]);
#pragma unroll
      for (int i = 0; i < 4; ++i) { float2 v = cmul(xv[i], E[4 * k + i]); xv[i] = make_float2(v.x * inn, v.y * inn); }
      bf4_inv(xv[0], xv[1], xv[2], xv[3]);
      st4c(X + (tid + k * NT) * 4, xv);
    }
    fft_inv_noq1(X);
    const int colg = (o == 0 ? 512 : 1024) + c;
    const float g0w = sw[0 * 1536 + colg], g1w = sw[1 * 1536 + colg], g2w = sw[2 * 1536 + colg], gbs = sb[colg];
    const u16* q0 = hyt + ((size_t)0 * 1536 + colg) * SS + CT;
    const u16* q1 = hyt + ((size_t)1 * 1536 + colg) * SS + CT;
    const float hbias = P.in[18][o * 512 + c];
    const float sc = 0.5f * invL;
    for (int n = opaque_tid() * 4; n < LL; n += NT * 4) {
      float2 bx[4], av[4], xv[4];
      float ga[4], gb[4];
      ld4c(X + n, bx); ld4c(ABUF + n, av); ld4c(ZBUF + n, xv);
      conv3x4(q0, n, LL, g0w, g1w, g2w, gbs, ga);
      conv3x4(q1, n, LL, g0w, g1w, g2w, gbs, gb);
#pragma unroll
      for (int i = 0; i < 4; ++i) {
        float sn, cs; sincospif((float)(n + i) * invL, &sn, &cs);
        const float2 bv = cmul(bx[i], make_float2(cs, sn));
        const float y0 = ((av[i].x + bv.x) * sc + xv[i].x * hbias) * ga[i];
        const float y1 = ((av[i].y + bv.y) * sc + xv[i].y * hbias) * gb[i];
        bx[i] = make_float2(y0, y1);
      }
      if (o == 0) st4c(ZBUF + n, bx);
      else st4c(X + n, bx);
    }
    __syncthreads();
  }
  {
    u16* w0 = hyt + ((size_t)0 * 1536 + c) * SS + CT;
    u16* w1 = hyt + ((size_t)1 * 1536 + c) * SS + CT;
    for (int n = opaque_tid() * 4; n < LL; n += NT * 4) {
      float2 v[4]; ld4c(X + n, v);
      u32x2 o0, o1;
      o0[0] = pack2(v[0].x, v[1].x); o0[1] = pack2(v[2].x, v[3].x);
      o1[0] = pack2(v[0].y, v[1].y); o1[1] = pack2(v[2].y, v[3].y);
      *(u32x2*)(w0 + n) = o0; *(u32x2*)(w1 + n) = o1;
    }
  }
  __syncthreads();
}

__device__ __forceinline__ void hyena_ctx_item(const Params& P, int c, unsigned char* smem) {
  const int tid = opaque_tid();
  const int b = tid >> 8, t = tid & 255;
  float* vs = (float*)smem;
  float* kf = vs + 512;
  float* kb = kf + 256;
  float* red = kb + 256;
  u16* hyt = (u16*)(P.ws + OFF_HYT);
  const float* sw = P.in[9]; const float* sb = P.in[10];
  const float* k256 = (const float*)(P.ws + OFF_KRAW256);
  float cur, x1, x2;
  {
    const u16* rv = hyt + ((size_t)b * 1536 + c) * SS;
    const u16* ra = hyt + ((size_t)b * 1536 + 512 + c) * SS;
    const u16* rb = hyt + ((size_t)b * 1536 + 1024 + c) * SS;
    cur = conv3(rv, t, CT, sw[c], sw[1536 + c], sw[3072 + c], sb[c]);
    x1 = conv3(ra, t, CT, sw[512 + c], sw[1536 + 512 + c], sw[3072 + 512 + c], sb[512 + c]);
    x2 = conv3(rb, t, CT, sw[1024 + c], sw[1536 + 1024 + c], sw[3072 + 1024 + c], sb[1024 + c]);
  }
  for (int o = 0; o < 2; ++o) {
    __syncthreads();
    float kv;
    if (b == 0) { kv = k256[(size_t)((0 * 2 + o) * 512 + c) * CT + t]; kf[t] = kv; }
    else { kv = k256[(size_t)((1 * 2 + o) * 512 + c) * CT + t]; kb[t] = kv; if (t == 0) kv = 0.f; }
    vs[b * 256 + t] = cur;
    float nrm = block_sum(fabsf(kv), red);
    float y = 0.f;
    for (int s = 0; s <= t; ++s) y += kf[t - s] * vs[b * 256 + s];
    for (int s = t + 1; s < CT; ++s) y += kb[s - t] * vs[b * 256 + s];
    y = y / nrm + cur * P.in[18][o * 512 + c];
    cur = y * (o == 0 ? x1 : x2);
  }
  __syncthreads();
  hyt[((size_t)b * 1536 + c) * SS + t] = f2bf(cur);
  __syncthreads();
}

__device__ __forceinline__ void attn_item(const Params& P, int b, int head, int qb, unsigned char* smem) {
  f32x16 O[4];
  float lrun = 0.f;
  {
  const int tid = opaque_tid(), lane = tid & 63, w = tid >> 6;
  const int r = lane & 31, h = lane >> 5;
  const int m = w & 1, wq = w >> 1;
  constexpr int KP = 72;
  unsigned char* kst = smem;
  unsigned char* vst = smem + 32768;
  u16* qs = (u16*)(smem + 65536);
  const u16* Qg = (const u16*)(P.ws + OFF_Q);
  const u16* Kg = (const u16*)(P.ws + OFF_K);
  const u16* Vg = (const u16*)(P.ws + OFF_VT);
  const int ntiles = (qb < 2) ? (CT / 64) : (SS / 64);
  const u16* K1p = Kg + ((size_t)((b * 4 + head) * 2 + 0) * SS) * 64;
  const u16* K2p = Kg + ((size_t)((b * 4 + head) * 2 + 1) * SS) * 64;
  const u16* Vp = Vg + ((size_t)(b * 4 + head) * 128) * SS;
  const int krow = tid >> 3, kkc = (tid & 7) ^ ((krow >> 1) & 7);
  unsigned koff = (unsigned)(krow * 64 + kkc * 8);
  const int e0 = tid >> 3, e1 = 64 + (tid >> 3);
  unsigned voff0 = (unsigned)(e0 * SS + ((tid & 7) ^ ((e0 >> 1) & 7)) * 8);
  unsigned voff1 = (unsigned)(e1 * SS + ((tid & 7) ^ ((e1 >> 1) & 7)) * 8);
#define GLDS16(gp, lp) __builtin_amdgcn_global_load_lds((const unsigned*)(gp), (unsigned*)(lp), 16, 0, 0)
  __syncthreads();
#pragma unroll
  for (int i = 0; i < 4; ++i) {
    int id = tid + i * NT;
    int mm = id >> 10, q = (id >> 3) & 127, ch = (id & 7) * 8;
    *(u32x4*)(qs + (mm * 128 + q) * KP + ch) = *(const u32x4*)(Qg + ((size_t)((b * 4 + head) * 2 + mm) * SS + qb * 128 + q) * 64 + ch);
  }
  GLDS16(K1p + koff, kst + tid * 16);
  GLDS16(K2p + koff, kst + 8192 + tid * 16);
  GLDS16(Vp + voff0, vst + tid * 16);
  GLDS16(Vp + voff1, vst + 8192 + tid * 16);
  if (ntiles > 1) {
    GLDS16(K1p + 64 * 64 + koff, kst + 16384 + tid * 16);
    GLDS16(K2p + 64 * 64 + koff, kst + 16384 + 8192 + tid * 16);
  }
  asm volatile("s_waitcnt vmcnt(0)" ::: "memory");
#pragma unroll
  for (int e = 0; e < 4; ++e)
#pragma unroll
    for (int j = 0; j < 16; ++j) O[e][j] = 0.f;
  float mrun;
  __syncthreads();
  const int sw = (r >> 1) & 7;
  const u16* qrow = qs + (m * 128 + wq * 32 + r) * KP + h * 8;
  f32x16 c0, c1;
  {
    bf16x8 qf[4];
#pragma unroll
    for (int sl = 0; sl < 4; ++sl) qf[sl] = *(const bf16x8*)(qrow + sl * 16);
    const unsigned char* ks_ = kst + m * 8192 + r * 128;
#pragma unroll
    for (int j = 0; j < 16; ++j) { c0[j] = 0.f; c1[j] = 0.f; }
#pragma unroll
    for (int sl = 0; sl < 4; ++sl) {
      const int o = ((sl * 2 + h) ^ sw) * 16;
      c0 = MFMA(*(const bf16x8*)(ks_ + o), qf[sl], c0);
      c1 = MFMA(*(const bf16x8*)(ks_ + 32 * 128 + o), qf[sl], c1);
    }
    float tm = fmaxf(c0[0], c1[0]);
#pragma unroll
    for (int j = 1; j < 16; ++j) tm = fmaxf(tm, fmaxf(c0[j], c1[j]));
    mrun = fmaxf(tm, __shfl_xor(tm, 32));
#pragma unroll
    for (int j = 0; j < 16; ++j) { c0[j] -= mrun; c1[j] -= mrun; }
  }
  float tmax = 0.f;
#define SB_() __builtin_amdgcn_sched_barrier(0)
  f32x16 n0, n1, ninit;
#pragma unroll
  for (int j = 0; j < 16; ++j) ninit[j] = -mrun;
  auto att_step = [&](f32x16& C0, f32x16& C1, f32x16& N0, f32x16& N1, const int kt, const int PAR) __attribute__((always_inline)) {
    const bool has1 = kt + 1 < ntiles, has2 = kt + 2 < ntiles;
    if (__any(tmax > 8.f)) {
      const float d = fmaxf(tmax, 0.f);
      const float alpha = __builtin_amdgcn_exp2f(-d);
      mrun += d;
      lrun *= alpha;
#pragma unroll
      for (int e = 0; e < 4; ++e)
#pragma unroll
        for (int j = 0; j < 16; ++j) O[e][j] *= alpha;
#pragma unroll
      for (int j = 0; j < 16; ++j) { C0[j] -= d; C1[j] -= d; ninit[j] = -mrun; }
    }
    if (has2) {
      const int k0 = (kt + 2) * 64;
      GLDS16(K1p + (size_t)k0 * 64 + koff, kst + PAR * 16384 + tid * 16);
      GLDS16(K2p + (size_t)k0 * 64 + koff, kst + PAR * 16384 + 8192 + tid * 16);
    }
    if (has1) {
      const int k0 = (kt + 1) * 64;
      GLDS16(Vp + k0 + voff0, vst + (PAR ^ 1) * 16384 + tid * 16);
      GLDS16(Vp + k0 + voff1, vst + (PAR ^ 1) * 16384 + 8192 + tid * 16);
    }
    const unsigned char* ks_ = kst + (PAR ^ 1) * 16384 + m * 8192 + r * 128;
    const unsigned char* vts = vst + PAR * 16384 + r * 128;
    bf16x8 kf[8], qf[4];
#pragma unroll
    for (int sl = 0; sl < 4; ++sl) {
      const int o = ((sl * 2 + h) ^ sw) * 16;
      kf[2 * sl] = *(const bf16x8*)(ks_ + o); kf[2 * sl + 1] = *(const bf16x8*)(ks_ + 32 * 128 + o);
      qf[sl] = *(const bf16x8*)(qrow + sl * 16);
    }
    SB_();
    N0 = MFMA(kf[0], qf[0], ninit);
    N1 = MFMA(kf[1], qf[0], ninit);
#pragma unroll
    for (int sl = 1; sl < 4; ++sl) { N0 = MFMA(kf[2 * sl], qf[sl], N0); N1 = MFMA(kf[2 * sl + 1], qf[sl], N1); }
    float psum = 0.f;
#pragma unroll
    for (int j = 0; j < 16; ++j) { C0[j] = __builtin_amdgcn_exp2f(C0[j]); psum += C0[j]; }
    bf16x8 pf[4];
#pragma unroll
    for (int q2 = 0; q2 < 2; ++q2) {
      u32x4 pk;
      pk[0] = pack2(C0[8 * q2 + 0], C0[8 * q2 + 1]); pk[1] = pack2(C0[8 * q2 + 2], C0[8 * q2 + 3]);
      pk[2] = pack2(C0[8 * q2 + 4], C0[8 * q2 + 5]); pk[3] = pack2(C0[8 * q2 + 6], C0[8 * q2 + 7]);
      pf[q2] = __builtin_bit_cast(bf16x8, pk);
    }
    SB_();
    bf16x8 vf[8];
#pragma unroll
    for (int q2 = 0; q2 < 2; ++q2)
#pragma unroll
      for (int e = 0; e < 4; ++e) vf[q2 * 4 + e] = *(const bf16x8*)(vts + e * 4096 + (((q2 * 2 + h) ^ sw) * 16));
    SB_();
#pragma unroll
    for (int q2 = 0; q2 < 2; ++q2)
#pragma unroll
      for (int e = 0; e < 4; ++e) O[e] = MFMA(vf[q2 * 4 + e], pf[q2], O[e]);
#pragma unroll
    for (int j = 0; j < 16; ++j) { C1[j] = __builtin_amdgcn_exp2f(C1[j]); psum += C1[j]; }
    lrun += psum;
#pragma unroll
    for (int q2 = 0; q2 < 2; ++q2) {
      u32x4 pk;
      pk[0] = pack2(C1[8 * q2 + 0], C1[8 * q2 + 1]); pk[1] = pack2(C1[8 * q2 + 2], C1[8 * q2 + 3]);
      pk[2] = pack2(C1[8 * q2 + 4], C1[8 * q2 + 5]); pk[3] = pack2(C1[8 * q2 + 6], C1[8 * q2 + 7]);
      pf[2 + q2] = __builtin_bit_cast(bf16x8, pk);
    }
    SB_();
#pragma unroll
    for (int q2 = 0; q2 < 2; ++q2)
#pragma unroll
      for (int e = 0; e < 4; ++e) vf[q2 * 4 + e] = *(const bf16x8*)(vts + e * 4096 + (((4 + q2 * 2 + h) ^ sw) * 16));
    SB_();
#pragma unroll
    for (int q2 = 0; q2 < 2; ++q2)
#pragma unroll
      for (int e = 0; e < 4; ++e) O[e] = MFMA(vf[q2 * 4 + e], pf[2 + q2], O[e]);
    {
      int mi = max(__builtin_bit_cast(int, N0[0]), __builtin_bit_cast(int, N1[0]));
#pragma unroll
      for (int j = 1; j < 16; ++j) mi = max(mi, max(__builtin_bit_cast(int, N0[j]), __builtin_bit_cast(int, N1[j])));
      mi = max(mi, __shfl_xor(mi, 32));
      tmax = __builtin_bit_cast(float, mi);
    }
    SB_();
    asm volatile("s_waitcnt vmcnt(0)" ::: "memory");
    __syncthreads();
  };
  for (int kt2 = 0; kt2 < ntiles; kt2 += 2) {
    att_step(c0, c1, n0, n1, kt2, 0);
    att_step(n0, n1, c0, c1, kt2 + 1, 1);
  }
#undef SB_
#undef GLDS16
  }
  const int tid_e = opaque_tid();
  const int lane = tid_e & 63, w = tid_e >> 6, r = lane & 31, h = lane >> 5, m = w & 1, wq = w >> 1;
  const int sq = qb * 128 + wq * 32 + r;
  const float lam = ((const float*)(P.ws + OFF_CNT))[1];
  const float lt = lrun + __shfl_xor(lrun, 32);
  float* xch = (float*)smem + wq * 4096;
  if (m == 1) {
    const float i2 = lam / lt;
#pragma unroll
    for (int e = 0; e < 4; ++e)
#pragma unroll
      for (int j = 0; j < 16; ++j) xch[(e * 16 + j) * 64 + lane] = O[e][j] * i2;
  }
  __syncthreads();
  if (m == 0) {
    const float i1 = 1.f / lt;
    float ssq = 0.f;
#pragma unroll
    for (int e = 0; e < 4; ++e)
#pragma unroll
      for (int j = 0; j < 16; ++j) { float a = O[e][j] * i1 - xch[(e * 16 + j) * 64 + lane]; O[e][j] = a; ssq += a * a; }
    ssq += __shfl_xor(ssq, 32);
    const float rstd = rsqrtf(ssq * (1.f / 128.f) + EPSN) * 0.8f;
    const size_t tok = (size_t)b * SS + sq;
    const u16* agp = (const u16*)(P.ws + OFF_AG) + tok * 512 + head * 128;
    u16* mixp = (u16*)(P.ws + OFF_XN) + tok * DM + 512 + head * 128;
    const float* sw = P.in[20];
#pragma unroll
    for (int e = 0; e < 4; ++e)
#pragma unroll
      for (int g = 0; g < 4; ++g) {
        const int e0 = e * 32 + 8 * g + 4 * h;
        u32x2 ag = *(const u32x2*)(agp + e0);
        float a0 = O[e][4 * g + 0] * rstd * sw[e0 + 0] * silu_f(bf2f((u16)(ag[0] & 0xffff)));
        float a1 = O[e][4 * g + 1] * rstd * sw[e0 + 1] * silu_f(bf2f((u16)(ag[0] >> 16)));
        float a2 = O[e][4 * g + 2] * rstd * sw[e0 + 2] * silu_f(bf2f((u16)(ag[1] & 0xffff)));
        float a3 = O[e][4 * g + 3] * rstd * sw[e0 + 3] * silu_f(bf2f((u16)(ag[1] >> 16)));
        u32x2 o; o[0] = pack2(a0, a1); o[1] = pack2(a2, a3);
        *(u32x2*)(mixp + e0) = o;
      }
  }
  __syncthreads();
}

__device__ __forceinline__ void phase_mixers(const Params& P, unsigned char* smem) {
  int* cnt = (int*)(P.ws + OFF_CNT);
  __shared__ int s_item;
  const int n_attl = NB * 4 * 128, n_hyl = 512, n_attc = NB * 4 * 2, n_hyc = 512;
  const int total = n_attl + n_hyl + n_attc + n_hyc;
  for (;;) {
    __syncthreads();
    if (threadIdx.x == 0) s_item = atomicAdd(cnt, 1);
    __syncthreads();
    int it = s_item;
    if (it >= total) break;
    const bool attc = (it >= n_attl + n_hyl) && (it < n_attl + n_hyl + n_attc);
    const bool attl = (it >= n_hyl) && (it < n_attl + n_hyl);
    if (attl || attc) {
      int bh = attc ? ((it - n_attl - n_hyl) >> 1) : (it - n_hyl) / 128;
      int qb = attc ? ((it - n_attl - n_hyl) & 1) : 2 + (it - n_hyl) % 128;
      for (int rep = 0; rep < ATT_REP; ++rep) attn_item(P, bh >> 2, bh & 3, qb, smem);
    }
#ifndef NO_HYL
    else if (it < n_hyl) hyena_latent_item(P, it, smem);
#endif
#ifndef NO_HYC
    else if (it >= n_attl + n_hyl + n_attc) hyena_ctx_item(P, it - n_attl - n_hyl - n_attc, smem);
#endif
  }
}

__device__ __forceinline__ void phase_hygate(const Params& P, unsigned char* smem) {
  const int tid = opaque_tid();
  float* tile = (float*)smem;
  const u16* hyt = (const u16*)(P.ws + OFF_HYT);
  const u16* hg = (const u16*)(P.ws + OFF_HG);
  u16* mix = (u16*)(P.ws + OFF_XN);
  for (int it = blockIdx.x; it < NB * 260 * 8; it += gridDim.x) {
    int ct = it & 7, stile = (it >> 3) % 260, b = it / (8 * 260);
    __syncthreads();
    {
      int ci = tid >> 3, sg = (tid & 7) * 8;
      u32x4 v = *(const u32x4*)(hyt + ((size_t)b * 1536 + ct * 64 + ci) * SS + stile * 64 + sg);
#pragma unroll
      for (int i = 0; i < 4; ++i) { tile[ci * 65 + sg + 2 * i] = bf2f((u16)(v[i] & 0xffff)); tile[ci * 65 + sg + 2 * i + 1] = bf2f((u16)(v[i] >> 16)); }
    }
    __syncthreads();
    {
      int si = tid >> 3, cg8 = (tid & 7) * 8;
      size_t tok = (size_t)b * SS + stile * 64 + si;
      u32x4 g = *(const u32x4*)(hg + tok * 512 + ct * 64 + cg8);
      u32x4 o;
#pragma unroll
      for (int i = 0; i < 4; ++i) {
        float a0 = tile[(cg8 + 2 * i) * 65 + si] * silu_f(bf2f((u16)(g[i] & 0xffff)));
        float a1 = tile[(cg8 + 2 * i + 1) * 65 + si] * silu_f(bf2f((u16)(g[i] >> 16)));
        o[i] = pack2(a0, a1);
      }
      *(u32x4*)(mix + tok * DM + ct * 64 + cg8) = o;
    }
  }
}

__device__ __forceinline__ void phase_conv(const Params& P, bool do_store) {
  const int tid = opaque_tid();
  u16* xbc = (u16*)(P.ws + OFF_XBC);
  const u16* halo = (const u16*)(P.ws + OFF_HALO);
  const float* cw = P.in[22]; const float* cb = P.in[23];
  for (int it = blockIdx.x; it < 260 * 16; it += gridDim.x) {
    const int tile = it >> 4, chunk = it & 15;
    const int sub = tid >> 5, cg8 = tid & 31;
    const int ch = chunk * 256 + cg8 * 8;
    const int row0 = tile * 128 + sub * 8;
    const int s_first = (tile * 128) % SS;
    u32x4 rows[10];
    u32 zz = 0; asm volatile("" : "+v"(zz));
    __syncthreads();
#pragma unroll
    for (int i = 0; i < 10; ++i) {
      int row = row0 - 1 + i;
      u32x4 v = {zz, zz, zz, zz};
      if (row < tile * 128) {
        if (!(s_first == 0 || s_first == CT)) v = *(const u32x4*)(halo + ((size_t)(tile - 1) * 2 + 1) * 4096 + ch);
      } else if (row >= tile * 128 + 128) {
        int s_last = s_first + 127;
        if (!(s_last == CT - 1 || s_last == SS - 1)) v = *(const u32x4*)(halo + ((size_t)(tile + 1) * 2 + 0) * 4096 + ch);
      } else v = *(const u32x4*)(xbc + (size_t)row * 4096 + ch);
      rows[i] = v;
    }
    __syncthreads();
    float w0[8], w1[8], w2[8], bb[8];
#pragma unroll
    for (int e = 0; e < 8; ++e) { w0[e] = cw[ch + e]; w1[e] = cw[4096 + ch + e]; w2[e] = cw[8192 + ch + e]; bb[e] = cb[ch + e]; }
#pragma unroll
    for (int i = 0; i < 8; ++i) {
      u32x4 o;
#pragma unroll
      for (int e2 = 0; e2 < 4; ++e2) {
        float r[2];
#pragma unroll
        for (int p = 0; p < 2; ++p) {
          int e = e2 * 2 + p;
          u32 a = rows[i][e2], bq = rows[i + 1][e2], cq = rows[i + 2][e2];
          float xa = p ? bf2f((u16)(a >> 16)) : bf2f((u16)(a & 0xffff));
          float xb = p ? bf2f((u16)(bq >> 16)) : bf2f((u16)(bq & 0xffff));
          float xc = p ? bf2f((u16)(cq >> 16)) : bf2f((u16)(cq & 0xffff));
          r[p] = silu_f(w0[e] * xa + w1[e] * xb + w2[e] * xc + bb[e]);
        }
        o[e2] = pack2(r[0], r[1]);
      }
      if (do_store) *(u32x4*)(xbc + (size_t)(row0 + i) * 4096 + ch) = o;
    }
  }
}

__device__ __forceinline__ void wave_scan4(float a[4], float& total) {
  a[1] += a[0]; a[2] += a[1]; a[3] += a[2];
  float t = a[3];
  const int lane = threadIdx.x & 63;
#pragma unroll
  for (int o = 1; o < 64; o <<= 1) { float u = __shfl_up(t, o); if (lane >= o) t += u; }
  float excl = t - a[3];
  a[0] += excl; a[1] += excl; a[2] += excl; a[3] += excl;
  total = __shfl(t, 63);
}

constexpr int XP = 136;

__device__ __forceinline__ void stage_xt(const u16* __restrict__ xbc, size_t tok0, int g, u16* XT) {
  const int tid_ = opaque_tid(); const int lane = tid_ & 63, w = tid_ >> 6;
  const int tg = w & 1, hh = w >> 1;
  const int s = tg * 64 + lane;
  const u16* src = xbc + (tok0 + s) * 4096 + g * 256 + hh * 64;
#pragma unroll
  for (int it = 0; it < 8; ++it) {
    u32x4 v = *(const u32x4*)(src + it * 8);
#pragma unroll
    for (int i = 0; i < 4; ++i) {
      XT[(hh * 64 + it * 8 + 2 * i) * XP + s] = (u16)(v[i] & 0xffff);
      XT[(hh * 64 + it * 8 + 2 * i + 1) * XP + s] = (u16)(v[i] >> 16);
    }
  }
}
__device__ __forceinline__ void stage_rows(const u16* __restrict__ xbc, size_t tok0, int coloff, u16* R) {
  const int tid = opaque_tid();
#pragma unroll
  for (int i = 0; i < 4; ++i) {
    int id = tid + i * NT;
    int s = id >> 4, c8 = (id & 15) * 8;
    *(u32x4*)(R + s * XP + c8) = *(const u32x4*)(xbc + (tok0 + s) * 4096 + coloff + c8);
  }
}

__device__ __forceinline__ void phase_ssd1(const Params& P, unsigned char* smem) {
  const int tid = opaque_tid(), lane = tid & 63, w = tid >> 6;
  const int r = lane & 31, h = lane >> 5;
  u16* XT = (u16*)smem;
  u16* BT = XT + 256 * XP;
  float* wgt = (float*)(BT + 128 * XP);
  const u16* xbc = (const u16*)(P.ws + OFF_XBC);
  const float* dt = (const float*)(P.ws + OFF_DT);
  float* dec = (float*)(P.ws + OFF_DEC);
  const int dir = w >> 2, hh = w & 3;
  for (int it = blockIdx.x; it < NB * 65 * 8; it += gridDim.x) {
    const int g = it & 7, c = (it >> 3) % 65, b = it / (8 * 65);
    const int head = g * 4 + hh;
    const size_t tok0 = (size_t)b * SS + (size_t)c * 256;
    const float Ah = -expf(P.in[25][dir * 32 + head]);
    __syncthreads();
    {
      float a[4], d4[4], tot;
#pragma unroll
      for (int i = 0; i < 4; ++i) { d4[i] = dt[(tok0 + lane * 4 + i) * 64 + dir * 32 + head]; a[i] = d4[i] * Ah; }
      float a_raw[4] = {a[0], a[1], a[2], a[3]};
      wave_scan4(a, tot);
#pragma unroll
      for (int i = 0; i < 4; ++i) {
        float te = (dir == 0) ? __expf(tot - a[i]) : __expf(a[i] - a_raw[i]);
        wgt[w * 256 + lane * 4 + i] = d4[i] * te;
      }
      if (lane == 0) dec[((dir * 2 + b) * 65 + c) * 32 + head] = __expf(tot);
    }
    f32x16 acc[2][4];
#pragma unroll
    for (int i = 0; i < 2; ++i)
#pragma unroll
      for (int j = 0; j < 4; ++j)
#pragma unroll
        for (int e = 0; e < 16; ++e) acc[i][j][e] = 0.f;
    for (int half = 0; half < 2; ++half) {
      __syncthreads();
      stage_xt(xbc, tok0 + half * 128, g, XT);
      {
        const int tg = w & 1, nq = w >> 1;
        const int s = tg * 64 + lane;
        const u16* src = xbc + (tok0 + half * 128 + s) * 4096 + 2048 + g * 128 + nq * 32;
#pragma unroll
        for (int i4 = 0; i4 < 4; ++i4) {
          u32x4 v = *(const u32x4*)(src + i4 * 8);
#pragma unroll
          for (int i = 0; i < 4; ++i) {
            BT[(nq * 32 + i4 * 8 + 2 * i) * XP + s] = (u16)(v[i] & 0xffff);
            BT[(nq * 32 + i4 * 8 + 2 * i + 1) * XP + s] = (u16)(v[i] >> 16);
          }
        }
      }
      __syncthreads();
#pragma unroll 2
      for (int sl = 0; sl < 8; ++sl) {
        const float* wp = wgt + w * 256 + half * 128 + sl * 16 + h * 8;
        float wv[8];
#pragma unroll
        for (int j = 0; j < 8; ++j) wv[j] = wp[j];
        bf16x8 af[2];
#pragma unroll
        for (int pt = 0; pt < 2; ++pt) {
          u32x4 xv = *(const u32x4*)(XT + (hh * 64 + pt * 32 + r) * XP + sl * 16 + h * 8);
          u32x4 sv;
#pragma unroll
          for (int i = 0; i < 4; ++i)
            sv[i] = pack2(bf2f((u16)(xv[i] & 0xffff)) * wv[2 * i], bf2f((u16)(xv[i] >> 16)) * wv[2 * i + 1]);
          af[pt] = __builtin_bit_cast(bf16x8, sv);
        }
#pragma unroll
        for (int nt = 0; nt < 4; ++nt) {
          bf16x8 bfr = *(const bf16x8*)(BT + (nt * 32 + r) * XP + sl * 16 + h * 8);
#pragma unroll
          for (int pt = 0; pt < 2; ++pt) acc[pt][nt] = MFMA(af[pt], bfr, acc[pt][nt]);
        }
      }
    }
    u16* G = (c == 0) ? ((u16*)(P.ws + OFF_GCTX) + (size_t)((dir * 2 + b) * 32 + head) * 8192)
                      : ((u16*)P.out + ((size_t)((dir * 2 + b) * 64 + (c - 1)) * 32 + head) * 8192);
#pragma unroll
    for (int pt = 0; pt < 2; ++pt)
#pragma unroll
      for (int nt = 0; nt < 4; ++nt)
#pragma unroll
        for (int j = 0; j < 16; ++j) {
          int p = pt * 32 + (j & 3) + 8 * (j >> 2) + 4 * h;
          G[p * 128 + nt * 32 + r] = f2bf(acc[pt][nt][j]);
        }
  }
}

__device__ __forceinline__ void phase_scan(const Params& P, bool do_store) {
  const float* dec = (const float*)(P.ws + OFF_DEC);
  const u16* gctx = (const u16*)(P.ws + OFF_GCTX);
  u16* st = (u16*)P.out;
  for (int v = blockIdx.x * NT + opaque_tid(); v < 131072; v += gridDim.x * NT) {
    const int pn8 = v & 1023, hd = (v >> 10) & 31, db = v >> 15;
    const int dir = db >> 1;
    float S[8];
    {
      u32x4 gv = *(const u32x4*)(gctx + ((size_t)db * 32 + hd) * 8192 + pn8 * 8);
#pragma unroll
      for (int i = 0; i < 4; ++i) { S[2 * i] = bf2f((u16)(gv[i] & 0xffff)); S[2 * i + 1] = bf2f((u16)(gv[i] >> 16)); }
    }
    u16* base = st + ((size_t)db * 64 * 32 + hd) * 8192 + pn8 * 8;
    const float* dbase = dec + (db * 65 + 1) * 32 + hd;
    for (int k0 = 0; k0 < 64; k0 += 8) {
      u32x4 gv[8]; float dd[8];
#pragma unroll
      for (int u = 0; u < 8; ++u) {
        const int ci = (dir == 0) ? (k0 + u) : 63 - (k0 + u);
        gv[u] = *(const u32x4*)(base + (size_t)ci * 32 * 8192);
        dd[u] = dbase[ci * 32];
      }
#pragma unroll
      for (int u = 0; u < 8; ++u) {
        const int ci = (dir == 0) ? (k0 + u) : 63 - (k0 + u);
        u32x4 sv;
#pragma unroll
        for (int i = 0; i < 4; ++i) sv[i] = pack2(S[2 * i], S[2 * i + 1]);
        if (do_store) *(u32x4*)(base + (size_t)ci * 32 * 8192) = sv;
#pragma unroll
        for (int i = 0; i < 4; ++i) {
          S[2 * i] = dd[u] * S[2 * i] + bf2f((u16)(gv[u][i] & 0xffff));
          S[2 * i + 1] = dd[u] * S[2 * i + 1] + bf2f((u16)(gv[u][i] >> 16));
        }
      }
    }
  }
}

__device__ __forceinline__ void phase_ssd3(const Params& P, unsigned char* smem, bool do_store) {
  const int tid = opaque_tid(), lane = tid & 63, w = tid >> 6;
  const int r = lane & 31, h = lane >> 5;
  u16* CS = (u16*)smem;
  u16* BS = CS + 128 * XP;
  u16* XT = BS + 128 * XP;
  float* cum = (float*)(XT + 256 * XP);
  float* dtl = cum + 8 * 256;
  float* red = (float*)BS;
  const u16* xbc = (const u16*)(P.ws + OFF_XBC);
  const float* dt = (const float*)(P.ws + OFF_DT);
  const u16* states = (const u16*)P.out;
  u16* zb = (u16*)(P.ws + OFF_ZB);
  const int hh = w & 3, lh = w >> 2;
  for (int it = blockIdx.x; it < NB * 128 * 8; it += gridDim.x) {
    const int g = it & 7, rblk = (it >> 3) & 127, b = it >> 10;
    const int c = rblk >> 1, rb = rblk & 1;
    const size_t tokc = (size_t)b * SS + CT + (size_t)c * 256;
    const int head = g * 4 + hh;
    __syncthreads();
    {
      const int dir = w >> 2;
      const int hd = g * 4 + (w & 3);
      const float Ah = -expf(P.in[25][dir * 32 + hd]);
      float a[4], d4[4], tot;
#pragma unroll
      for (int i = 0; i < 4; ++i) { d4[i] = dt[(tokc + lane * 4 + i) * 64 + dir * 32 + hd]; a[i] = d4[i] * Ah; }
      float a_raw[4] = {a[0], a[1], a[2], a[3]};
      wave_scan4(a, tot);
#pragma unroll
      for (int i = 0; i < 4; ++i) {
        cum[w * 256 + lane * 4 + i] = (dir == 0) ? a[i] : (tot - a[i] + a_raw[i]);
        dtl[w * 256 + lane * 4 + i] = d4[i];
      }
    }
    stage_rows(xbc, tokc + rb * 128, 3072 + g * 128, CS);
    __syncthreads();
    f32x16 acc[2][2];
#pragma unroll
    for (int i = 0; i < 2; ++i)
#pragma unroll
      for (int j = 0; j < 2; ++j)
#pragma unroll
        for (int e = 0; e < 16; ++e) acc[i][j][e] = 0.f;
#pragma unroll 1
    for (int dir = 0; dir < 2; ++dir) {
      const u16* Sp = states + (((size_t)(dir * 2 + b) * 64 + c) * 32 + head) * 8192;
      f32x16 tmp[2][2];
#pragma unroll
      for (int i = 0; i < 2; ++i)
#pragma unroll
        for (int j = 0; j < 2; ++j)
#pragma unroll
          for (int e = 0; e < 16; ++e) tmp[i][j][e] = 0.f;
#pragma unroll
      for (int sb4 = 0; sb4 < 2; ++sb4) {
        bf16x8 sf[4][2];
#pragma unroll
        for (int s4 = 0; s4 < 4; ++s4)
#pragma unroll
          for (int pt = 0; pt < 2; ++pt) sf[s4][pt] = *(const bf16x8*)(Sp + (pt * 32 + r) * 128 + (sb4 * 4 + s4) * 16 + h * 8);
        __builtin_amdgcn_sched_barrier(0);
#pragma unroll
        for (int s4 = 0; s4 < 4; ++s4) {
          bf16x8 cf[2];
#pragma unroll
          for (int li = 0; li < 2; ++li) cf[li] = *(const bf16x8*)(CS + ((lh * 2 + li) * 32 + r) * XP + (sb4 * 4 + s4) * 16 + h * 8);
#pragma unroll
          for (int pt = 0; pt < 2; ++pt)
#pragma unroll
            for (int li = 0; li < 2; ++li) tmp[pt][li] = MFMA(sf[s4][pt], cf[li], tmp[pt][li]);
        }
      }
#pragma unroll
      for (int li = 0; li < 2; ++li) {
        const float sc = __expf(cum[(dir * 4 + hh) * 256 + rb * 128 + (lh * 2 + li) * 32 + r]);
#pragma unroll
        for (int pt = 0; pt < 2; ++pt)
#pragma unroll
          for (int e = 0; e < 16; ++e) acc[pt][li][e] += tmp[pt][li][e] * sc;
      }
    }
#pragma unroll 1
    for (int sb = 0; sb < 2; ++sb) {
      __syncthreads();
      stage_rows(xbc, tokc + sb * 128, 2048 + g * 128, BS);
      stage_xt(xbc, tokc + sb * 128, g, XT);
      __syncthreads();
#pragma unroll 1
      for (int st = 0; st < 4; ++st) {
#pragma unroll
        for (int li = 0; li < 2; ++li) {
          const int lt = lh * 2 + li;
          const bool needf = (sb < rb) || (sb == rb && st <= lt);
          const bool needb = (sb > rb) || (sb == rb && st >= lt);
          if (!needf && !needb) continue;
          f32x16 cbt;
#pragma unroll
          for (int e = 0; e < 16; ++e) cbt[e] = 0.f;
#pragma unroll
          for (int sl = 0; sl < 8; ++sl) {
            bf16x8 bfr = *(const bf16x8*)(BS + (st * 32 + r) * XP + sl * 16 + h * 8);
            bf16x8 cfr = *(const bf16x8*)(CS + (lt * 32 + r) * XP + sl * 16 + h * 8);
            cbt = MFMA(bfr, cfr, cbt);
          }
          const int lidx = rb * 128 + lt * 32 + r;
#pragma unroll 1
          for (int dir = 0; dir < 2; ++dir) {
            if (dir == 0 ? !needf : !needb) continue;
            const float* cu = cum + (dir * 4 + hh) * 256;
            const float* dl = dtl + (dir * 4 + hh) * 256;
            const float cl = cu[lidx];
            float mv[16];
#pragma unroll
            for (int j = 0; j < 16; ++j) {
              const int sidx = sb * 128 + st * 32 + (j & 3) + 8 * (j >> 2) + 4 * h;
              const bool valid = (dir == 0) ? (sidx <= lidx) : (sidx >= lidx);
              const float e = __expf(fminf(cl - cu[sidx], 0.f));
              mv[j] = valid ? cbt[j] * e * dl[sidx] : 0.f;
            }
#pragma unroll
            for (int q2 = 0; q2 < 2; ++q2) {
              u32x4 pk;
#pragma unroll
              for (int i = 0; i < 4; ++i) pk[i] = pack2(mv[8 * q2 + 2 * i], mv[8 * q2 + 2 * i + 1]);
              bf16x8 mf = __builtin_bit_cast(bf16x8, pk);
              const int kb = st * 32 + q2 * 16 + 4 * h;
#pragma unroll
              for (int pt = 0; pt < 2; ++pt) {
                u32x2 lo = *(const u32x2*)(XT + (hh * 64 + pt * 32 + r) * XP + kb);
                u32x2 hi = *(const u32x2*)(XT + (hh * 64 + pt * 32 + r) * XP + kb + 8);
                u32x4 vv; vv[0] = lo[0]; vv[1] = lo[1]; vv[2] = hi[0]; vv[3] = hi[1];
                acc[pt][li] = MFMA(__builtin_bit_cast(bf16x8, vv), mf, acc[pt][li]);
              }
            }
          }
        }
      }
    }
    __syncthreads();
    const float Dsum = P.in[26][head] + P.in[26][32 + head];
    float ssq[2] = {0.f, 0.f};
#pragma unroll
    for (int li = 0; li < 2; ++li) {
      const int l = rb * 128 + (lh * 2 + li) * 32 + r;
      const size_t tok = tokc + l;
      const size_t zrow = ((size_t)b * LL + (size_t)c * 256 + l) * 2048 + head * 64;
#pragma unroll
      for (int pt = 0; pt < 2; ++pt)
#pragma unroll
        for (int gq = 0; gq < 4; ++gq) {
          const int p0 = pt * 32 + 8 * gq + 4 * h;
          u32x2 xv = *(const u32x2*)(xbc + tok * 4096 + head * 64 + p0);
          u32x2 zv = *(const u32x2*)(zb + zrow + p0);
          float xs[4] = {bf2f((u16)(xv[0] & 0xffff)), bf2f((u16)(xv[0] >> 16)), bf2f((u16)(xv[1] & 0xffff)), bf2f((u16)(xv[1] >> 16))};
          float zs[4] = {bf2f((u16)(zv[0] & 0xffff)), bf2f((u16)(zv[0] >> 16)), bf2f((u16)(zv[1] & 0xffff)), bf2f((u16)(zv[1] >> 16))};
#pragma unroll
          for (int i = 0; i < 4; ++i) {
            float y = (acc[pt][li][4 * gq + i] + Dsum * xs[i]) * silu_f(zs[i]);
            acc[pt][li][4 * gq + i] = y;
            ssq[li] += y * y;
          }
        }
      ssq[li] += __shfl_xor(ssq[li], 32);
      if (h == 0) red[hh * 128 + (lh * 2 + li) * 32 + r] = ssq[li];
    }
    __syncthreads();
    const float* gw = P.in[27];
#pragma unroll
    for (int li = 0; li < 2; ++li) {
      const int ll = (lh * 2 + li) * 32 + r;
      const float tot = red[ll] + red[128 + ll] + red[256 + ll] + red[384 + ll];
      const float rstd = rsqrtf(tot * (1.f / 256.f) + EPSN);
      const int l = rb * 128 + ll;
      const size_t zrow = ((size_t)b * LL + (size_t)c * 256 + l) * 2048 + head * 64;
#pragma unroll
      for (int pt = 0; pt < 2; ++pt)
#pragma unroll
        for (int gq = 0; gq < 4; ++gq) {
          const int p0 = pt * 32 + 8 * gq + 4 * h;
          const float* gp = gw + head * 64 + p0;
          u32x2 o;
          o[0] = pack2(acc[pt][li][4 * gq + 0] * rstd * gp[0], acc[pt][li][4 * gq + 1] * rstd * gp[1]);
          o[1] = pack2(acc[pt][li][4 * gq + 2] * rstd * gp[2], acc[pt][li][4 * gq + 3] * rstd * gp[3]);
          if (do_store) *(u32x2*)(zb + zrow + p0) = o;
        }
    }
  }
}

__device__ __forceinline__ void phase_final(const Params& P) {
  const int tid_ = opaque_tid(); const int lane = tid_ & 63, wv = tid_ >> 6;
  const float* nw = P.in[29];
  for (int it = blockIdx.x; it < NB * LL / 8; it += gridDim.x) {
    float* row = P.out + (size_t)(it * 8 + wv) * DM;
    float4 v[4];
    float ss = 0.f;
#pragma unroll
    for (int i = 0; i < 4; ++i) {
      v[i] = *(const float4*)(row + i * 256 + lane * 4);
      ss += v[i].x * v[i].x + v[i].y * v[i].y + v[i].z * v[i].z + v[i].w * v[i].w;
    }
    ss = wave_sum(ss);
    float rstd = rsqrtf(ss * (1.f / DM) + EPSN);
#pragma unroll
    for (int i = 0; i < 4; ++i) {
      float4 w = *(const float4*)(nw + i * 256 + lane * 4);
      float4 o = make_float4(v[i].x * rstd * w.x, v[i].y * rstd * w.y, v[i].z * rstd * w.z, v[i].w * rstd * w.w);
      *(float4*)(row + i * 256 + lane * 4) = o;
    }
  }
}


#define XB_TMO      128
#define XB_XCNT(j)  (256  + 64 * (j))
#define XB_XSUB(j)  (1280 + 64 * (j))
#define XB_XGEN(j)  (2304 + 64 * (j))
#define XB_TOP      3328
#define XB_TOPGEN   3392
#define XCD_BAR_WORDS 3456
#define XB_SPIN_CAP (1u << 18)
#define LAS __attribute__((address_space(3)))
__device__ __forceinline__ unsigned xb_ld(unsigned* p)              { return __hip_atomic_load(p, __ATOMIC_RELAXED, __HIP_MEMORY_SCOPE_AGENT); }
__device__ __forceinline__ unsigned xb_add(unsigned* p, unsigned v) { return __hip_atomic_fetch_add(p, v, __ATOMIC_RELAXED, __HIP_MEMORY_SCOPE_AGENT); }
__device__ __forceinline__ unsigned xb_xcc_id() { return (unsigned)__builtin_amdgcn_s_getreg((3 << 11) | 20) & 0xFu; }
#define XB_SPIN(cond, bar) do { unsigned _sp = 0; while (cond) { __builtin_amdgcn_s_sleep(1); \
    if ((++_sp & 255u) == 0u) { if (xb_ld(&(bar)[XB_TMO])) break; if (_sp > XB_SPIN_CAP) { atomicAdd(&(bar)[XB_TMO], 1u); break; } } } } while (0)
struct XcdBarrier { unsigned* bar; unsigned x; volatile LAS unsigned* st; };
__device__ __forceinline__ XcdBarrier xcd_barrier_post(unsigned* bar, volatile LAS unsigned* st) {
  XcdBarrier b; b.bar = bar; b.x = xb_xcc_id(); b.st = st;
  if (threadIdx.x == 0) (void)xb_add(&bar[XB_XCNT(b.x)], 1u);
  return b;
}
__device__ __forceinline__ void xcd_barrier_complete(unsigned* bar, unsigned x, unsigned& nloc, unsigned& nx) {
  const unsigned G = gridDim.x * gridDim.y * gridDim.z;
  unsigned sum, cnt, mine, sp = 0u;
  for (;;) {
    sum = 0u; cnt = 0u; mine = 0u;
#pragma unroll
    for (unsigned j = 0; j < 16; ++j) { const unsigned c = xb_ld(&bar[XB_XCNT(j)]); sum += c; cnt += (c > 0u) ? 1u : 0u; mine = (j == x) ? c : mine; }
    if (sum == G) break;
    __builtin_amdgcn_s_sleep(1);
    if ((++sp & 255u) == 0u) { if (xb_ld(&bar[XB_TMO])) break; if (sp > XB_SPIN_CAP) { atomicAdd(&bar[XB_TMO], 1u); break; } }
  }
  nloc = mine > 0u ? mine : 1u; nx = cnt > 0u ? cnt : 1u;
}
__device__ __forceinline__ void xcd_barrier(const XcdBarrier& b) {
  asm volatile("s_waitcnt vmcnt(0)" ::: "memory");
  __syncthreads();
  if (threadIdx.x == 0) {
    unsigned* bar = b.bar;
    __builtin_amdgcn_s_waitcnt(0);
    unsigned nloc = b.st[0], nx = b.st[1];
    if (nloc == 0u) { xcd_barrier_complete(bar, b.x, nloc, nx); b.st[0] = nloc; b.st[1] = nx; }
    const unsigned old = xb_add(&bar[XB_XSUB(b.x)], 1u);
    const unsigned gen = old / nloc;
    if (old + 1u == (gen + 1u) * nloc) {
      __builtin_amdgcn_fence(__ATOMIC_RELEASE, "agent");
      asm volatile("s_waitcnt vmcnt(0)" ::: "memory");
      const unsigned og = xb_add(&bar[XB_TOP], 1u);
      const unsigned tg = og / nx;
      if (og + 1u == (tg + 1u) * nx) xb_add(&bar[XB_TOPGEN], 1u);
      else XB_SPIN(xb_ld(&bar[XB_TOPGEN]) == tg, bar);
      __builtin_amdgcn_fence(__ATOMIC_ACQUIRE, "agent");
      xb_add(&bar[XB_XGEN(b.x)], 1u);
      asm volatile("s_waitcnt vmcnt(0)" ::: "memory");
    } else {
      XB_SPIN(xb_ld(&bar[XB_XGEN(b.x)]) == gen, bar);
      __builtin_amdgcn_fence(__ATOMIC_ACQUIRE, "agent");
      asm volatile("s_waitcnt vmcnt(0)" ::: "memory");
    }
  }
  __syncthreads();
}

__global__ void __launch_bounds__(NT) fwd_kernel(Params P) {
  extern __shared__ __attribute__((aligned(16))) unsigned char smem[];
  __shared__ uint4 xb_words;
  if (threadIdx.x == 0) xb_words = make_uint4(0u, 0u, 0u, 0u);
  __syncthreads();
  XcdBarrier xb = xcd_barrier_post((unsigned*)(P.ws + OFF_BAR), (volatile LAS unsigned*)&xb_words);
  for (int ph = P.ph_lo; ph < P.ph_hi; ++ph) {
    switch (ph) {
#if !defined(PHASE_ONLY) || PHASE_ONLY == 0
      case 0: for (int rep = 0; rep < MISC_REP; ++rep) phase_prep(P, smem); break;
#endif
#if !defined(PHASE_ONLY) || PHASE_ONLY == 1
      case 1: for (int rep = 0; rep < MISC_REP; ++rep) { phase_norm(P, 0, (u16*)(P.ws + OFF_XN)); phase_filter(P, smem); } break;
#endif
#if !defined(PHASE_ONLY) || PHASE_ONLY == 2
      case 2: for (int rep = 0; rep < GEMM_REP; ++rep) gemm_phase<0>(P, (const u16*)(P.ws + OFF_XN), DM, (const u16*)(P.ws + OFF_WEIN), DM, DM, NTOK / 256, 16, smem); break;
#endif
#if !defined(PHASE_ONLY) || PHASE_ONLY == 3
      case 3: phase_mixers(P, smem); break;
#endif
#if !defined(PHASE_ONLY) || PHASE_ONLY == 4
      case 4: phase_hygate(P, smem); break;
#endif
#if !defined(PHASE_ONLY) || PHASE_ONLY == 5
      case 5: for (int rep = 0; rep < GEMM_REP; ++rep) gemm_phase<1>(P, (const u16*)(P.ws + OFF_XN), DM, (const u16*)(P.ws + OFF_WEOUT), DM, DM, NTOK / 256, 4, smem); break;
#endif
#if !defined(PHASE_ONLY) || PHASE_ONLY == 6
      case 6: phase_norm(P, 1, (u16*)P.out); break;
#endif
#if !defined(PHASE_ONLY) || PHASE_ONLY == 7
      case 7: for (int rep = 0; rep < GEMM_REP; ++rep) gemm_phase<2>(P, (const u16*)P.out, DM, (const u16*)(P.ws + OFF_WOIN), DM, DM, NTOK / 256, 25, smem); break;
#endif
#if !defined(PHASE_ONLY) || PHASE_ONLY == 8
      case 8: for (int rep = 0; rep < TAIL_REP; ++rep) phase_conv(P, rep == TAIL_REP - 1); break;
#endif
#if !defined(PHASE_ONLY) || PHASE_ONLY == 9
      case 9: for (int rep = 0; rep < SSD1_REP; ++rep) phase_ssd1(P, smem); break;
#endif
#if !defined(PHASE_ONLY) || PHASE_ONLY == 10
      case 10: for (int rep = 0; rep < TAIL_REP; ++rep) phase_scan(P, rep == TAIL_REP - 1); break;
#endif
#if !defined(PHASE_ONLY) || PHASE_ONLY == 11
      case 11: for (int rep = 0; rep < TAIL_REP; ++rep) phase_ssd3(P, smem, rep == TAIL_REP - 1); break;
#endif
#if !defined(PHASE_ONLY) || PHASE_ONLY == 12
      case 12: for (int rep = 0; rep < GEMM_REP; ++rep) gemm_phase<3>(P, (const u16*)(P.ws + OFF_ZB), 2048, (const u16*)(P.ws + OFF_WOOUT), 2048, 2048, NB * LL / 256, 4, smem); break;
#endif
#if !defined(PHASE_ONLY) || PHASE_ONLY == 13
      case 13: phase_final(P); break;
#endif
    }
    if (ph + 1 < P.ph_hi) {
      if (P.ph_lo < 0) cg::this_grid().sync();
      xcd_barrier(xb);
    }
  }
}

extern "C" void kernel_launch(void* const* d_in, const int* in_sizes, int n_in, void* d_out, int out_size,
                              void* d_ws, size_t ws_size, hipStream_t stream) {
  static int grid = 0;
  if (grid == 0) {
    if (n_in != 30 || ws_size < OFF_END) { fprintf(stderr, "kernel_launch: unexpected n_in %d / ws %zu\n", n_in, ws_size); grid = -1; return; }
    int dev = 0, cus = 0, per_cu = 0;
    hipGetDevice(&dev);
    hipDeviceGetAttribute(&cus, hipDeviceAttributeMultiprocessorCount, dev);
    if (hipFuncSetAttribute((const void*)fwd_kernel, hipFuncAttributeMaxDynamicSharedMemorySize, LDS_BYTES) != hipSuccess) {
      fprintf(stderr, "kernel_launch: hipFuncSetAttribute failed\n"); grid = -1; return; }
    hipOccupancyMaxActiveBlocksPerMultiprocessor(&per_cu, (const void*)fwd_kernel, NT, LDS_BYTES);
    if (per_cu < 1) { fprintf(stderr, "kernel_launch: occupancy query says %d\n", per_cu); per_cu = 1; }
    (void)hipGetLastError();
    grid = cus * 1;
  }
  if (grid < 0) return;
  Params p{};
  for (int i = 0; i < 30; ++i) p.in[i] = (const float*)d_in[i];
  p.out = (float*)d_out;
  p.ws = (unsigned char*)d_ws;
#if ONE_LAUNCH
  (void)hipMemsetAsync((unsigned char*)d_ws + OFF_BAR, 0, XCD_BAR_WORDS * 4, stream);
  p.ph_lo = 0; p.ph_hi = NPH;
  void* args[] = {&p};
  hipError_t e = hipLaunchCooperativeKernel((const void*)fwd_kernel, dim3(grid), dim3(NT), args, LDS_BYTES, stream);
  if (e != hipSuccess) fprintf(stderr, "cooperative launch failed: %s (grid %d)\n", hipGetErrorString(e), grid);
#else
  for (int ph = 0; ph < NPH; ++ph) {
    p.ph_lo = ph; p.ph_hi = ph + 1;
    hipLaunchKernelGGL(fwd_kernel, dim3(grid), dim3(NT), LDS_BYTES, stream, p);
  }
#endif
}
```

```cpp
#include <hip/hip_runtime.h>
#include <hip/hip_cooperative_groups.h>
#include <cstdio>
#include <cstdint>
namespace cg = cooperative_groups;

#ifndef ONE_LAUNCH
#define ONE_LAUNCH 1
#endif

typedef unsigned short u16;
typedef unsigned int u32;
using bf16x8 = __attribute__((ext_vector_type(8))) short;
using s16x4  = __attribute__((ext_vector_type(4))) short;
using f32x16 = __attribute__((ext_vector_type(16))) float;
using u32x4  = __attribute__((ext_vector_type(4))) unsigned;
using u32x2  = __attribute__((ext_vector_type(2))) unsigned;

#ifndef ATT_REP
#define ATT_REP 1
#endif
#ifndef HYL_REP
#define HYL_REP 1
#endif
#ifndef GEMM_REP
#define GEMM_REP 1
#endif
#ifndef MISC_REP
#define MISC_REP 1
#endif
#ifndef TAIL_REP
#define TAIL_REP 2
#endif
#ifndef SSD1_REP
#define SSD1_REP 1
#endif
#define NT 512
constexpr int DM = 1024;
constexpr int NB = 2;
constexpr int LL = 16384;
constexpr int CT = 256;
constexpr int SS = LL + CT;
constexpr int NTOK = NB * SS;
constexpr float EPSN = 1e-6f;
constexpr int NPH = 14;

constexpr size_t MiB = 1048576;
constexpr size_t OFF_WEIN = 0, OFF_WEOUT = 8 * MiB, OFF_WOIN = 10 * MiB, OFF_WOOUT = 23 * MiB;
constexpr size_t OFF_MODS = 27 * MiB;
constexpr size_t OFF_CNT = 27 * MiB + 128 * 1024;
constexpr size_t OFF_ROPE = 27 * MiB + 160 * 1024;
constexpr size_t OFF_DEC = 27 * MiB + 256 * 1024;
constexpr size_t OFF_BAR = 27 * MiB + 768 * 1024;
constexpr size_t OFF_H2 = 28 * MiB;
constexpr size_t OFF_KRAW256 = 33 * MiB;
constexpr size_t OFF_GCTX = 35 * MiB;
constexpr size_t OFF_BIG = 37 * MiB;
constexpr size_t SZ_HYT = (size_t)NB * 1536 * SS * 2;
constexpr size_t SZ_TOK512 = (size_t)NTOK * 512 * 2;
constexpr size_t OFF_HYT = OFF_BIG, OFF_HG = OFF_HYT + SZ_HYT, OFF_AG = OFF_HG + SZ_TOK512;
constexpr size_t OFF_Q = OFF_AG + SZ_TOK512, OFF_K = OFF_Q + SZ_TOK512, OFF_VT = OFF_K + SZ_TOK512;
constexpr size_t OFF_XBC = OFF_BIG;
constexpr size_t OFF_ZREG = 297 * MiB;
constexpr size_t OFF_XN = OFF_ZREG;
constexpr size_t OFF_FFTS = OFF_ZREG + 65 * MiB;
constexpr size_t OFF_ZB = OFF_ZREG;
constexpr size_t OFF_OUT0 = 425 * MiB;
constexpr size_t OFF_DT = 490 * MiB;
constexpr size_t OFF_HALO = 499 * MiB;
constexpr size_t OFF_END = 504 * MiB;

constexpr int LDS_BYTES = 156672;

struct Params {
  const float* in[30];
  float* out;
  unsigned char* ws;
  int ph_lo, ph_hi;
};

__device__ __forceinline__ u16 f2bf(float f) { return __builtin_bit_cast(u16, (__bf16)f); }
__device__ __forceinline__ float bf2f(u16 h) { return __uint_as_float(((u32)h) << 16); }
typedef float f32x2_t __attribute__((ext_vector_type(2)));
typedef __bf16 bf16x2_t __attribute__((ext_vector_type(2)));
__device__ __forceinline__ u32 pack2(float a, float b) {
  f32x2_t v = {a, b};
  bf16x2_t r = __builtin_convertvector(v, bf16x2_t);
  return __builtin_bit_cast(u32, r);
}
__device__ __forceinline__ float silu_f(float x) { return x * __builtin_amdgcn_rcpf(1.f + __expf(-x)); }
__device__ __forceinline__ float softplus_f(float x) {
  float y = __expf(-fabsf(x));
  float l = (y < 1e-2f) ? y * (1.f - y * (0.5f - y * (1.f / 3.f))) : __logf(1.f + y);
  return fmaxf(x, 0.f) + l;
}
__device__ __forceinline__ int opaque_tid() { int t = threadIdx.x; asm volatile("" : "+v"(t)); return t; }
#define MFMA(a, b, c) __builtin_amdgcn_mfma_f32_32x32x16_bf16((a), (b), (c), 0, 0, 0)

__device__ __forceinline__ float wave_sum(float v) {
#pragma unroll
  for (int o = 32; o >= 1; o >>= 1) v += __shfl_xor(v, o);
  return v;
}
__device__ __forceinline__ float block_sum(float v, float* red) {
  v = wave_sum(v);
  __syncthreads();
  if ((threadIdx.x & 63) == 0) red[threadIdx.x >> 6] = v;
  __syncthreads();
  float t = 0.f;
#pragma unroll
  for (int i = 0; i < 8; ++i) t += red[i];
  return t;
}

__device__ __forceinline__ void transpose_tile(const float* __restrict__ W, int K, int N, u16* __restrict__ Wt, int kt, int nt, float* tile) {
  const int tid = opaque_tid();
  {
    int k = tid >> 3, ng = (tid & 7) * 8;
    const float* src = W + (size_t)(kt * 64 + k) * N + nt * 64 + ng;
    float4 a = *(const float4*)src, b = *(const float4*)(src + 4);
    float* d = tile + k * 65 + ng;
    d[0] = a.x; d[1] = a.y; d[2] = a.z; d[3] = a.w; d[4] = b.x; d[5] = b.y; d[6] = b.z; d[7] = b.w;
  }
  __syncthreads();
  {
    int n = tid >> 3, kg = (tid & 7) * 8;
    u32x4 o;
    o[0] = pack2(tile[(kg + 0) * 65 + n], tile[(kg + 1) * 65 + n]);
    o[1] = pack2(tile[(kg + 2) * 65 + n], tile[(kg + 3) * 65 + n]);
    o[2] = pack2(tile[(kg + 4) * 65 + n], tile[(kg + 5) * 65 + n]);
    o[3] = pack2(tile[(kg + 6) * 65 + n], tile[(kg + 7) * 65 + n]);
    *(u32x4*)(Wt + (size_t)(nt * 64 + n) * K + kt * 64 + kg) = o;
  }
  __syncthreads();
}

__device__ __forceinline__ void phase_prep(const Params& P, unsigned char* smem) {
  const int tid = opaque_tid();
  float* fs = (float*)smem;
  const int n_wt = 1024 + 256 + 1552 + 512;
  const int i_pad = n_wt, i_mod = i_pad + 1, i_h2 = i_mod + 384, i_misc = i_h2 + 2080, n_items = i_misc + 1;
  float* w1s = fs + 8192;
  float* w2s = w1s + 33 * 64;
  for (int i = tid; i < 33 * 64; i += NT) w1s[i] = P.in[11][i];
  for (int i = tid; i < 64 * 64; i += NT) w2s[i] = P.in[13][i];
  __syncthreads();
  for (int it = blockIdx.x; it < n_items; it += gridDim.x) {
    if (it < n_wt) {
      int t = it;
      if (t < 1024) transpose_tile(P.in[7], 1024, 4096, (u16*)(P.ws + OFF_WEIN), t / 64, t % 64, fs);
      else if ((t -= 1024) < 256) transpose_tile(P.in[8], 1024, 1024, (u16*)(P.ws + OFF_WEOUT), t / 16, t % 16, fs);
      else if ((t -= 256) < 1552) transpose_tile(P.in[21], 1024, 6208, (u16*)(P.ws + OFF_WOIN), t / 97, t % 97, fs);
      else { t -= 1552; transpose_tile(P.in[28], 2048, 1024, (u16*)(P.ws + OFF_WOOUT), t / 16, t % 16, fs); }
    } else if (it == i_pad) {
      u32 zz = 0; asm volatile("" : "+v"(zz));
      u32x4 z = {zz, zz, zz, zz};
      u32x4* d = (u32x4*)(P.ws + OFF_WOIN + (size_t)6208 * 1024 * 2);
      for (int i = tid; i < 192 * 1024 * 2 / 16; i += NT) d[i] = z;
    } else if (it < i_h2) {
      int m = it - i_mod;
      int layer = m / 192, cg16 = m % 192;
      int kg = tid >> 4, col = cg16 * 16 + (tid & 15);
      const float* w = P.in[4] + (size_t)layer * 1024 * 3072;
      float s0 = 0.f, s1 = 0.f, s2 = 0.f;
#pragma unroll 4
      for (int k = kg * 32; k < kg * 32 + 32; ++k) {
        float wv = w[(size_t)k * 3072 + col];
        s0 += silu_f(P.in[1][k]) * wv;
        s1 += silu_f(P.in[1][1024 + k]) * wv;
        s2 += silu_f(P.in[3][k]) * wv;
      }
      __syncthreads();
      fs[(0 * 32 + kg) * 16 + (tid & 15)] = s0;
      fs[(1 * 32 + kg) * 16 + (tid & 15)] = s1;
      fs[(2 * 32 + kg) * 16 + (tid & 15)] = s2;
      __syncthreads();
      if (tid < 48) {
        int v = tid >> 4, c = tid & 15;
        float s = 0.f;
#pragma unroll 4
        for (int g = 0; g < 32; ++g) s += fs[(v * 32 + g) * 16 + c];
        int cc = cg16 * 16 + c;
        ((float*)(P.ws + OFF_MODS))[(layer * 3 + v) * 3072 + cc] = s + P.in[5][layer * 3072 + cc];
      }
      __syncthreads();
    } else if (it < i_misc) {
      int gp = (it - i_h2) * 8 + (tid >> 6);
      int j = tid & 63, pl = tid >> 6;
      int Lp = gp < LL ? LL : CT;
      int t = gp < LL ? gp : gp - LL;
      float* zs = fs;
      float* h1s = fs + 8 * 40;
      __syncthreads();
      if (j < 33) {
        float z;
        if (j == 0) z = (float)t / (float)(Lp - 1);
        else {
          int bi = (j - 1) & 15;
          float band = 1e-4f + (float)bi * ((15.f - 1e-4f) / 15.f);
          float w = 6.283185307179586f * (float)t / (float)Lp;
          float a = band * w;
          z = (j <= 16) ? cosf(a) : -sinf(a);
        }
        zs[pl * 40 + j] = z;
      }
      __syncthreads();
      {
        float a = P.in[12][j];
#pragma unroll 3
        for (int e = 0; e < 33; ++e) a += zs[pl * 40 + e] * w1s[e * 64 + j];
        h1s[pl * 64 + j] = sinf(P.in[17][j] * a);
      }
      __syncthreads();
      {
        float a = P.in[14][j];
#pragma unroll 4
        for (int i = 0; i < 64; ++i) a += h1s[pl * 64 + i] * w2s[i * 64 + j];
        ((float*)(P.ws + OFF_H2))[(size_t)gp * 64 + j] = sinf(P.in[17][64 + j] * a);
      }
      __syncthreads();
    } else {
      for (int i = tid; i < 256 * 16; i += NT) {
        int pos = i >> 4, j = i & 15;
        float inv = exp2f(-(float)j * (13.287712379549449f / 16.f));
        float sn, cs;
        sincosf((float)pos * inv, &sn, &cs);
        ((float2*)(P.ws + OFF_ROPE))[i] = make_float2(cs, sn);
      }
      if (tid == 0) {
        int* cnt = (int*)(P.ws + OFF_CNT);
        cnt[0] = 0;
        const float* lp = P.in[19];
        float a = 0.f, b = 0.f;
        for (int i = 0; i < 64; ++i) { a += lp[i] * lp[64 + i]; b += lp[128 + i] * lp[192 + i]; }
        ((float*)cnt)[1] = expf(a) - expf(b) + 0.2f;
      }
    }
  }
}

__device__ __forceinline__ void phase_norm(const Params& P, int layer, u16* __restrict__ xn) {
  const int tid_ = opaque_tid(); const int lane = tid_ & 63, wv = tid_ >> 6;
  const float* mods = (const float*)(P.ws + OFF_MODS) + (size_t)layer * 3 * 3072;
  const float* nw = P.in[6] + layer * 1024;
  const u16* out0 = (const u16*)(P.ws + OFF_OUT0);
  for (int it = blockIdx.x; it < NTOK / 8; it += gridDim.x) {
    int tok = it * 8 + wv;
    int b = tok / SS, s = tok % SS;
    const float* src = (s < CT) ? (P.in[2] + ((size_t)b * CT + s) * DM) : (P.in[0] + ((size_t)b * LL + (s - CT)) * DM);
    const float* mv = mods + ((s < CT) ? 2 : b) * 3072;
    float4 v[4];
    float ss = 0.f;
#pragma unroll
    for (int i = 0; i < 4; ++i) {
      int col = i * 256 + lane * 4;
      v[i] = *(const float4*)(src + col);
      if (layer == 1) {
        u32x2 d = *(const u32x2*)(out0 + (size_t)tok * DM + col);
        v[i].x += bf2f((u16)(d[0] & 0xffff)); v[i].y += bf2f((u16)(d[0] >> 16));
        v[i].z += bf2f((u16)(d[1] & 0xffff)); v[i].w += bf2f((u16)(d[1] >> 16));
      }
      ss += v[i].x * v[i].x + v[i].y * v[i].y + v[i].z * v[i].z + v[i].w * v[i].w;
    }
    ss = wave_sum(ss);
    float rstd = rsqrtf(ss * (1.f / DM) + EPSN);
#pragma unroll
    for (int i = 0; i < 4; ++i) {
      int col = i * 256 + lane * 4;
      float4 w = *(const float4*)(nw + col);
      float4 sh = *(const float4*)(mv + col);
      float4 sc = *(const float4*)(mv + 1024 + col);
      float a0 = v[i].x * rstd * w.x * (1.f + sc.x) + sh.x;
      float a1 = v[i].y * rstd * w.y * (1.f + sc.y) + sh.y;
      float a2 = v[i].z * rstd * w.z * (1.f + sc.z) + sh.z;
      float a3 = v[i].w * rstd * w.w * (1.f + sc.w) + sh.w;
      u32x2 o; o[0] = pack2(a0, a1); o[1] = pack2(a2, a3);
      *(u32x2*)(xn + (size_t)tok * DM + col) = o;
    }
  }
}

__device__ __forceinline__ void phase_filter(const Params& P, unsigned char* smem) {
  const int tid = opaque_tid();
  float* hs = (float*)smem;
  float* wsm = hs + 128 * 65;
  const float* H2 = (const float*)(P.ws + OFF_H2);
  const float* w3 = P.in[15];
  const float* b3 = P.in[16];
  const int nbig = 128 * 16, nsm = 2 * 16;
  const int tq = tid & 31, cg8 = tid >> 5;
  for (int it = blockIdx.x; it < nbig + nsm; it += gridDim.x) {
    int Lp, tt, ct; float* dst; size_t hoff;
    if (it < nbig) { Lp = LL; tt = it >> 4; ct = it & 15; dst = P.out; hoff = 0; }
    else { int k = it - nbig; Lp = CT; tt = k >> 4; ct = k & 15; dst = (float*)(P.ws + OFF_KRAW256); hoff = (size_t)LL * 64; }
    __syncthreads();
    for (int i = tid; i < 128 * 16; i += NT) {
      int rr = i >> 4, c4 = (i & 15) * 4;
      float4 v = *(const float4*)(H2 + hoff + (size_t)(tt * 128 + rr) * 64 + c4);
      float* d = hs + rr * 65 + c4; d[0] = v.x; d[1] = v.y; d[2] = v.z; d[3] = v.w;
    }
    for (int i = tid; i < 64 * 32; i += NT) {
      int rr = i >> 5, c4 = (i & 31) * 4;
      *(float4*)(wsm + rr * 128 + c4) = *(const float4*)(w3 + (size_t)rr * 2048 + ct * 128 + c4);
    }
    __syncthreads();
    float acc[4][8];
#pragma unroll
    for (int e = 0; e < 8; ++e) { float b = b3[ct * 128 + cg8 * 8 + e]; acc[0][e] = b; acc[1][e] = b; acc[2][e] = b; acc[3][e] = b; }
#pragma unroll 4
    for (int j = 0; j < 64; ++j) {
      float a[4], wv[8];
#pragma unroll
      for (int i = 0; i < 4; ++i) a[i] = hs[(tq + 32 * i) * 65 + j];
      *(float4*)&wv[0] = *(const float4*)(wsm + j * 128 + cg8 * 8);
      *(float4*)&wv[4] = *(const float4*)(wsm + j * 128 + cg8 * 8 + 4);
#pragma unroll
      for (int i = 0; i < 4; ++i)
#pragma unroll
        for (int e = 0; e < 8; ++e) acc[i][e] += a[i] * wv[e];
    }
    const float mind = -3.0701134573253944f, maxd = -15.350567286626972f;
#pragma unroll
    for (int e = 0; e < 8; ++e) {
      const int col = ct * 128 + cg8 * 8 + e;
      const float delta = fabsf(mind + (float)(col & 511) * ((maxd - mind) / 511.f));
#pragma unroll
      for (int i = 0; i < 4; ++i) {
        const int t = tt * 128 + tq + 32 * i;
        const float tlin = (float)t / (float)(Lp - 1);
        dst[(size_t)col * Lp + t] = acc[i][e] * expf(-tlin * delta);
      }
    }
  }
}

constexpr int EP = 36;
template <int MODE>
__device__ __forceinline__ void gemm_epilogue(const Params& P, int row0, int col0, const f32x16& acc, float* wl);

__device__ __forceinline__ void glds_tile(const u16* __restrict__ g, int ld, int k0, unsigned char* ldst, int tid) {
#pragma unroll
  for (int p = 0; p < 4; ++p) {
    const int slot = p * 512 + tid;
    const int row = slot >> 3, kc = (slot & 7) ^ ((row >> 1) & 7);
    unsigned off = (unsigned)(row * ld + kc * 8);
    asm volatile("" : "+v"(off));
    __builtin_amdgcn_global_load_lds((const unsigned*)((g + k0) + off), (unsigned*)(ldst + slot * 16), 16, 0, 0);
  }
}

template <int MODE>
__device__ __forceinline__ void gemm_phase(const Params& P, const u16* __restrict__ A, int lda, const u16* __restrict__ Bt, int ldb,
                           int K, int nMt, int nNt, unsigned char* smem) {
  const int tid = opaque_tid(), lane = tid & 63, w = tid >> 6;
  const int r = lane & 31, h = lane >> 5;
  const int wm = w >> 2, wn = w & 3;
  unsigned char* As = smem;
  unsigned char* Bs = smem + 2 * 32768;
  const int KT = K / 64;
  const int sw = (r >> 1) & 7;
  const int nTiles = nMt * nNt;
  const int bslot = (blockIdx.x & 7) * (gridDim.x >> 3) + (blockIdx.x >> 3);
  for (int tile0 = 0; tile0 < nTiles; tile0 += gridDim.x) {
    const int T = tile0 + ((gridDim.x & 7) ? (int)blockIdx.x : bslot);
    if (T >= nTiles) break;
    int mt, nt;
    {
      const int nig = 8 * nNt, gid = T / nig, fm = gid * 8, gsz = min(nMt - fm, 8), within = T - gid * nig;
      mt = fm + within % gsz; nt = within / gsz;
    }
    int arow0 = mt * 256;
    const u16* Ap = A + (size_t)arow0 * lda;
    const u16* Bp = Bt + (size_t)(nt * 256) * ldb;
    f32x16 acc[4][2];
#pragma unroll
    for (int i = 0; i < 4; ++i)
#pragma unroll
      for (int j = 0; j < 2; ++j)
#pragma unroll
        for (int e = 0; e < 16; ++e) acc[i][j][e] = 0.f;
    __syncthreads();
    glds_tile(Ap, lda, 0, As, tid);
    glds_tile(Bp, ldb, 0, Bs, tid);
    asm volatile("s_waitcnt vmcnt(0)" ::: "memory");
    __syncthreads();
    for (int kt = 0; kt < KT; ++kt) {
      const int buf = kt & 1;
      const unsigned char* as = As + buf * 32768 + (wm * 128 + r) * 128;
      const unsigned char* bs = Bs + buf * 32768 + (wn * 64 + r) * 128;
      bf16x8 af[2][4], bfr[2][2];
      {
        const int o0 = ((0 * 2 + h) ^ sw) * 16;
#pragma unroll
        for (int i = 0; i < 4; ++i) af[0][i] = *(const bf16x8*)(as + i * 4096 + o0);
#pragma unroll
        for (int j = 0; j < 2; ++j) bfr[0][j] = *(const bf16x8*)(bs + j * 4096 + o0);
      }
#pragma unroll
      for (int ks = 0; ks < 4; ++ks) {
        if (ks + 1 < 4) {
          const int o1 = (((ks + 1) * 2 + h) ^ sw) * 16;
#pragma unroll
          for (int i = 0; i < 4; ++i) af[(ks + 1) & 1][i] = *(const bf16x8*)(as + i * 4096 + o1);
#pragma unroll
          for (int j = 0; j < 2; ++j) bfr[(ks + 1) & 1][j] = *(const bf16x8*)(bs + j * 4096 + o1);
        }
        __builtin_amdgcn_sched_barrier(0);
#pragma unroll
        for (int i = 0; i < 4; ++i)
#pragma unroll
          for (int j = 0; j < 2; ++j) acc[i][j] = MFMA(af[ks & 1][i], bfr[ks & 1][j], acc[i][j]);
        __builtin_amdgcn_sched_barrier(0);
        if (ks == 0 && kt + 1 < KT) glds_tile(Ap, lda, (kt + 1) * 64, As + (buf ^ 1) * 32768, tid);
        if (ks == 1 && kt + 1 < KT) glds_tile(Bp, ldb, (kt + 1) * 64, Bs + (buf ^ 1) * 32768, tid);
        __builtin_amdgcn_sched_barrier(0);
      }
      asm volatile("s_waitcnt vmcnt(0)" ::: "memory");
      __syncthreads();
    }
#pragma unroll
    for (int i = 0; i < 4; ++i)
#pragma unroll
      for (int j = 0; j < 2; ++j)
      {
        gemm_epilogue<MODE>(P, arow0 + wm * 128 + i * 32, nt * 256 + wn * 64 + j * 32, acc[i][j], (float*)smem + w * (32 * EP));
        __builtin_amdgcn_sched_barrier(0);
      }
  }
}

__device__ __forceinline__ void lds_wave_fence() { asm volatile("s_waitcnt lgkmcnt(0)" ::: "memory"); }
__device__ __forceinline__ void stage_rowmajor(float* wl, const f32x16& acc, int r, int h) {
#pragma unroll
  for (int j = 0; j < 16; ++j) wl[((j & 3) + 8 * (j >> 2) + 4 * h) * EP + r] = acc[j];
  lds_wave_fence();
}
__device__ __forceinline__ void stage_colmajor(float* wl, const f32x16& acc, int r, int h) {
#pragma unroll
  for (int g = 0; g < 4; ++g) *(float4*)(wl + r * EP + 8 * g + 4 * h) = make_float4(acc[4 * g], acc[4 * g + 1], acc[4 * g + 2], acc[4 * g + 3]);
  lds_wave_fence();
}
__device__ __forceinline__ u32x4 pack8(const float4& a, const float4& b) {
  u32x4 o; o[0] = pack2(a.x, a.y); o[1] = pack2(a.z, a.w); o[2] = pack2(b.x, b.y); o[3] = pack2(b.z, b.w); return o;
}

template <>
__device__ __forceinline__ void gemm_epilogue<0>(const Params& P, int row0, int col0, const f32x16& acc, float* wl) {
  const int lane = opaque_tid() & 63, r = lane & 31, h = lane >> 5;
  const int b = row0 / SS, s0 = row0 % SS;
  if (col0 < 1536 || (col0 >= 3072 && col0 < 3584)) {
    stage_colmajor(wl, acc, r, h);
#pragma unroll
    for (int k = 0; k < 2; ++k) {
      const int id = lane + 64 * k, col = id >> 2, rc = (id & 3) * 8;
      const float4 a = *(const float4*)(wl + col * EP + rc), c = *(const float4*)(wl + col * EP + rc + 4);
      const u32x4 pv8 = pack8(a, c);
      if (col0 < 1536) *(u32x4*)((u16*)(P.ws + OFF_HYT) + ((size_t)b * 1536 + col0 + col) * SS + s0 + rc) = pv8;
      else {
        const int cc = col0 + col - 3072;
        u16* dst = (u16*)(P.ws + OFF_VT) + ((size_t)(b * 4 + (cc >> 7)) * 128 + (cc & 127)) * SS + s0 + (rc & ~15);
        u32x2 lo, hi; lo[0] = pv8[0]; lo[1] = pv8[1]; hi[0] = pv8[2]; hi[1] = pv8[3];
        *(u32x2*)(dst + ((rc & 8) ? 4 : 0)) = lo;
        *(u32x2*)(dst + ((rc & 8) ? 12 : 8)) = hi;
      }
    }
  } else if (col0 < 2048 || col0 >= 3584) {
    stage_rowmajor(wl, acc, r, h);
    u16* base = (col0 < 2048) ? ((u16*)(P.ws + OFF_HG) + (col0 - 1536)) : ((u16*)(P.ws + OFF_AG) + (col0 - 3584));
#pragma unroll
    for (int k = 0; k < 2; ++k) {
      const int id = lane + 64 * k, row = id >> 2, c8 = (id & 3) * 8;
      const float4 a = *(const float4*)(wl + row * EP + c8), c = *(const float4*)(wl + row * EP + c8 + 4);
      *(u32x4*)(base + (size_t)(row0 + row) * 512 + c8) = pack8(a, c);
    }
  } else {
    stage_rowmajor(wl, acc, r, h);
    const bool isq = col0 < 2560;
    const int cc0 = col0 - (isq ? 2048 : 2560);
    const int head = cc0 >> 7, comp = (cc0 >> 6) & 1, dt0 = cc0 & 63;
    u16* base = (u16*)(P.ws + (isq ? OFF_Q : OFF_K)) + ((size_t)((b * 4 + head) * 2 + comp) * SS) * 64 + dt0;
    const float qs = isq ? (0.125f * 1.4426950408889634f) : 1.f;
#pragma unroll
    for (int k = 0; k < 2; ++k) {
      const int id = lane + 64 * k, row = id >> 2, c8 = (id & 3) * 8;
      const int s = s0 + row;
      float v[8], pv[8];
      *(float4*)&v[0] = *(const float4*)(wl + row * EP + c8); *(float4*)&v[4] = *(const float4*)(wl + row * EP + c8 + 4);
      *(float4*)&pv[0] = *(const float4*)(wl + row * EP + (c8 ^ 16)); *(float4*)&pv[4] = *(const float4*)(wl + row * EP + (c8 ^ 16) + 4);
      float o[8];
      if (s >= CT) {
        const int t = s - CT;
        const int pos = (dt0 == 0) ? (t >> 6) : (t & 63);
        const float4* rp = (const float4*)((const float2*)(P.ws + OFF_ROPE) + pos * 16 + (c8 & 15));
        float cs[8], sn[8];
#pragma unroll
        for (int i = 0; i < 4; ++i) { float4 q4 = rp[i]; cs[2 * i] = q4.x; sn[2 * i] = q4.y; cs[2 * i + 1] = q4.z; sn[2 * i + 1] = q4.w; }
        const bool hi16 = (c8 & 16) != 0;
#pragma unroll
        for (int i = 0; i < 8; ++i) o[i] = (hi16 ? (pv[i] * sn[i] + v[i] * cs[i]) : (v[i] * cs[i] - pv[i] * sn[i])) * qs;
      } else {
#pragma unroll
        for (int i = 0; i < 8; ++i) o[i] = v[i] * qs;
      }
      u32x4 ov; ov[0] = pack2(o[0], o[1]); ov[1] = pack2(o[2], o[3]); ov[2] = pack2(o[4], o[5]); ov[3] = pack2(o[6], o[7]);
      *(u32x4*)(base + (size_t)s * 64 + c8) = ov;
    }
  }
}
template <>
__device__ __forceinline__ void gemm_epilogue<1>(const Params& P, int row0, int col0, const f32x16& acc, float* wl) {
  const int lane = opaque_tid() & 63, r = lane & 31, h = lane >> 5;
  const int b = row0 / SS, s0 = row0 % SS;
  stage_rowmajor(wl, acc, r, h);
  const float* gp = (const float*)(P.ws + OFF_MODS) + ((s0 < CT) ? 2 : b) * 3072 + 2048 + col0;
  u16* base = (u16*)(P.ws + OFF_OUT0) + col0;
#pragma unroll
  for (int k = 0; k < 2; ++k) {
    const int id = lane + 64 * k, row = id >> 2, c8 = (id & 3) * 8;
    float4 a = *(const float4*)(wl + row * EP + c8), c = *(const float4*)(wl + row * EP + c8 + 4);
    const float4 g0 = *(const float4*)(gp + c8), g1 = *(const float4*)(gp + c8 + 4);
    a.x *= g0.x; a.y *= g0.y; a.z *= g0.z; a.w *= g0.w; c.x *= g1.x; c.y *= g1.y; c.z *= g1.z; c.w *= g1.w;
    *(u32x4*)(base + (size_t)(row0 + row) * DM + c8) = pack8(a, c);
  }
}
template <>
__device__ __forceinline__ void gemm_epilogue<2>(const Params& P, int row0, int col0, const f32x16& acc, float* wl) {
  const int lane = opaque_tid() & 63, r = lane & 31, h = lane >> 5;
  const int b = row0 / SS, s0 = row0 % SS;
  if (col0 >= 6208) return;
  if (col0 < 2048 && s0 < CT) return;
  stage_rowmajor(wl, acc, r, h);
  if (col0 < 2048) {
    u16* base = (u16*)(P.ws + OFF_ZB) + ((size_t)b * LL + (s0 - CT)) * 2048 + col0;
#pragma unroll
    for (int k = 0; k < 2; ++k) {
      const int id = lane + 64 * k, row = id >> 2, c8 = (id & 3) * 8;
      const float4 a = *(const float4*)(wl + row * EP + c8), c = *(const float4*)(wl + row * EP + c8 + 4);
      *(u32x4*)(base + (size_t)row * 2048 + c8) = pack8(a, c);
    }
  } else if (col0 < 6144) {
    const int cc0 = col0 - 2048;
    u16* base = (u16*)(P.ws + OFF_XBC) + cc0;
    u16* halo = (u16*)(P.ws + OFF_HALO) + cc0;
#pragma unroll
    for (int k = 0; k < 2; ++k) {
      const int id = lane + 64 * k, row = id >> 2, c8 = (id & 3) * 8;
      const float4 a = *(const float4*)(wl + row * EP + c8), c = *(const float4*)(wl + row * EP + c8 + 4);
      const u32x4 ov = pack8(a, c);
      const int tok = row0 + row;
      *(u32x4*)(base + (size_t)tok * 4096 + c8) = ov;
      const int m = tok & 127;
      if (m == 0) *(u32x4*)(halo + ((size_t)(tok >> 7) * 2 + 0) * 4096 + c8) = ov;
      if (m == 127) *(u32x4*)(halo + ((size_t)(tok >> 7) * 2 + 1) * 4096 + c8) = ov;
    }
  } else {
    const int cc0 = col0 - 6144;
    const float* bp = P.in[24] + cc0;
    float* base = (float*)(P.ws + OFF_DT) + cc0;
#pragma unroll
    for (int k = 0; k < 2; ++k) {
      const int id = lane + 64 * k, row = id >> 2, c8 = (id & 3) * 8;
      float4 a = *(const float4*)(wl + row * EP + c8), c = *(const float4*)(wl + row * EP + c8 + 4);
      const float4 b0 = *(const float4*)(bp + c8), b1 = *(const float4*)(bp + c8 + 4);
      a.x = softplus_f(a.x + b0.x); a.y = softplus_f(a.y + b0.y); a.z = softplus_f(a.z + b0.z); a.w = softplus_f(a.w + b0.w);
      c.x = softplus_f(c.x + b1.x); c.y = softplus_f(c.y + b1.y); c.z = softplus_f(c.z + b1.z); c.w = softplus_f(c.w + b1.w);
      float* d = base + (size_t)(row0 + row) * 64 + c8;
      *(float4*)d = a; *(float4*)(d + 4) = c;
    }
  }
}
template <>
__device__ __forceinline__ void gemm_epilogue<3>(const Params& P, int row0, int col0, const f32x16& acc, float* wl) {
  const int lane = opaque_tid() & 63, r = lane & 31, h = lane >> 5;
  const int b = row0 / LL, t0 = row0 % LL;
  stage_rowmajor(wl, acc, r, h);
  const float* gp = (const float*)(P.ws + OFF_MODS) + 3 * 3072 + b * 3072 + 2048 + col0;
  const u16* o0 = (const u16*)(P.ws + OFF_OUT0) + ((size_t)b * SS + CT + t0) * DM + col0;
  const float* xin = P.in[0] + (size_t)row0 * DM + col0;
  float* dst = P.out + (size_t)row0 * DM + col0;
#pragma unroll
  for (int k = 0; k < 4; ++k) {
    const int id = lane + 64 * k, row = id >> 3, c4 = (id & 7) * 4;
    const float4 a = *(const float4*)(wl + row * EP + c4);
    const float4 g = *(const float4*)(gp + c4);
    const float4 x = *(const float4*)(xin + (size_t)row * DM + c4);
    const u32x2 ob = *(const u32x2*)(o0 + (size_t)row * DM + c4);
    float4 o;
    o.x = x.x + bf2f((u16)(ob[0] & 0xffff)) + g.x * a.x;
    o.y = x.y + bf2f((u16)(ob[0] >> 16)) + g.y * a.y;
    o.z = x.z + bf2f((u16)(ob[1] & 0xffff)) + g.z * a.z;
    o.w = x.w + bf2f((u16)(ob[1] >> 16)) + g.w * a.w;
    *(float4*)(dst + (size_t)row * DM + c4) = o;
  }
}

__device__ __forceinline__ float2 cmul(float2 a, float2 b) { return make_float2(a.x * b.x - a.y * b.y, a.x * b.y + a.y * b.x); }

__device__ __forceinline__ void bf4_fwd(float2& a0, float2& a1, float2& a2, float2& a3) {
  float2 t0 = make_float2(a0.x + a2.x, a0.y + a2.y), t1 = make_float2(a0.x - a2.x, a0.y - a2.y);
  float2 t2 = make_float2(a1.x + a3.x, a1.y + a3.y), t3 = make_float2(a1.x - a3.x, a1.y - a3.y);
  a0 = make_float2(t0.x + t2.x, t0.y + t2.y); a2 = make_float2(t0.x - t2.x, t0.y - t2.y);
  a1 = make_float2(t1.x + t3.y, t1.y - t3.x);
  a3 = make_float2(t1.x - t3.y, t1.y + t3.x);
}
__device__ __forceinline__ void bf4_inv(float2& a0, float2& a1, float2& a2, float2& a3) {
  float2 t0 = make_float2(a0.x + a2.x, a0.y + a2.y), t1 = make_float2(a0.x - a2.x, a0.y - a2.y);
  float2 t2 = make_float2(a1.x + a3.x, a1.y + a3.y), t3 = make_float2(a1.x - a3.x, a1.y - a3.y);
  a0 = make_float2(t0.x + t2.x, t0.y + t2.y); a2 = make_float2(t0.x - t2.x, t0.y - t2.y);
  a1 = make_float2(t1.x - t3.y, t1.y + t3.x);
  a3 = make_float2(t1.x + t3.y, t1.y - t3.x);
}
template <bool INV>
__device__ __forceinline__ void fft_pass4(float2* X, const int lq, const int tid) {
  const int q = 1 << lq;
  for (int i = tid; i < 4096; i += NT) {
    int blk = i >> lq, j = i & (q - 1);
    int base = (blk << (lq + 2)) + j;
    float sn, cs;
    sincospif(2.f * (float)j / (float)(4 * q), &sn, &cs);
    const float2 w1 = make_float2(cs, INV ? sn : -sn);
    const float2 w2 = cmul(w1, w1), w3 = cmul(w2, w1);
    float2 a0 = X[base], a1 = X[base + q], a2 = X[base + 2 * q], a3 = X[base + 3 * q];
    if (!INV) { bf4_fwd(a0, a1, a2, a3); a1 = cmul(a1, w1); a2 = cmul(a2, w2); a3 = cmul(a3, w3); }
    else { a1 = cmul(a1, w1); a2 = cmul(a2, w2); a3 = cmul(a3, w3); bf4_inv(a0, a1, a2, a3); }
    X[base] = a0; X[base + q] = a1; X[base + 2 * q] = a2; X[base + 3 * q] = a3;
  }
}
template <bool INV>
__device__ __forceinline__ void fft_pass16(float2* X, const int lq, const int tid) {
  const int q = 1 << lq, qq = q >> 2, lqq = lq - 2;
  const float sg = INV ? 1.f : -1.f;
#pragma unroll 1
  for (int i = tid; i < 1024; i += NT) {
    const int blk = i >> lqq, jp = i & (qq - 1);
    const int base = (blk << (lq + 2)) + jp;
    float2 e[4][4];
#pragma unroll
    for (int a = 0; a < 4; ++a)
#pragma unroll
      for (int b = 0; b < 4; ++b) e[a][b] = X[base + a * q + b * qq];
    float sn, cs;
    sincospif(2.f * (float)jp / (float)(4 * q), &sn, &cs);
    const float2 wj = make_float2(cs, sg * sn);
    const float2 wj2 = cmul(wj, wj), w4 = cmul(wj2, wj2);
    const float2 w42 = cmul(w4, w4), w43 = cmul(w42, w4);
    const float2 c16[4] = {make_float2(1.f, 0.f), make_float2(0.92387953251128674f, sg * 0.38268343236508977f),
                           make_float2(0.70710678118654752f, sg * 0.70710678118654752f), make_float2(0.38268343236508977f, sg * 0.92387953251128674f)};
    if (!INV) {
#pragma unroll
      for (int b = 0; b < 4; ++b) {
        const float2 w1 = cmul(wj, c16[b]), w2 = cmul(w1, w1), w3 = cmul(w2, w1);
        bf4_fwd(e[0][b], e[1][b], e[2][b], e[3][b]);
        e[1][b] = cmul(e[1][b], w1); e[2][b] = cmul(e[2][b], w2); e[3][b] = cmul(e[3][b], w3);
      }
#pragma unroll
      for (int a = 0; a < 4; ++a) {
        bf4_fwd(e[a][0], e[a][1], e[a][2], e[a][3]);
        e[a][1] = cmul(e[a][1], w4); e[a][2] = cmul(e[a][2], w42); e[a][3] = cmul(e[a][3], w43);
      }
    } else {
#pragma unroll
      for (int a = 0; a < 4; ++a) {
        e[a][1] = cmul(e[a][1], w4); e[a][2] = cmul(e[a][2], w42); e[a][3] = cmul(e[a][3], w43);
        bf4_inv(e[a][0], e[a][1], e[a][2], e[a][3]);
      }
#pragma unroll
      for (int b = 0; b < 4; ++b) {
        const float2 w1 = cmul(wj, c16[b]), w2 = cmul(w1, w1), w3 = cmul(w2, w1);
        e[1][b] = cmul(e[1][b], w1); e[2][b] = cmul(e[2][b], w2); e[3][b] = cmul(e[3][b], w3);
        bf4_inv(e[0][b], e[1][b], e[2][b], e[3][b]);
      }
    }
#pragma unroll
    for (int a = 0; a < 4; ++a)
#pragma unroll
      for (int b = 0; b < 4; ++b) X[base + a * q + b * qq] = e[a][b];
  }
}
__device__ __forceinline__ void fft_fwd(float2* X) {
  const int tid = opaque_tid();
  __syncthreads(); fft_pass16<false>(X, 12, tid);
  __syncthreads(); fft_pass16<false>(X, 8, tid);
  __syncthreads(); fft_pass16<false>(X, 4, tid);
  __syncthreads(); fft_pass4<false>(X, 0, tid);
  __syncthreads();
}
__device__ __forceinline__ void fft_fwd_noq1(float2* X) {
  const int tid = opaque_tid();
  __syncthreads(); fft_pass16<false>(X, 12, tid);
  __syncthreads(); fft_pass16<false>(X, 8, tid);
  __syncthreads(); fft_pass16<false>(X, 4, tid);
  __syncthreads();
}
__device__ __forceinline__ void fft_inv_noq1(float2* X) {
  const int tid = opaque_tid();
  __syncthreads(); fft_pass16<true>(X, 4, tid);
  __syncthreads(); fft_pass16<true>(X, 8, tid);
  __syncthreads(); fft_pass16<true>(X, 12, tid);
  __syncthreads();
}
__device__ __forceinline__ void fft_inv(float2* X) {
  const int tid = opaque_tid();
  __syncthreads(); fft_pass4<true>(X, 0, tid);
  __syncthreads(); fft_pass16<true>(X, 4, tid);
  __syncthreads(); fft_pass16<true>(X, 8, tid);
  __syncthreads(); fft_pass16<true>(X, 12, tid);
  __syncthreads();
}

__device__ __forceinline__ float conv3(const u16* row, int n, int Ls, float w0, float w1, float w2, float bias) {
  float a = bias + w1 * bf2f(row[n]);
  if (n > 0) a += w0 * bf2f(row[n - 1]);
  if (n + 1 < Ls) a += w2 * bf2f(row[n + 1]);
  return a;
}

__device__ __forceinline__ void conv3x4(const u16* __restrict__ row, int n, int Ls, float w0, float w1, float w2, float bias, float out[4]) {
  const u32x2 v = *(const u32x2*)(row + n);
  const float x0 = bf2f((u16)(v[0] & 0xffff)), x1 = bf2f((u16)(v[0] >> 16)), x2 = bf2f((u16)(v[1] & 0xffff)), x3 = bf2f((u16)(v[1] >> 16));
  const float xm = (n > 0) ? bf2f(row[n - 1]) : 0.f;
  const float xp = (n + 4 < Ls) ? bf2f(row[n + 4]) : 0.f;
  out[0] = bias + w0 * xm + w1 * x0 + w2 * x1;
  out[1] = bias + w0 * x0 + w1 * x1 + w2 * x2;
  out[2] = bias + w0 * x1 + w1 * x2 + w2 * x3;
  out[3] = bias + w0 * x2 + w1 * x3 + w2 * xp;
}
__device__ __forceinline__ void ld4c(const float2* p, float2 o[4]) {
  const float4 a = *(const float4*)p, b = *(const float4*)(p + 2);
  o[0] = make_float2(a.x, a.y); o[1] = make_float2(a.z, a.w); o[2] = make_float2(b.x, b.y); o[3] = make_float2(b.z, b.w);
}
__device__ __forceinline__ void st4c(float2* p, const float2 o[4]) {
  *(float4*)p = make_float4(o[0].x, o[0].y, o[1].x, o[1].y);
  *(float4*)(p + 2) = make_float4(o[2].x, o[2].y, o[3].x, o[3].y);
}

__device__ __forceinline__ void hyena_latent_item(const Params& P, int c, unsigned char* smem) {
  const int tid = opaque_tid();
  float2* X = (float2*)smem;
  float* red = (float*)(smem + 131072);
  unsigned char* scr = P.ws + OFF_FFTS + (size_t)blockIdx.x * (512 * 1024);
  float2* ABUF = (float2*)scr; float2* ZBUF = ABUF + LL;
  u16* hyt = (u16*)(P.ws + OFF_HYT);
  const float* sw = P.in[9]; const float* sb = P.in[10];
  const float* kraw = P.out;
  const float invL = 1.f / (float)LL;
  for (int rep = 0; rep < HYL_REP; ++rep)
  for (int o = 0; o < 2; ++o) {
    const float* hf = kraw + (size_t)((0 * 2 + o) * 512 + c) * LL;
    const float* hb = kraw + (size_t)((1 * 2 + o) * 512 + c) * LL;
    float2 E[32];
    __syncthreads();
    if (o == 0) {
      const float v0w = sw[0 * 1536 + c], v1w = sw[1 * 1536 + c], v2w = sw[2 * 1536 + c], vbs = sb[c];
      const u16* r0 = hyt + ((size_t)0 * 1536 + c) * SS + CT;
      const u16* r1 = hyt + ((size_t)1 * 1536 + c) * SS + CT;
      for (int n = opaque_tid() * 4; n < LL; n += NT * 4) {
        float a[4], b4[4]; float2 xv[4];
        conv3x4(r0, n, LL, v0w, v1w, v2w, vbs, a);
        conv3x4(r1, n, LL, v0w, v1w, v2w, vbs, b4);
#pragma unroll
        for (int i = 0; i < 4; ++i) xv[i] = make_float2(a[i], b4[i]);
        st4c(ZBUF + n, xv);
        st4c(X + n, xv);
      }
    } else {
      for (int n = opaque_tid() * 4; n < LL; n += NT * 4) { float2 xv[4]; ld4c(ZBUF + n, xv); st4c(X + n, xv); }
    }
    fft_fwd_noq1(X);
#pragma unroll
    for (int k = 0; k < 8; ++k) {
      ld4c(X + (tid + k * NT) * 4, &E[4 * k]);
      bf4_fwd(E[4 * k], E[4 * k + 1], E[4 * k + 2], E[4 * k + 3]);
    }
    float ns = 0.f;
    for (int n = opaque_tid() * 4; n < LL; n += NT * 4) {
      const float4 f4 = *(const float4*)(hf + n), b4 = *(const float4*)(hb + LL - n - 4);
      const float kf[4] = {f4.x, f4.y, f4.z, f4.w};
      const float kb[4] = {(n > 0) ? hb[LL - n] : 0.f, b4.w, b4.z, b4.y};
      float2 xv[4];
#pragma unroll
      for (int i = 0; i < 4; ++i) { ns += fabsf(kf[i]) + fabsf(kb[i]); xv[i] = make_float2(kf[i] + kb[i], 0.f); }
      st4c(X + n, xv);
    }
    const float inn = 1.f / block_sum(ns, red);
    fft_fwd_noq1(X);
#pragma unroll
    for (int k = 0; k < 8; ++k) {
      float2 xv[4]; ld4c(X + (tid + k * NT) * 4, xv);
      bf4_fwd(xv[0], xv[1], xv[2], xv[3]);
#pragma unroll
      for (int i = 0; i < 4; ++i) { float2 v = cmul(xv[i], E[4 * k + i]); xv[i] = make_float2(v.x * inn, v.y * inn); }
      bf4_inv(xv[0], xv[1], xv[2], xv[3]);
      st4c(X + (tid + k * NT) * 4, xv);
    }
    fft_inv_noq1(X);
    for (int n = opaque_tid() * 4; n < LL; n += NT * 4) {
      float2 xa[4], zv[4];
      ld4c(X + n, xa);
      st4c(ABUF + n, xa);
      ld4c(ZBUF + n, zv);
#pragma unroll
      for (int i = 0; i < 4; ++i) {
        float sn, cs; sincospif((float)(n + i) * invL, &sn, &cs);
        xa[i] = cmul(zv[i], make_float2(cs, -sn));
      }
      st4c(X + n, xa);
    }
    fft_fwd_noq1(X);
#pragma unroll
    for (int k = 0; k < 8; ++k) {
      ld4c(X + (tid + k * NT) * 4, &E[4 * k]);
      bf4_fwd(E[4 * k], E[4 * k + 1], E[4 * k + 2], E[4 * k + 3]);
    }
    for (int n = opaque_tid() * 4; n < LL; n += NT * 4) {
      const float4 f4 = *(const float4*)(hf + n), b4 = *(const float4*)(hb + LL - n - 4);
      const float kf[4] = {f4.x, f4.y, f4.z, f4.w};
      const float kb[4] = {(n > 0) ? hb[LL - n] : 0.f, b4.w, b4.z, b4.y};
      float2 xv[4];
#pragma unroll
      for (int i = 0; i < 4; ++i) {
        float sn, cs; sincospif((float)(n + i) * invL, &sn, &cs);
        const float d = kf[i] - kb[i];
        xv[i] = make_float2(d * cs, -d * sn);
      }
      st4c(X + n, xv);
    }
    fft_fwd_noq1(X);
#pragma unroll
    for (int k = 0; k < 8; ++k) {
      float2 xv[4]; ld4c(X + (tid + k * NT) * 4, xv);
      bf4_fwd(xv[0], xv[1], xv[2], xv[3]);
#pragma unroll
      for (int i = 0; i < 4; ++i) { float2 v = cmul(xv[i], E[4 * k + i]); xv[i] = make_float2(v.x * inn, v.y * inn); }
      bf4_inv(xv[0], xv[1], xv[2], xv[3]);
      st4c(X + (tid + k * NT) * 4, xv);
    }
    fft_inv_noq1(X);
    const int colg = (o == 0 ? 512 : 1024) + c;
    const float g0w = sw[0 * 1536 + colg], g1w = sw[1 * 1536 + colg], g2w = sw[2 * 1536 + colg], gbs = sb[colg];
    const u16* q0 = hyt + ((size_t)0 * 1536 + colg) * SS + CT;
    const u16* q1 = hyt + ((size_t)1 * 1536 + colg) * SS + CT;
    const float hbias = P.in[18][o * 512 + c];
    const float sc = 0.5f * invL;
    for (int n = opaque_tid() * 4; n < LL; n += NT * 4) {
      float2 bx[4], av[4], xv[4];
      float ga[4], gb[4];
      ld4c(X + n, bx); ld4c(ABUF + n, av); ld4c(ZBUF + n, xv);
      conv3x4(q0, n, LL, g0w, g1w, g2w, gbs, ga);
      conv3x4(q1, n, LL, g0w, g1w, g2w, gbs, gb);
#pragma unroll
      for (int i = 0; i < 4; ++i) {
        float sn, cs; sincospif((float)(n + i) * invL, &sn, &cs);
        const float2 bv = cmul(bx[i], make_float2(cs, sn));
        const float y0 = ((av[i].x + bv.x) * sc + xv[i].x * hbias) * ga[i];
        const float y1 = ((av[i].y + bv.y) * sc + xv[i].y * hbias) * gb[i];
        bx[i] = make_float2(y0, y1);
      }
      if (o == 0) st4c(ZBUF + n, bx);
      else st4c(X + n, bx);
    }
    __syncthreads();
  }
  {
    u16* w0 = hyt + ((size_t)0 * 1536 + c) * SS + CT;
    u16* w1 = hyt + ((size_t)1 * 1536 + c) * SS + CT;
    for (int n = opaque_tid() * 4; n < LL; n += NT * 4) {
      float2 v[4]; ld4c(X + n, v);
      u32x2 o0, o1;
      o0[0] = pack2(v[0].x, v[1].x); o0[1] = pack2(v[2].x, v[3].x);
      o1[0] = pack2(v[0].y, v[1].y); o1[1] = pack2(v[2].y, v[3].y);
      *(u32x2*)(w0 + n) = o0; *(u32x2*)(w1 + n) = o1;
    }
  }
  __syncthreads();
}

__device__ __forceinline__ void hyena_ctx_item(const Params& P, int c, unsigned char* smem) {
  const int tid = opaque_tid();
  const int b = tid >> 8, t = tid & 255;
  float* vs = (float*)smem;
  float* kf = vs + 512;
  float* kb = kf + 256;
  float* red = kb + 256;
  u16* hyt = (u16*)(P.ws + OFF_HYT);
  const float* sw = P.in[9]; const float* sb = P.in[10];
  const float* k256 = (const float*)(P.ws + OFF_KRAW256);
  float cur, x1, x2;
  {
    const u16* rv = hyt + ((size_t)b * 1536 + c) * SS;
    const u16* ra = hyt + ((size_t)b * 1536 + 512 + c) * SS;
    const u16* rb = hyt + ((size_t)b * 1536 + 1024 + c) * SS;
    cur = conv3(rv, t, CT, sw[c], sw[1536 + c], sw[3072 + c], sb[c]);
    x1 = conv3(ra, t, CT, sw[512 + c], sw[1536 + 512 + c], sw[3072 + 512 + c], sb[512 + c]);
    x2 = conv3(rb, t, CT, sw[1024 + c], sw[1536 + 1024 + c], sw[3072 + 1024 + c], sb[1024 + c]);
  }
  for (int o = 0; o < 2; ++o) {
    __syncthreads();
    float kv;
    if (b == 0) { kv = k256[(size_t)((0 * 2 + o) * 512 + c) * CT + t]; kf[t] = kv; }
    else { kv = k256[(size_t)((1 * 2 + o) * 512 + c) * CT + t]; kb[t] = kv; if (t == 0) kv = 0.f; }
    vs[b * 256 + t] = cur;
    float nrm = block_sum(fabsf(kv), red);
    float y = 0.f;
    for (int s = 0; s <= t; ++s) y += kf[t - s] * vs[b * 256 + s];
    for (int s = t + 1; s < CT; ++s) y += kb[s - t] * vs[b * 256 + s];
    y = y / nrm + cur * P.in[18][o * 512 + c];
    cur = y * (o == 0 ? x1 : x2);
  }
  __syncthreads();
  hyt[((size_t)b * 1536 + c) * SS + t] = f2bf(cur);
  __syncthreads();
}

__device__ __forceinline__ void attn_item(const Params& P, int b, int head, int qb, unsigned char* smem) {
  f32x16 O[4];
  float lrun = 0.f;
  {
  const int tid = opaque_tid(), lane = tid & 63, w = tid >> 6;
  const int r = lane & 31, h = lane >> 5;
  const int m = w & 1, wq = w >> 1;
  constexpr int KP = 72;
  unsigned char* kst = smem;
  unsigned char* vst = smem + 32768;
  u16* qs = (u16*)(smem + 65536);
  const u16* Qg = (const u16*)(P.ws + OFF_Q);
  const u16* Kg = (const u16*)(P.ws + OFF_K);
  const u16* Vg = (const u16*)(P.ws + OFF_VT);
  const int ntiles = (qb < 2) ? (CT / 64) : (SS / 64);
  const u16* K1p = Kg + ((size_t)((b * 4 + head) * 2 + 0) * SS) * 64;
  const u16* K2p = Kg + ((size_t)((b * 4 + head) * 2 + 1) * SS) * 64;
  const u16* Vp = Vg + ((size_t)(b * 4 + head) * 128) * SS;
  const int krow = tid >> 3, kkc = (tid & 7) ^ ((krow >> 1) & 7);
  unsigned koff = (unsigned)(krow * 64 + kkc * 8);
  const int e0 = tid >> 3, e1 = 64 + (tid >> 3);
  unsigned voff0 = (unsigned)(e0 * SS + ((tid & 7) ^ ((e0 >> 1) & 7)) * 8);
  unsigned voff1 = (unsigned)(e1 * SS + ((tid & 7) ^ ((e1 >> 1) & 7)) * 8);
#define GLDS16(gp, lp) __builtin_amdgcn_global_load_lds((const unsigned*)(gp), (unsigned*)(lp), 16, 0, 0)
  __syncthreads();
#pragma unroll
  for (int i = 0; i < 4; ++i) {
    int id = tid + i * NT;
    int mm = id >> 10, q = (id >> 3) & 127, ch = (id & 7) * 8;
    *(u32x4*)(qs + (mm * 128 + q) * KP + ch) = *(const u32x4*)(Qg + ((size_t)((b * 4 + head) * 2 + mm) * SS + qb * 128 + q) * 64 + ch);
  }
  GLDS16(K1p + koff, kst + tid * 16);
  GLDS16(K2p + koff, kst + 8192 + tid * 16);
  GLDS16(Vp + voff0, vst + tid * 16);
  GLDS16(Vp + voff1, vst + 8192 + tid * 16);
  if (ntiles > 1) {
    GLDS16(K1p + 64 * 64 + koff, kst + 16384 + tid * 16);
    GLDS16(K2p + 64 * 64 + koff, kst + 16384 + 8192 + tid * 16);
  }
  asm volatile("s_waitcnt vmcnt(0)" ::: "memory");
#pragma unroll
  for (int e = 0; e < 4; ++e)
#pragma unroll
    for (int j = 0; j < 16; ++j) O[e][j] = 0.f;
  float mrun;
  __syncthreads();
  const int sw = (r >> 1) & 7;
  const u16* qrow = qs + (m * 128 + wq * 32 + r) * KP + h * 8;
  f32x16 c0, c1;
  {
    bf16x8 qf[4];
#pragma unroll
    for (int sl = 0; sl < 4; ++sl) qf[sl] = *(const bf16x8*)(qrow + sl * 16);
    const unsigned char* ks_ = kst + m * 8192 + r * 128;
#pragma unroll
    for (int j = 0; j < 16; ++j) { c0[j] = 0.f; c1[j] = 0.f; }
#pragma unroll
    for (int sl = 0; sl < 4; ++sl) {
      const int o = ((sl * 2 + h) ^ sw) * 16;
      c0 = MFMA(*(const bf16x8*)(ks_ + o), qf[sl], c0);
      c1 = MFMA(*(const bf16x8*)(ks_ + 32 * 128 + o), qf[sl], c1);
    }
    float tm = fmaxf(c0[0], c1[0]);
#pragma unroll
    for (int j = 1; j < 16; ++j) tm = fmaxf(tm, fmaxf(c0[j], c1[j]));
    mrun = fmaxf(tm, __shfl_xor(tm, 32));
#pragma unroll
    for (int j = 0; j < 16; ++j) { c0[j] -= mrun; c1[j] -= mrun; }
  }
  float tmax = 0.f;
#define SB_() __builtin_amdgcn_sched_barrier(0)
  f32x16 n0, n1, ninit;
#pragma unroll
  for (int j = 0; j < 16; ++j) ninit[j] = -mrun;
  auto att_step = [&](f32x16& C0, f32x16& C1, f32x16& N0, f32x16& N1, const int kt, const int PAR) __attribute__((always_inline)) {
    const bool has1 = kt + 1 < ntiles, has2 = kt + 2 < ntiles;
    if (__any(tmax > 16.f)) {
      const float d = fmaxf(tmax, 0.f);
      const float alpha = __builtin_amdgcn_exp2f(-d);
      mrun += d;
      lrun *= alpha;
#pragma unroll
      for (int e = 0; e < 4; ++e)
#pragma unroll
        for (int j = 0; j < 16; ++j) O[e][j] *= alpha;
#pragma unroll
      for (int j = 0; j < 16; ++j) { C0[j] -= d; C1[j] -= d; ninit[j] = -mrun; }
    }
    if (has2) {
      const int k0 = (kt + 2) * 64;
      GLDS16(K1p + (size_t)k0 * 64 + koff, kst + PAR * 16384 + tid * 16);
      GLDS16(K2p + (size_t)k0 * 64 + koff, kst + PAR * 16384 + 8192 + tid * 16);
    }
    if (has1) {
      const int k0 = (kt + 1) * 64;
      GLDS16(Vp + k0 + voff0, vst + (PAR ^ 1) * 16384 + tid * 16);
      GLDS16(Vp + k0 + voff1, vst + (PAR ^ 1) * 16384 + 8192 + tid * 16);
    }
    const unsigned char* ks_ = kst + (PAR ^ 1) * 16384 + m * 8192 + r * 128;
    const unsigned char* vts = vst + PAR * 16384 + r * 128;
    bf16x8 kf[8], qf[4];
#pragma unroll
    for (int sl = 0; sl < 4; ++sl) {
      const int o = ((sl * 2 + h) ^ sw) * 16;
      kf[2 * sl] = *(const bf16x8*)(ks_ + o); kf[2 * sl + 1] = *(const bf16x8*)(ks_ + 32 * 128 + o);
      qf[sl] = *(const bf16x8*)(qrow + sl * 16);
    }
    SB_();
    N0 = MFMA(kf[0], qf[0], ninit);
    N1 = MFMA(kf[1], qf[0], ninit);
#pragma unroll
    for (int sl = 1; sl < 4; ++sl) { N0 = MFMA(kf[2 * sl], qf[sl], N0); N1 = MFMA(kf[2 * sl + 1], qf[sl], N1); }
    float psum = 0.f;
#pragma unroll
    for (int j = 0; j < 16; ++j) { C0[j] = __builtin_amdgcn_exp2f(C0[j]); psum += C0[j]; }
    bf16x8 pf[4];
#pragma unroll
    for (int q2 = 0; q2 < 2; ++q2) {
      u32x4 pk;
      pk[0] = pack2(C0[8 * q2 + 0], C0[8 * q2 + 1]); pk[1] = pack2(C0[8 * q2 + 2], C0[8 * q2 + 3]);
      pk[2] = pack2(C0[8 * q2 + 4], C0[8 * q2 + 5]); pk[3] = pack2(C0[8 * q2 + 6], C0[8 * q2 + 7]);
      pf[q2] = __builtin_bit_cast(bf16x8, pk);
    }
    SB_();
    bf16x8 vf[8];
#pragma unroll
    for (int q2 = 0; q2 < 2; ++q2)
#pragma unroll
      for (int e = 0; e < 4; ++e) vf[q2 * 4 + e] = *(const bf16x8*)(vts + e * 4096 + (((q2 * 2 + h) ^ sw) * 16));
    SB_();
#pragma unroll
    for (int q2 = 0; q2 < 2; ++q2)
#pragma unroll
      for (int e = 0; e < 4; ++e) O[e] = MFMA(vf[q2 * 4 + e], pf[q2], O[e]);
#pragma unroll
    for (int j = 0; j < 16; ++j) { C1[j] = __builtin_amdgcn_exp2f(C1[j]); psum += C1[j]; }
    lrun += psum;
#pragma unroll
    for (int q2 = 0; q2 < 2; ++q2) {
      u32x4 pk;
      pk[0] = pack2(C1[8 * q2 + 0], C1[8 * q2 + 1]); pk[1] = pack2(C1[8 * q2 + 2], C1[8 * q2 + 3]);
      pk[2] = pack2(C1[8 * q2 + 4], C1[8 * q2 + 5]); pk[3] = pack2(C1[8 * q2 + 6], C1[8 * q2 + 7]);
      pf[2 + q2] = __builtin_bit_cast(bf16x8, pk);
    }
    SB_();
#pragma unroll
    for (int q2 = 0; q2 < 2; ++q2)
#pragma unroll
      for (int e = 0; e < 4; ++e) vf[q2 * 4 + e] = *(const bf16x8*)(vts + e * 4096 + (((4 + q2 * 2 + h) ^ sw) * 16));
    SB_();
#pragma unroll
    for (int q2 = 0; q2 < 2; ++q2)
#pragma unroll
      for (int e = 0; e < 4; ++e) O[e] = MFMA(vf[q2 * 4 + e], pf[2 + q2], O[e]);
    {
      int mi = max(__builtin_bit_cast(int, N0[0]), __builtin_bit_cast(int, N1[0]));
#pragma unroll
      for (int j = 1; j < 16; ++j) mi = max(mi, max(__builtin_bit_cast(int, N0[j]), __builtin_bit_cast(int, N1[j])));
      mi = max(mi, __shfl_xor(mi, 32));
      tmax = __builtin_bit_cast(float, mi);
    }
    SB_();
    asm volatile("s_waitcnt vmcnt(0)" ::: "memory");
    __syncthreads();
  };
  for (int kt2 = 0; kt2 < ntiles; kt2 += 2) {
    att_step(c0, c1, n0, n1, kt2, 0);
    att_step(n0, n1, c0, c1, kt2 + 1, 1);
  }
#undef SB_
#undef GLDS16
  }
  const int tid_e = opaque_tid();
  const int lane = tid_e & 63, w = tid_e >> 6, r = lane & 31, h = lane >> 5, m = w & 1, wq = w >> 1;
  const int sq = qb * 128 + wq * 32 + r;
  const float lam = ((const float*)(P.ws + OFF_CNT))[1];
  const float lt = lrun + __shfl_xor(lrun, 32);
  float* xch = (float*)smem + wq * 4096;
  if (m == 1) {
    const float i2 = lam / lt;
#pragma unroll
    for (int e = 0; e < 4; ++e)
#pragma unroll
      for (int j = 0; j < 16; ++j) xch[(e * 16 + j) * 64 + lane] = O[e][j] * i2;
  }
  __syncthreads();
  if (m == 0) {
    const float i1 = 1.f / lt;
    float ssq = 0.f;
#pragma unroll
    for (int e = 0; e < 4; ++e)
#pragma unroll
      for (int j = 0; j < 16; ++j) { float a = O[e][j] * i1 - xch[(e * 16 + j) * 64 + lane]; O[e][j] = a; ssq += a * a; }
    ssq += __shfl_xor(ssq, 32);
    const float rstd = rsqrtf(ssq * (1.f / 128.f) + EPSN) * 0.8f;
    const size_t tok = (size_t)b * SS + sq;
    const u16* agp = (const u16*)(P.ws + OFF_AG) + tok * 512 + head * 128;
    u16* mixp = (u16*)(P.ws + OFF_XN) + tok * DM + 512 + head * 128;
    const float* sw = P.in[20];
#pragma unroll
    for (int e = 0; e < 4; ++e)
#pragma unroll
      for (int g = 0; g < 4; ++g) {
        const int e0 = e * 32 + 8 * g + 4 * h;
        u32x2 ag = *(const u32x2*)(agp + e0);
        float a0 = O[e][4 * g + 0] * rstd * sw[e0 + 0] * silu_f(bf2f((u16)(ag[0] & 0xffff)));
        float a1 = O[e][4 * g + 1] * rstd * sw[e0 + 1] * silu_f(bf2f((u16)(ag[0] >> 16)));
        float a2 = O[e][4 * g + 2] * rstd * sw[e0 + 2] * silu_f(bf2f((u16)(ag[1] & 0xffff)));
        float a3 = O[e][4 * g + 3] * rstd * sw[e0 + 3] * silu_f(bf2f((u16)(ag[1] >> 16)));
        u32x2 o; o[0] = pack2(a0, a1); o[1] = pack2(a2, a3);
        *(u32x2*)(mixp + e0) = o;
      }
  }
  __syncthreads();
}

__device__ __forceinline__ void phase_mixers(const Params& P, unsigned char* smem) {
  int* cnt = (int*)(P.ws + OFF_CNT);
  __shared__ int s_item;
  const int n_attl = NB * 4 * 128, n_hyl = 512, n_attc = NB * 4 * 2, n_hyc = 512;
  const int total = n_attl + n_hyl + n_attc + n_hyc;
  for (;;) {
    __syncthreads();
    if (threadIdx.x == 0) s_item = atomicAdd(cnt, 1);
    __syncthreads();
    int it = s_item;
    if (it >= total) break;
    const bool attc = (it >= n_attl + n_hyl) && (it < n_attl + n_hyl + n_attc);
    const bool attl = (it >= n_hyl) && (it < n_attl + n_hyl);
    if (attl || attc) {
      int bh = attc ? ((it - n_attl - n_hyl) >> 1) : (it - n_hyl) / 128;
      int qb = attc ? ((it - n_attl - n_hyl) & 1) : 2 + (it - n_hyl) % 128;
      for (int rep = 0; rep < ATT_REP; ++rep) attn_item(P, bh >> 2, bh & 3, qb, smem);
    }
#ifndef NO_HYL
    else if (it < n_hyl) hyena_latent_item(P, it, smem);
#endif
#ifndef NO_HYC
    else if (it >= n_attl + n_hyl + n_attc) hyena_ctx_item(P, it - n_attl - n_hyl - n_attc, smem);
#endif
  }
}

__device__ __forceinline__ void phase_hygate(const Params& P, unsigned char* smem) {
  const int tid = opaque_tid();
  float* tile = (float*)smem;
  const u16* hyt = (const u16*)(P.ws + OFF_HYT);
  const u16* hg = (const u16*)(P.ws + OFF_HG);
  u16* mix = (u16*)(P.ws + OFF_XN);
  for (int it = blockIdx.x; it < NB * 260 * 8; it += gridDim.x) {
    int ct = it & 7, stile = (it >> 3) % 260, b = it / (8 * 260);
    __syncthreads();
    {
      int ci = tid >> 3, sg = (tid & 7) * 8;
      u32x4 v = *(const u32x4*)(hyt + ((size_t)b * 1536 + ct * 64 + ci) * SS + stile * 64 + sg);
#pragma unroll
      for (int i = 0; i < 4; ++i) { tile[ci * 65 + sg + 2 * i] = bf2f((u16)(v[i] & 0xffff)); tile[ci * 65 + sg + 2 * i + 1] = bf2f((u16)(v[i] >> 16)); }
    }
    __syncthreads();
    {
      int si = tid >> 3, cg8 = (tid & 7) * 8;
      size_t tok = (size_t)b * SS + stile * 64 + si;
      u32x4 g = *(const u32x4*)(hg + tok * 512 + ct * 64 + cg8);
      u32x4 o;
#pragma unroll
      for (int i = 0; i < 4; ++i) {
        float a0 = tile[(cg8 + 2 * i) * 65 + si] * silu_f(bf2f((u16)(g[i] & 0xffff)));
        float a1 = tile[(cg8 + 2 * i + 1) * 65 + si] * silu_f(bf2f((u16)(g[i] >> 16)));
        o[i] = pack2(a0, a1);
      }
      *(u32x4*)(mix + tok * DM + ct * 64 + cg8) = o;
    }
  }
}

__device__ __forceinline__ void phase_conv(const Params& P, bool do_store) {
  const int tid = opaque_tid();
  u16* xbc = (u16*)(P.ws + OFF_XBC);
  const u16* halo = (const u16*)(P.ws + OFF_HALO);
  const float* cw = P.in[22]; const float* cb = P.in[23];
  for (int it = blockIdx.x; it < 260 * 16; it += gridDim.x) {
    const int tile = it >> 4, chunk = it & 15;
    const int sub = tid >> 5, cg8 = tid & 31;
    const int ch = chunk * 256 + cg8 * 8;
    const int row0 = tile * 128 + sub * 8;
    const int s_first = (tile * 128) % SS;
    u32x4 rows[10];
    u32 zz = 0; asm volatile("" : "+v"(zz));
    __syncthreads();
#pragma unroll
    for (int i = 0; i < 10; ++i) {
      int row = row0 - 1 + i;
      u32x4 v = {zz, zz, zz, zz};
      if (row < tile * 128) {
        if (!(s_first == 0 || s_first == CT)) v = *(const u32x4*)(halo + ((size_t)(tile - 1) * 2 + 1) * 4096 + ch);
      } else if (row >= tile * 128 + 128) {
        int s_last = s_first + 127;
        if (!(s_last == CT - 1 || s_last == SS - 1)) v = *(const u32x4*)(halo + ((size_t)(tile + 1) * 2 + 0) * 4096 + ch);
      } else v = *(const u32x4*)(xbc + (size_t)row * 4096 + ch);
      rows[i] = v;
    }
    __syncthreads();
    float w0[8], w1[8], w2[8], bb[8];
#pragma unroll
    for (int e = 0; e < 8; ++e) { w0[e] = cw[ch + e]; w1[e] = cw[4096 + ch + e]; w2[e] = cw[8192 + ch + e]; bb[e] = cb[ch + e]; }
#pragma unroll
    for (int i = 0; i < 8; ++i) {
      u32x4 o;
#pragma unroll
      for (int e2 = 0; e2 < 4; ++e2) {
        float r[2];
#pragma unroll
        for (int p = 0; p < 2; ++p) {
          int e = e2 * 2 + p;
          u32 a = rows[i][e2], bq = rows[i + 1][e2], cq = rows[i + 2][e2];
          float xa = p ? bf2f((u16)(a >> 16)) : bf2f((u16)(a & 0xffff));
          float xb = p ? bf2f((u16)(bq >> 16)) : bf2f((u16)(bq & 0xffff));
          float xc = p ? bf2f((u16)(cq >> 16)) : bf2f((u16)(cq & 0xffff));
          r[p] = silu_f(w0[e] * xa + w1[e] * xb + w2[e] * xc + bb[e]);
        }
        o[e2] = pack2(r[0], r[1]);
      }
      if (do_store) *(u32x4*)(xbc + (size_t)(row0 + i) * 4096 + ch) = o;
    }
  }
}

__device__ __forceinline__ void wave_scan4(float a[4], float& total) {
  a[1] += a[0]; a[2] += a[1]; a[3] += a[2];
  float t = a[3];
  const int lane = threadIdx.x & 63;
#pragma unroll
  for (int o = 1; o < 64; o <<= 1) { float u = __shfl_up(t, o); if (lane >= o) t += u; }
  float excl = t - a[3];
  a[0] += excl; a[1] += excl; a[2] += excl; a[3] += excl;
  total = __shfl(t, 63);
}

constexpr int XP = 136;

__device__ __forceinline__ void stage_xt(const u16* __restrict__ xbc, size_t tok0, int g, u16* XT) {
  const int tid_ = opaque_tid(); const int lane = tid_ & 63, w = tid_ >> 6;
  const int tg = w & 1, hh = w >> 1;
  const int s = tg * 64 + lane;
  const u16* src = xbc + (tok0 + s) * 4096 + g * 256 + hh * 64;
#pragma unroll
  for (int it = 0; it < 8; ++it) {
    u32x4 v = *(const u32x4*)(src + it * 8);
#pragma unroll
    for (int i = 0; i < 4; ++i) {
      XT[(hh * 64 + it * 8 + 2 * i) * XP + s] = (u16)(v[i] & 0xffff);
      XT[(hh * 64 + it * 8 + 2 * i + 1) * XP + s] = (u16)(v[i] >> 16);
    }
  }
}
__device__ __forceinline__ void stage_rows(const u16* __restrict__ xbc, size_t tok0, int coloff, u16* R) {
  const int tid = opaque_tid();
#pragma unroll
  for (int i = 0; i < 4; ++i) {
    int id = tid + i * NT;
    int s = id >> 4, c8 = (id & 15) * 8;
    *(u32x4*)(R + s * XP + c8) = *(const u32x4*)(xbc + (tok0 + s) * 4096 + coloff + c8);
  }
}

__device__ __forceinline__ void phase_ssd1(const Params& P, unsigned char* smem) {
  const int tid = opaque_tid(), lane = tid & 63, w = tid >> 6;
  const int r = lane & 31, h = lane >> 5;
  u16* XT = (u16*)smem;
  u16* BT = XT + 256 * XP;
  float* wgt = (float*)(BT + 128 * XP);
  const u16* xbc = (const u16*)(P.ws + OFF_XBC);
  const float* dt = (const float*)(P.ws + OFF_DT);
  float* dec = (float*)(P.ws + OFF_DEC);
  const int dir = w >> 2, hh = w & 3;
  for (int it = blockIdx.x; it < NB * 65 * 8; it += gridDim.x) {
    const int g = it & 7, c = (it >> 3) % 65, b = it / (8 * 65);
    const int head = g * 4 + hh;
    const size_t tok0 = (size_t)b * SS + (size_t)c * 256;
    const float Ah = -expf(P.in[25][dir * 32 + head]);
    __syncthreads();
    {
      float a[4], d4[4], tot;
#pragma unroll
      for (int i = 0; i < 4; ++i) { d4[i] = dt[(tok0 + lane * 4 + i) * 64 + dir * 32 + head]; a[i] = d4[i] * Ah; }
      float a_raw[4] = {a[0], a[1], a[2], a[3]};
      wave_scan4(a, tot);
#pragma unroll
      for (int i = 0; i < 4; ++i) {
        float te = (dir == 0) ? __expf(tot - a[i]) : __expf(a[i] - a_raw[i]);
        wgt[w * 256 + lane * 4 + i] = d4[i] * te;
      }
      if (lane == 0) dec[((dir * 2 + b) * 65 + c) * 32 + head] = __expf(tot);
    }
    f32x16 acc[2][4];
#pragma unroll
    for (int i = 0; i < 2; ++i)
#pragma unroll
      for (int j = 0; j < 4; ++j)
#pragma unroll
        for (int e = 0; e < 16; ++e) acc[i][j][e] = 0.f;
    for (int half = 0; half < 2; ++half) {
      __syncthreads();
      stage_xt(xbc, tok0 + half * 128, g, XT);
      {
        const int tg = w & 1, nq = w >> 1;
        const int s = tg * 64 + lane;
        const u16* src = xbc + (tok0 + half * 128 + s) * 4096 + 2048 + g * 128 + nq * 32;
#pragma unroll
        for (int i4 = 0; i4 < 4; ++i4) {
          u32x4 v = *(const u32x4*)(src + i4 * 8);
#pragma unroll
          for (int i = 0; i < 4; ++i) {
            BT[(nq * 32 + i4 * 8 + 2 * i) * XP + s] = (u16)(v[i] & 0xffff);
            BT[(nq * 32 + i4 * 8 + 2 * i + 1) * XP + s] = (u16)(v[i] >> 16);
          }
        }
      }
      __syncthreads();
#pragma unroll 2
      for (int sl = 0; sl < 8; ++sl) {
        const float* wp = wgt + w * 256 + half * 128 + sl * 16 + h * 8;
        float wv[8];
#pragma unroll
        for (int j = 0; j < 8; ++j) wv[j] = wp[j];
        bf16x8 af[2];
#pragma unroll
        for (int pt = 0; pt < 2; ++pt) {
          u32x4 xv = *(const u32x4*)(XT + (hh * 64 + pt * 32 + r) * XP + sl * 16 + h * 8);
          u32x4 sv;
#pragma unroll
          for (int i = 0; i < 4; ++i)
            sv[i] = pack2(bf2f((u16)(xv[i] & 0xffff)) * wv[2 * i], bf2f((u16)(xv[i] >> 16)) * wv[2 * i + 1]);
          af[pt] = __builtin_bit_cast(bf16x8, sv);
        }
#pragma unroll
        for (int nt = 0; nt < 4; ++nt) {
          bf16x8 bfr = *(const bf16x8*)(BT + (nt * 32 + r) * XP + sl * 16 + h * 8);
#pragma unroll
          for (int pt = 0; pt < 2; ++pt) acc[pt][nt] = MFMA(af[pt], bfr, acc[pt][nt]);
        }
      }
    }
    u16* G = (c == 0) ? ((u16*)(P.ws + OFF_GCTX) + (size_t)((dir * 2 + b) * 32 + head) * 8192)
                      : ((u16*)P.out + ((size_t)((dir * 2 + b) * 64 + (c - 1)) * 32 + head) * 8192);
#pragma unroll
    for (int pt = 0; pt < 2; ++pt)
#pragma unroll
      for (int nt = 0; nt < 4; ++nt)
#pragma unroll
        for (int j = 0; j < 16; ++j) {
          int p = pt * 32 + (j & 3) + 8 * (j >> 2) + 4 * h;
          G[p * 128 + nt * 32 + r] = f2bf(acc[pt][nt][j]);
        }
  }
}

__device__ __forceinline__ void phase_scan(const Params& P, bool do_store) {
  const float* dec = (const float*)(P.ws + OFF_DEC);
  const u16* gctx = (const u16*)(P.ws + OFF_GCTX);
  u16* st = (u16*)P.out;
  for (int v = blockIdx.x * NT + opaque_tid(); v < 131072; v += gridDim.x * NT) {
    const int pn8 = v & 1023, hd = (v >> 10) & 31, db = v >> 15;
    const int dir = db >> 1;
    float S[8];
    {
      u32x4 gv = *(const u32x4*)(gctx + ((size_t)db * 32 + hd) * 8192 + pn8 * 8);
#pragma unroll
      for (int i = 0; i < 4; ++i) { S[2 * i] = bf2f((u16)(gv[i] & 0xffff)); S[2 * i + 1] = bf2f((u16)(gv[i] >> 16)); }
    }
    u16* base = st + ((size_t)db * 64 * 32 + hd) * 8192 + pn8 * 8;
    const float* dbase = dec + (db * 65 + 1) * 32 + hd;
    for (int k0 = 0; k0 < 64; k0 += 8) {
      u32x4 gv[8]; float dd[8];
#pragma unroll
      for (int u = 0; u < 8; ++u) {
        const int ci = (dir == 0) ? (k0 + u) : 63 - (k0 + u);
        gv[u] = *(const u32x4*)(base + (size_t)ci * 32 * 8192);
        dd[u] = dbase[ci * 32];
      }
#pragma unroll
      for (int u = 0; u < 8; ++u) {
        const int ci = (dir == 0) ? (k0 + u) : 63 - (k0 + u);
        u32x4 sv;
#pragma unroll
        for (int i = 0; i < 4; ++i) sv[i] = pack2(S[2 * i], S[2 * i + 1]);
        if (do_store) *(u32x4*)(base + (size_t)ci * 32 * 8192) = sv;
#pragma unroll
        for (int i = 0; i < 4; ++i) {
          S[2 * i] = dd[u] * S[2 * i] + bf2f((u16)(gv[u][i] & 0xffff));
          S[2 * i + 1] = dd[u] * S[2 * i + 1] + bf2f((u16)(gv[u][i] >> 16));
        }
      }
    }
  }
}

__device__ __forceinline__ void phase_ssd3(const Params& P, unsigned char* smem, bool do_store) {
  const int tid = opaque_tid(), lane = tid & 63, w = tid >> 6;
  const int r = lane & 31, h = lane >> 5;
  u16* CS = (u16*)smem;
  u16* BS = CS + 128 * XP;
  u16* XT = BS + 128 * XP;
  float* cum = (float*)(XT + 256 * XP);
  float* dtl = cum + 8 * 256;
  float* red = (float*)BS;
  const u16* xbc = (const u16*)(P.ws + OFF_XBC);
  const float* dt = (const float*)(P.ws + OFF_DT);
  const u16* states = (const u16*)P.out;
  u16* zb = (u16*)(P.ws + OFF_ZB);
  const int hh = w & 3, lh = w >> 2;
  for (int it = blockIdx.x; it < NB * 128 * 8; it += gridDim.x) {
    const int g = it & 7, rblk = (it >> 3) & 127, b = it >> 10;
    const int c = rblk >> 1, rb = rblk & 1;
    const size_t tokc = (size_t)b * SS + CT + (size_t)c * 256;
    const int head = g * 4 + hh;
    __syncthreads();
    {
      const int dir = w >> 2;
      const int hd = g * 4 + (w & 3);
      const float Ah = -expf(P.in[25][dir * 32 + hd]);
      float a[4], d4[4], tot;
#pragma unroll
      for (int i = 0; i < 4; ++i) { d4[i] = dt[(tokc + lane * 4 + i) * 64 + dir * 32 + hd]; a[i] = d4[i] * Ah; }
      float a_raw[4] = {a[0], a[1], a[2], a[3]};
      wave_scan4(a, tot);
#pragma unroll
      for (int i = 0; i < 4; ++i) {
        cum[w * 256 + lane * 4 + i] = (dir == 0) ? a[i] : (tot - a[i] + a_raw[i]);
        dtl[w * 256 + lane * 4 + i] = d4[i];
      }
    }
    stage_rows(xbc, tokc + rb * 128, 3072 + g * 128, CS);
    __syncthreads();
    f32x16 acc[2][2];
#pragma unroll
    for (int i = 0; i < 2; ++i)
#pragma unroll
      for (int j = 0; j < 2; ++j)
#pragma unroll
        for (int e = 0; e < 16; ++e) acc[i][j][e] = 0.f;
#pragma unroll 1
    for (int dir = 0; dir < 2; ++dir) {
      const u16* Sp = states + (((size_t)(dir * 2 + b) * 64 + c) * 32 + head) * 8192;
      f32x16 tmp[2][2];
#pragma unroll
      for (int i = 0; i < 2; ++i)
#pragma unroll
        for (int j = 0; j < 2; ++j)
#pragma unroll
          for (int e = 0; e < 16; ++e) tmp[i][j][e] = 0.f;
#pragma unroll
      for (int sb4 = 0; sb4 < 2; ++sb4) {
        bf16x8 sf[4][2];
#pragma unroll
        for (int s4 = 0; s4 < 4; ++s4)
#pragma unroll
          for (int pt = 0; pt < 2; ++pt) sf[s4][pt] = *(const bf16x8*)(Sp + (pt * 32 + r) * 128 + (sb4 * 4 + s4) * 16 + h * 8);
        __builtin_amdgcn_sched_barrier(0);
#pragma unroll
        for (int s4 = 0; s4 < 4; ++s4) {
          bf16x8 cf[2];
#pragma unroll
          for (int li = 0; li < 2; ++li) cf[li] = *(const bf16x8*)(CS + ((lh * 2 + li) * 32 + r) * XP + (sb4 * 4 + s4) * 16 + h * 8);
#pragma unroll
          for (int pt = 0; pt < 2; ++pt)
#pragma unroll
            for (int li = 0; li < 2; ++li) tmp[pt][li] = MFMA(sf[s4][pt], cf[li], tmp[pt][li]);
        }
      }
#pragma unroll
      for (int li = 0; li < 2; ++li) {
        const float sc = __expf(cum[(dir * 4 + hh) * 256 + rb * 128 + (lh * 2 + li) * 32 + r]);
#pragma unroll
        for (int pt = 0; pt < 2; ++pt)
#pragma unroll
          for (int e = 0; e < 16; ++e) acc[pt][li][e] += tmp[pt][li][e] * sc;
      }
    }
#pragma unroll 1
    for (int sb = 0; sb < 2; ++sb) {
      __syncthreads();
      stage_rows(xbc, tokc + sb * 128, 2048 + g * 128, BS);
      stage_xt(xbc, tokc + sb * 128, g, XT);
      __syncthreads();
#pragma unroll 1
      for (int st = 0; st < 4; ++st) {
#pragma unroll
        for (int li = 0; li < 2; ++li) {
          const int lt = lh * 2 + li;
          const bool needf = (sb < rb) || (sb == rb && st <= lt);
          const bool needb = (sb > rb) || (sb == rb && st >= lt);
          if (!needf && !needb) continue;
          f32x16 cbt;
#pragma unroll
          for (int e = 0; e < 16; ++e) cbt[e] = 0.f;
#pragma unroll
          for (int sl = 0; sl < 8; ++sl) {
            bf16x8 bfr = *(const bf16x8*)(BS + (st * 32 + r) * XP + sl * 16 + h * 8);
            bf16x8 cfr = *(const bf16x8*)(CS + (lt * 32 + r) * XP + sl * 16 + h * 8);
            cbt = MFMA(bfr, cfr, cbt);
          }
          const int lidx = rb * 128 + lt * 32 + r;
#pragma unroll 1
          for (int dir = 0; dir < 2; ++dir) {
            if (dir == 0 ? !needf : !needb) continue;
            const float* cu = cum + (dir * 4 + hh) * 256;
            const float* dl = dtl + (dir * 4 + hh) * 256;
            const float cl = cu[lidx];
            float mv[16];
#pragma unroll
            for (int j = 0; j < 16; ++j) {
              const int sidx = sb * 128 + st * 32 + (j & 3) + 8 * (j >> 2) + 4 * h;
              const bool valid = (dir == 0) ? (sidx <= lidx) : (sidx >= lidx);
              const float e = __expf(fminf(cl - cu[sidx], 0.f));
              mv[j] = valid ? cbt[j] * e * dl[sidx] : 0.f;
            }
#pragma unroll
            for (int q2 = 0; q2 < 2; ++q2) {
              u32x4 pk;
#pragma unroll
              for (int i = 0; i < 4; ++i) pk[i] = pack2(mv[8 * q2 + 2 * i], mv[8 * q2 + 2 * i + 1]);
              bf16x8 mf = __builtin_bit_cast(bf16x8, pk);
              const int kb = st * 32 + q2 * 16 + 4 * h;
#pragma unroll
              for (int pt = 0; pt < 2; ++pt) {
                u32x2 lo = *(const u32x2*)(XT + (hh * 64 + pt * 32 + r) * XP + kb);
                u32x2 hi = *(const u32x2*)(XT + (hh * 64 + pt * 32 + r) * XP + kb + 8);
                u32x4 vv; vv[0] = lo[0]; vv[1] = lo[1]; vv[2] = hi[0]; vv[3] = hi[1];
                acc[pt][li] = MFMA(__builtin_bit_cast(bf16x8, vv), mf, acc[pt][li]);
              }
            }
          }
        }
      }
    }
    __syncthreads();
    const float Dsum = P.in[26][head] + P.in[26][32 + head];
    float ssq[2] = {0.f, 0.f};
#pragma unroll
    for (int li = 0; li < 2; ++li) {
      const int l = rb * 128 + (lh * 2 + li) * 32 + r;
      const size_t tok = tokc + l;
      const size_t zrow = ((size_t)b * LL + (size_t)c * 256 + l) * 2048 + head * 64;
#pragma unroll
      for (int pt = 0; pt < 2; ++pt)
#pragma unroll
        for (int gq = 0; gq < 4; ++gq) {
          const int p0 = pt * 32 + 8 * gq + 4 * h;
          u32x2 xv = *(const u32x2*)(xbc + tok * 4096 + head * 64 + p0);
          u32x2 zv = *(const u32x2*)(zb + zrow + p0);
          float xs[4] = {bf2f((u16)(xv[0] & 0xffff)), bf2f((u16)(xv[0] >> 16)), bf2f((u16)(xv[1] & 0xffff)), bf2f((u16)(xv[1] >> 16))};
          float zs[4] = {bf2f((u16)(zv[0] & 0xffff)), bf2f((u16)(zv[0] >> 16)), bf2f((u16)(zv[1] & 0xffff)), bf2f((u16)(zv[1] >> 16))};
#pragma unroll
          for (int i = 0; i < 4; ++i) {
            float y = (acc[pt][li][4 * gq + i] + Dsum * xs[i]) * silu_f(zs[i]);
            acc[pt][li][4 * gq + i] = y;
            ssq[li] += y * y;
          }
        }
      ssq[li] += __shfl_xor(ssq[li], 32);
      if (h == 0) red[hh * 128 + (lh * 2 + li) * 32 + r] = ssq[li];
    }
    __syncthreads();
    const float* gw = P.in[27];
#pragma unroll
    for (int li = 0; li < 2; ++li) {
      const int ll = (lh * 2 + li) * 32 + r;
      const float tot = red[ll] + red[128 + ll] + red[256 + ll] + red[384 + ll];
      const float rstd = rsqrtf(tot * (1.f / 256.f) + EPSN);
      const int l = rb * 128 + ll;
      const size_t zrow = ((size_t)b * LL + (size_t)c * 256 + l) * 2048 + head * 64;
#pragma unroll
      for (int pt = 0; pt < 2; ++pt)
#pragma unroll
        for (int gq = 0; gq < 4; ++gq) {
          const int p0 = pt * 32 + 8 * gq + 4 * h;
          const float* gp = gw + head * 64 + p0;
          u32x2 o;
          o[0] = pack2(acc[pt][li][4 * gq + 0] * rstd * gp[0], acc[pt][li][4 * gq + 1] * rstd * gp[1]);
          o[1] = pack2(acc[pt][li][4 * gq + 2] * rstd * gp[2], acc[pt][li][4 * gq + 3] * rstd * gp[3]);
          if (do_store) *(u32x2*)(zb + zrow + p0) = o;
        }
    }
  }
}

__device__ __forceinline__ void phase_final(const Params& P) {
  const int tid_ = opaque_tid(); const int lane = tid_ & 63, wv = tid_ >> 6;
  const float* nw = P.in[29];
  for (int it = blockIdx.x; it < NB * LL / 8; it += gridDim.x) {
    float* row = P.out + (size_t)(it * 8 + wv) * DM;
    float4 v[4];
    float ss = 0.f;
#pragma unroll
    for (int i = 0; i < 4; ++i) {
      v[i] = *(const float4*)(row + i * 256 + lane * 4);
      ss += v[i].x * v[i].x + v[i].y * v[i].y + v[i].z * v[i].z + v[i].w * v[i].w;
    }
    ss = wave_sum(ss);
    float rstd = rsqrtf(ss * (1.f / DM) + EPSN);
#pragma unroll
    for (int i = 0; i < 4; ++i) {
      float4 w = *(const float4*)(nw + i * 256 + lane * 4);
      float4 o = make_float4(v[i].x * rstd * w.x, v[i].y * rstd * w.y, v[i].z * rstd * w.z, v[i].w * rstd * w.w);
      *(float4*)(row + i * 256 + lane * 4) = o;
    }
  }
}


#define XB_TMO      128
#define XB_XCNT(j)  (256  + 64 * (j))
#define XB_XSUB(j)  (1280 + 64 * (j))
#define XB_XGEN(j)  (2304 + 64 * (j))
#define XB_TOP      3328
#define XB_TOPGEN   3392
#define XCD_BAR_WORDS 3456
#define XB_SPIN_CAP (1u << 18)
#define LAS __attribute__((address_space(3)))
__device__ __forceinline__ unsigned xb_ld(unsigned* p)              { return __hip_atomic_load(p, __ATOMIC_RELAXED, __HIP_MEMORY_SCOPE_AGENT); }
__device__ __forceinline__ unsigned xb_add(unsigned* p, unsigned v) { return __hip_atomic_fetch_add(p, v, __ATOMIC_RELAXED, __HIP_MEMORY_SCOPE_AGENT); }
__device__ __forceinline__ unsigned xb_xcc_id() { return (unsigned)__builtin_amdgcn_s_getreg((3 << 11) | 20) & 0xFu; }
#define XB_SPIN(cond, bar) do { unsigned _sp = 0; while (cond) { __builtin_amdgcn_s_sleep(1); \
    if ((++_sp & 255u) == 0u) { if (xb_ld(&(bar)[XB_TMO])) break; if (_sp > XB_SPIN_CAP) { atomicAdd(&(bar)[XB_TMO], 1u); break; } } } } while (0)
struct XcdBarrier { unsigned* bar; unsigned x; volatile LAS unsigned* st; };
__device__ __forceinline__ XcdBarrier xcd_barrier_post(unsigned* bar, volatile LAS unsigned* st) {
  XcdBarrier b; b.bar = bar; b.x = xb_xcc_id(); b.st = st;
  if (threadIdx.x == 0) (void)xb_add(&bar[XB_XCNT(b.x)], 1u);
  return b;
}
__device__ __forceinline__ void xcd_barrier_complete(unsigned* bar, unsigned x, unsigned& nloc, unsigned& nx) {
  const unsigned G = gridDim.x * gridDim.y * gridDim.z;
  unsigned sum, cnt, mine, sp = 0u;
  for (;;) {
    sum = 0u; cnt = 0u; mine = 0u;
#pragma unroll
    for (unsigned j = 0; j < 16; ++j) { const unsigned c = xb_ld(&bar[XB_XCNT(j)]); sum += c; cnt += (c > 0u) ? 1u : 0u; mine = (j == x) ? c : mine; }
    if (sum == G) break;
    __builtin_amdgcn_s_sleep(1);
    if ((++sp & 255u) == 0u) { if (xb_ld(&bar[XB_TMO])) break; if (sp > XB_SPIN_CAP) { atomicAdd(&bar[XB_TMO], 1u); break; } }
  }
  nloc = mine > 0u ? mine : 1u; nx = cnt > 0u ? cnt : 1u;
}
__device__ __forceinline__ void xcd_barrier(const XcdBarrier& b) {
  asm volatile("s_waitcnt vmcnt(0)" ::: "memory");
  __syncthreads();
  if (threadIdx.x == 0) {
    unsigned* bar = b.bar;
    __builtin_amdgcn_s_waitcnt(0);
    unsigned nloc = b.st[0], nx = b.st[1];
    if (nloc == 0u) { xcd_barrier_complete(bar, b.x, nloc, nx); b.st[0] = nloc; b.st[1] = nx; }
    const unsigned old = xb_add(&bar[XB_XSUB(b.x)], 1u);
    const unsigned gen = old / nloc;
    if (old + 1u == (gen + 1u) * nloc) {
      __builtin_amdgcn_fence(__ATOMIC_RELEASE, "agent");
      asm volatile("s_waitcnt vmcnt(0)" ::: "memory");
      const unsigned og = xb_add(&bar[XB_TOP], 1u);
      const unsigned tg = og / nx;
      if (og + 1u == (tg + 1u) * nx) xb_add(&bar[XB_TOPGEN], 1u);
      else XB_SPIN(xb_ld(&bar[XB_TOPGEN]) == tg, bar);
      __builtin_amdgcn_fence(__ATOMIC_ACQUIRE, "agent");
      xb_add(&bar[XB_XGEN(b.x)], 1u);
      asm volatile("s_waitcnt vmcnt(0)" ::: "memory");
    } else {
      XB_SPIN(xb_ld(&bar[XB_XGEN(b.x)]) == gen, bar);
      __builtin_amdgcn_fence(__ATOMIC_ACQUIRE, "agent");
      asm volatile("s_waitcnt vmcnt(0)" ::: "memory");
    }
  }
  __syncthreads();
}

__global__ void __launch_bounds__(NT) fwd_kernel(Params P) {
  extern __shared__ __attribute__((aligned(16))) unsigned char smem[];
  __shared__ uint4 xb_words;
  if (threadIdx.x == 0) xb_words = make_uint4(0u, 0u, 0u, 0u);
  __syncthreads();
  XcdBarrier xb = xcd_barrier_post((unsigned*)(P.ws + OFF_BAR), (volatile LAS unsigned*)&xb_words);
  for (int ph = P.ph_lo; ph < P.ph_hi; ++ph) {
    switch (ph) {
#if !defined(PHASE_ONLY) || PHASE_ONLY == 0
      case 0: for (int rep = 0; rep < MISC_REP; ++rep) phase_prep(P, smem); break;
#endif
#if !defined(PHASE_ONLY) || PHASE_ONLY == 1
      case 1: for (int rep = 0; rep < MISC_REP; ++rep) { phase_norm(P, 0, (u16*)(P.ws + OFF_XN)); phase_filter(P, smem); } break;
#endif
#if !defined(PHASE_ONLY) || PHASE_ONLY == 2
      case 2: for (int rep = 0; rep < GEMM_REP; ++rep) gemm_phase<0>(P, (const u16*)(P.ws + OFF_XN), DM, (const u16*)(P.ws + OFF_WEIN), DM, DM, NTOK / 256, 16, smem); break;
#endif
#if !defined(PHASE_ONLY) || PHASE_ONLY == 3
      case 3: phase_mixers(P, smem); break;
#endif
#if !defined(PHASE_ONLY) || PHASE_ONLY == 4
      case 4: phase_hygate(P, smem); break;
#endif
#if !defined(PHASE_ONLY) || PHASE_ONLY == 5
      case 5: for (int rep = 0; rep < GEMM_REP; ++rep) gemm_phase<1>(P, (const u16*)(P.ws + OFF_XN), DM, (const u16*)(P.ws + OFF_WEOUT), DM, DM, NTOK / 256, 4, smem); break;
#endif
#if !defined(PHASE_ONLY) || PHASE_ONLY == 6
      case 6: phase_norm(P, 1, (u16*)P.out); break;
#endif
#if !defined(PHASE_ONLY) || PHASE_ONLY == 7
      case 7: for (int rep = 0; rep < GEMM_REP; ++rep) gemm_phase<2>(P, (const u16*)P.out, DM, (const u16*)(P.ws + OFF_WOIN), DM, DM, NTOK / 256, 25, smem); break;
#endif
#if !defined(PHASE_ONLY) || PHASE_ONLY == 8
      case 8: for (int rep = 0; rep < TAIL_REP; ++rep) phase_conv(P, rep == TAIL_REP - 1); break;
#endif
#if !defined(PHASE_ONLY) || PHASE_ONLY == 9
      case 9: for (int rep = 0; rep < SSD1_REP; ++rep) phase_ssd1(P, smem); break;
#endif
#if !defined(PHASE_ONLY) || PHASE_ONLY == 10
      case 10: for (int rep = 0; rep < TAIL_REP; ++rep) phase_scan(P, rep == TAIL_REP - 1); break;
#endif
#if !defined(PHASE_ONLY) || PHASE_ONLY == 11
      case 11: for (int rep = 0; rep < TAIL_REP; ++rep) phase_ssd3(P, smem, rep == TAIL_REP - 1); break;
#endif
#if !defined(PHASE_ONLY) || PHASE_ONLY == 12
      case 12: for (int rep = 0; rep < GEMM_REP; ++rep) gemm_phase<3>(P, (const u16*)(P.ws + OFF_ZB), 2048, (const u16*)(P.ws + OFF_WOOUT), 2048, 2048, NB * LL / 256, 4, smem); break;
#endif
#if !defined(PHASE_ONLY) || PHASE_ONLY == 13
      case 13: phase_final(P); break;
#endif
    }
    if (ph + 1 < P.ph_hi) {
      if (P.ph_lo < 0) cg::this_grid().sync();
      xcd_barrier(xb);
    }
  }
}

extern "C" void kernel_launch(void* const* d_in, const int* in_sizes, int n_in, void* d_out, int out_size,
                              void* d_ws, size_t ws_size, hipStream_t stream) {
  static int grid = 0;
  if (grid == 0) {
    if (n_in != 30 || ws_size < OFF_END) { fprintf(stderr, "kernel_launch: unexpected n_in %d / ws %zu\n", n_in, ws_size); grid = -1; return; }
    int dev = 0, cus = 0, per_cu = 0;
    hipGetDevice(&dev);
    hipDeviceGetAttribute(&cus, hipDeviceAttributeMultiprocessorCount, dev);
    if (hipFuncSetAttribute((const void*)fwd_kernel, hipFuncAttributeMaxDynamicSharedMemorySize, LDS_BYTES) != hipSuccess) {
      fprintf(stderr, "kernel_launch: hipFuncSetAttribute failed\n"); grid = -1; return; }
    hipOccupancyMaxActiveBlocksPerMultiprocessor(&per_cu, (const void*)fwd_kernel, NT, LDS_BYTES);
    if (per_cu < 1) { fprintf(stderr, "kernel_launch: occupancy query says %d\n", per_cu); per_cu = 1; }
    (void)hipGetLastError();
    grid = cus * 1;
  }
  if (grid < 0) return;
  Params p{};
  for (int i = 0; i < 30; ++i) p.in[i] = (const float*)d_in[i];
  p.out = (float*)d_out;
  p.ws = (unsigned char*)d_ws;
#if ONE_LAUNCH
  (void)hipMemsetAsync((unsigned char*)d_ws + OFF_BAR, 0, XCD_BAR_WORDS * 4, stream);
  p.ph_lo = 0; p.ph_hi = NPH;
  void* args[] = {&p};
  hipError_t e = hipLaunchCooperativeKernel((const void*)fwd_kernel, dim3(grid), dim3(NT), args, LDS_BYTES, stream);
  if (e != hipSuccess) fprintf(stderr, "cooperative launch failed: %s (grid %d)\n", hipGetErrorString(e), grid);
#else
  for (int ph = 0; ph < NPH; ++ph) {
    p.ph_lo = ph; p.ph_hi = ph + 1;
    hipLaunchKernelGGL(fwd_kernel, dim3(grid), dim3(NT), LDS_BYTES, stream, p);
  }
#endif
}
```

```cpp
#include <hip/hip_runtime.h>
#include <hip/hip_cooperative_groups.h>
#include <cstdio>
#include <cstdint>
namespace cg = cooperative_groups;

#ifndef ONE_LAUNCH
#define ONE_LAUNCH 1
#endif

typedef unsigned short u16;
typedef unsigned int u32;
using bf16x8 = __attribute__((ext_vector_type(8))) short;
using s16x4  = __attribute__((ext_vector_type(4))) short;
using f32x16 = __attribute__((ext_vector_type(16))) float;
using u32x4  = __attribute__((ext_vector_type(4))) unsigned;
using u32x2  = __attribute__((ext_vector_type(2))) unsigned;

#ifndef ATT_REP
#define ATT_REP 1
#endif
#ifndef HYL_REP
#define HYL_REP 1
#endif
#ifndef GEMM_REP
#define GEMM_REP 1
#endif
#ifndef MISC_REP
#define MISC_REP 1
#endif
#ifndef TAIL_REP
#define TAIL_REP 2
#endif
#ifndef SSD1_REP
#define SSD1_REP 1
#endif
#define NT 512
constexpr int DM = 1024;
constexpr int NB = 2;
constexpr int LL = 16384;
constexpr int CT = 256;
constexpr int SS = LL + CT;
constexpr int NTOK = NB * SS;
constexpr float EPSN = 1e-6f;
constexpr int NPH = 14;

constexpr size_t MiB = 1048576;
constexpr size_t OFF_WEIN = 0, OFF_WEOUT = 8 * MiB, OFF_WOIN = 10 * MiB, OFF_WOOUT = 23 * MiB;
constexpr size_t OFF_MODS = 27 * MiB;
constexpr size_t OFF_CNT = 27 * MiB + 128 * 1024;
constexpr size_t OFF_ROPE = 27 * MiB + 160 * 1024;
constexpr size_t OFF_DEC = 27 * MiB + 256 * 1024;
constexpr size_t OFF_BAR = 27 * MiB + 768 * 1024;
constexpr size_t OFF_H2 = 28 * MiB;
constexpr size_t OFF_KRAW256 = 33 * MiB;
constexpr size_t OFF_GCTX = 35 * MiB;
constexpr size_t OFF_BIG = 37 * MiB;
constexpr size_t SZ_HYT = (size_t)NB * 1536 * SS * 2;
constexpr size_t SZ_TOK512 = (size_t)NTOK * 512 * 2;
constexpr size_t OFF_HYT = OFF_BIG, OFF_HG = OFF_HYT + SZ_HYT, OFF_AG = OFF_HG + SZ_TOK512;
constexpr size_t OFF_Q = OFF_AG + SZ_TOK512, OFF_K = OFF_Q + SZ_TOK512, OFF_VT = OFF_K + SZ_TOK512;
constexpr size_t OFF_XBC = OFF_BIG;
constexpr size_t OFF_ZREG = 297 * MiB;
constexpr size_t OFF_XN = OFF_ZREG;
constexpr size_t OFF_FFTS = OFF_ZREG + 65 * MiB;
constexpr size_t OFF_ZB = OFF_ZREG;
constexpr size_t OFF_OUT0 = 425 * MiB;
constexpr size_t OFF_DT = 490 * MiB;
constexpr size_t OFF_HALO = 499 * MiB;
constexpr size_t OFF_END = 504 * MiB;

constexpr int LDS_BYTES = 156672;

struct Params {
  const float* in[30];
  float* out;
  unsigned char* ws;
  int ph_lo, ph_hi;
};

__device__ __forceinline__ u16 f2bf(float f) { return __builtin_bit_cast(u16, (__bf16)f); }
__device__ __forceinline__ float bf2f(u16 h) { return __uint_as_float(((u32)h) << 16); }
typedef float f32x2_t __attribute__((ext_vector_type(2)));
typedef __bf16 bf16x2_t __attribute__((ext_vector_type(2)));
__device__ __forceinline__ u32 pack2(float a, float b) {
  f32x2_t v = {a, b};
  bf16x2_t r = __builtin_convertvector(v, bf16x2_t);
  return __builtin_bit_cast(u32, r);
}
__device__ __forceinline__ float silu_f(float x) { return x * __builtin_amdgcn_rcpf(1.f + __expf(-x)); }
__device__ __forceinline__ float softplus_f(float x) {
  float y = __expf(-fabsf(x));
  float l = (y < 1e-2f) ? y * (1.f - y * (0.5f - y * (1.f / 3.f))) : __logf(1.f + y);
  return fmaxf(x, 0.f) + l;
}
__device__ __forceinline__ int opaque_tid() { int t = threadIdx.x; asm volatile("" : "+v"(t)); return t; }
#define MFMA(a, b, c) __builtin_amdgcn_mfma_f32_32x32x16_bf16((a), (b), (c), 0, 0, 0)

__device__ __forceinline__ float wave_sum(float v) {
#pragma unroll
  for (int o = 32; o >= 1; o >>= 1) v += __shfl_xor(v, o);
  return v;
}
__device__ __forceinline__ float block_sum(float v, float* red) {
  v = wave_sum(v);
  __syncthreads();
  if ((threadIdx.x & 63) == 0) red[threadIdx.x >> 6] = v;
  __syncthreads();
  float t = 0.f;
#pragma unroll
  for (int i = 0; i < 8; ++i) t += red[i];
  return t;
}

__device__ __forceinline__ void transpose_tile(const float* __restrict__ W, int K, int N, u16* __restrict__ Wt, int kt, int nt, float* tile) {
  const int tid = opaque_tid();
  {
    int k = tid >> 3, ng = (tid & 7) * 8;
    const float* src = W + (size_t)(kt * 64 + k) * N + nt * 64 + ng;
    float4 a = *(const float4*)src, b = *(const float4*)(src + 4);
    float* d = tile + k * 65 + ng;
    d[0] = a.x; d[1] = a.y; d[2] = a.z; d[3] = a.w; d[4] = b.x; d[5] = b.y; d[6] = b.z; d[7] = b.w;
  }
  __syncthreads();
  {
    int n = tid >> 3, kg = (tid & 7) * 8;
    u32x4 o;
    o[0] = pack2(tile[(kg + 0) * 65 + n], tile[(kg + 1) * 65 + n]);
    o[1] = pack2(tile[(kg + 2) * 65 + n], tile[(kg + 3) * 65 + n]);
    o[2] = pack2(tile[(kg + 4) * 65 + n], tile[(kg + 5) * 65 + n]);
    o[3] = pack2(tile[(kg + 6) * 65 + n], tile[(kg + 7) * 65 + n]);
    *(u32x4*)(Wt + (size_t)(nt * 64 + n) * K + kt * 64 + kg) = o;
  }
  __syncthreads();
}

__device__ __forceinline__ void phase_prep(const Params& P, unsigned char* smem) {
  const int tid = opaque_tid();
  float* fs = (float*)smem;
  const int n_wt = 1024 + 256 + 1552 + 512;
  const int i_pad = n_wt, i_mod = i_pad + 1, i_h2 = i_mod + 384, i_misc = i_h2 + 2080, n_items = i_misc + 1;
  float* w1s = fs + 8192;
  float* w2s = w1s + 33 * 64;
  for (int i = tid; i < 33 * 64; i += NT) w1s[i] = P.in[11][i];
  for (int i = tid; i < 64 * 64; i += NT) w2s[i] = P.in[13][i];
  __syncthreads();
  for (int it = blockIdx.x; it < n_items; it += gridDim.x) {
    if (it < n_wt) {
      int t = it;
      if (t < 1024) transpose_tile(P.in[7], 1024, 4096, (u16*)(P.ws + OFF_WEIN), t / 64, t % 64, fs);
      else if ((t -= 1024) < 256) transpose_tile(P.in[8], 1024, 1024, (u16*)(P.ws + OFF_WEOUT), t / 16, t % 16, fs);
      else if ((t -= 256) < 1552) transpose_tile(P.in[21], 1024, 6208, (u16*)(P.ws + OFF_WOIN), t / 97, t % 97, fs);
      else { t -= 1552; transpose_tile(P.in[28], 2048, 1024, (u16*)(P.ws + OFF_WOOUT), t / 16, t % 16, fs); }
    } else if (it == i_pad) {
      u32 zz = 0; asm volatile("" : "+v"(zz));
      u32x4 z = {zz, zz, zz, zz};
      u32x4* d = (u32x4*)(P.ws + OFF_WOIN + (size_t)6208 * 1024 * 2);
      for (int i = tid; i < 192 * 1024 * 2 / 16; i += NT) d[i] = z;
    } else if (it < i_h2) {
      int m = it - i_mod;
      int layer = m / 192, cg16 = m % 192;
      int kg = tid >> 4, col = cg16 * 16 + (tid & 15);
      const float* w = P.in[4] + (size_t)layer * 1024 * 3072;
      float s0 = 0.f, s1 = 0.f, s2 = 0.f;
#pragma unroll 4
      for (int k = kg * 32; k < kg * 32 + 32; ++k) {
        float wv = w[(size_t)k * 3072 + col];
        s0 += silu_f(P.in[1][k]) * wv;
        s1 += silu_f(P.in[1][1024 + k]) * wv;
        s2 += silu_f(P.in[3][k]) * wv;
      }
      __syncthreads();
      fs[(0 * 32 + kg) * 16 + (tid & 15)] = s0;
      fs[(1 * 32 + kg) * 16 + (tid & 15)] = s1;
      fs[(2 * 32 + kg) * 16 + (tid & 15)] = s2;
      __syncthreads();
      if (tid < 48) {
        int v = tid >> 4, c = tid & 15;
        float s = 0.f;
#pragma unroll 4
        for (int g = 0; g < 32; ++g) s += fs[(v * 32 + g) * 16 + c];
        int cc = cg16 * 16 + c;
        ((float*)(P.ws + OFF_MODS))[(layer * 3 + v) * 3072 + cc] = s + P.in[5][layer * 3072 + cc];
      }
      __syncthreads();
    } else if (it < i_misc) {
      int gp = (it - i_h2) * 8 + (tid >> 6);
      int j = tid & 63, pl = tid >> 6;
      int Lp = gp < LL ? LL : CT;
      int t = gp < LL ? gp : gp - LL;
      float* zs = fs;
      float* h1s = fs + 8 * 40;
      __syncthreads();
      if (j < 33) {
        float z;
        if (j == 0) z = (float)t / (float)(Lp - 1);
        else {
          int bi = (j - 1) & 15;
          float band = 1e-4f + (float)bi * ((15.f - 1e-4f) / 15.f);
          float w = 6.283185307179586f * (float)t / (float)Lp;
          float a = band * w;
          z = (j <= 16) ? cosf(a) : -sinf(a);
        }
        zs[pl * 40 + j] = z;
      }
      __syncthreads();
      {
        float a = P.in[12][j];
#pragma unroll 3
        for (int e = 0; e < 33; ++e) a += zs[pl * 40 + e] * w1s[e * 64 + j];
        h1s[pl * 64 + j] = sinf(P.in[17][j] * a);
      }
      __syncthreads();
      {
        float a = P.in[14][j];
#pragma unroll 4
        for (int i = 0; i < 64; ++i) a += h1s[pl * 64 + i] * w2s[i * 64 + j];
        ((float*)(P.ws + OFF_H2))[(size_t)gp * 64 + j] = sinf(P.in[17][64 + j] * a);
      }
      __syncthreads();
    } else {
      for (int i = tid; i < 256 * 16; i += NT) {
        int pos = i >> 4, j = i & 15;
        float inv = exp2f(-(float)j * (13.287712379549449f / 16.f));
        float sn, cs;
        sincosf((float)pos * inv, &sn, &cs);
        ((float2*)(P.ws + OFF_ROPE))[i] = make_float2(cs, sn);
      }
      if (tid == 0) {
        int* cnt = (int*)(P.ws + OFF_CNT);
        cnt[0] = 0;
        const float* lp = P.in[19];
        float a = 0.f, b = 0.f;
        for (int i = 0; i < 64; ++i) { a += lp[i] * lp[64 + i]; b += lp[128 + i] * lp[192 + i]; }
        ((float*)cnt)[1] = expf(a) - expf(b) + 0.2f;
      }
    }
  }
}

__device__ __forceinline__ void phase_norm(const Params& P, int layer, u16* __restrict__ xn) {
  const int tid_ = opaque_tid(); const int lane = tid_ & 63, wv = tid_ >> 6;
  const float* mods = (const float*)(P.ws + OFF_MODS) + (size_t)layer * 3 * 3072;
  const float* nw = P.in[6] + layer * 1024;
  const u16* out0 = (const u16*)(P.ws + OFF_OUT0);
  for (int it = blockIdx.x; it < NTOK / 8; it += gridDim.x) {
    int tok = it * 8 + wv;
    int b = tok / SS, s = tok % SS;
    const float* src = (s < CT) ? (P.in[2] + ((size_t)b * CT + s) * DM) : (P.in[0] + ((size_t)b * LL + (s - CT)) * DM);
    const float* mv = mods + ((s < CT) ? 2 : b) * 3072;
    float4 v[4];
    float ss = 0.f;
#pragma unroll
    for (int i = 0; i < 4; ++i) {
      int col = i * 256 + lane * 4;
      v[i] = *(const float4*)(src + col);
      if (layer == 1) {
        u32x2 d = *(const u32x2*)(out0 + (size_t)tok * DM + col);
        v[i].x += bf2f((u16)(d[0] & 0xffff)); v[i].y += bf2f((u16)(d[0] >> 16));
        v[i].z += bf2f((u16)(d[1] & 0xffff)); v[i].w += bf2f((u16)(d[1] >> 16));
      }
      ss += v[i].x * v[i].x + v[i].y * v[i].y + v[i].z * v[i].z + v[i].w * v[i].w;
    }
    ss = wave_sum(ss);
    float rstd = rsqrtf(ss * (1.f / DM) + EPSN);
#pragma unroll
    for (int i = 0; i < 4; ++i) {
      int col = i * 256 + lane * 4;
      float4 w = *(const float4*)(nw + col);
      float4 sh = *(const float4*)(mv + col);
      float4 sc = *(const float4*)(mv + 1024 + col);
      float a0 = v[i].x * rstd * w.x * (1.f + sc.x) + sh.x;
      float a1 = v[i].y * rstd * w.y * (1.f + sc.y) + sh.y;
      float a2 = v[i].z * rstd * w.z * (1.f + sc.z) + sh.z;
      float a3 = v[i].w * rstd * w.w * (1.f + sc.w) + sh.w;
      u32x2 o; o[0] = pack2(a0, a1); o[1] = pack2(a2, a3);
      *(u32x2*)(xn + (size_t)tok * DM + col) = o;
    }
  }
}

__device__ __forceinline__ void phase_filter(const Params& P, unsigned char* smem) {
  const int tid = opaque_tid();
  float* hs = (float*)smem;
  float* wsm = hs + 128 * 65;
  const float* H2 = (const float*)(P.ws + OFF_H2);
  const float* w3 = P.in[15];
  const float* b3 = P.in[16];
  const int nbig = 128 * 16, nsm = 2 * 16;
  const int tq = tid & 31, cg8 = tid >> 5;
  for (int it = blockIdx.x; it < nbig + nsm; it += gridDim.x) {
    int Lp, tt, ct; float* dst; size_t hoff;
    if (it < nbig) { Lp = LL; tt = it >> 4; ct = it & 15; dst = P.out; hoff = 0; }
    else { int k = it - nbig; Lp = CT; tt = k >> 4; ct = k & 15; dst = (float*)(P.ws + OFF_KRAW256); hoff = (size_t)LL * 64; }
    __syncthreads();
    for (int i = tid; i < 128 * 16; i += NT) {
      int rr = i >> 4, c4 = (i & 15) * 4;
      float4 v = *(const float4*)(H2 + hoff + (size_t)(tt * 128 + rr) * 64 + c4);
      float* d = hs + rr * 65 + c4; d[0] = v.x; d[1] = v.y; d[2] = v.z; d[3] = v.w;
    }
    for (int i = tid; i < 64 * 32; i += NT) {
      int rr = i >> 5, c4 = (i & 31) * 4;
      *(float4*)(wsm + rr * 128 + c4) = *(const float4*)(w3 + (size_t)rr * 2048 + ct * 128 + c4);
    }
    __syncthreads();
    float acc[4][8];
#pragma unroll
    for (int e = 0; e < 8; ++e) { float b = b3[ct * 128 + cg8 * 8 + e]; acc[0][e] = b; acc[1][e] = b; acc[2][e] = b; acc[3][e] = b; }
#pragma unroll 4
    for (int j = 0; j < 64; ++j) {
      float a[4], wv[8];
#pragma unroll
      for (int i = 0; i < 4; ++i) a[i] = hs[(tq + 32 * i) * 65 + j];
      *(float4*)&wv[0] = *(const float4*)(wsm + j * 128 + cg8 * 8);
      *(float4*)&wv[4] = *(const float4*)(wsm + j * 128 + cg8 * 8 + 4);
#pragma unroll
      for (int i = 0; i < 4; ++i)
#pragma unroll
        for (int e = 0; e < 8; ++e) acc[i][e] += a[i] * wv[e];
    }
    const float mind = -3.0701134573253944f, maxd = -15.350567286626972f;
#pragma unroll
    for (int e = 0; e < 8; ++e) {
      const int col = ct * 128 + cg8 * 8 + e;
      const float delta = fabsf(mind + (float)(col & 511) * ((maxd - mind) / 511.f));
#pragma unroll
      for (int i = 0; i < 4; ++i) {
        const int t = tt * 128 + tq + 32 * i;
        const float tlin = (float)t / (float)(Lp - 1);
        dst[(size_t)col * Lp + t] = acc[i][e] * expf(-tlin * delta);
      }
    }
  }
}

constexpr int EP = 36;
template <int MODE>
__device__ __forceinline__ void gemm_epilogue(const Params& P, int row0, int col0, const f32x16& acc, float* wl);

__device__ __forceinline__ void glds_tile(const u16* __restrict__ g, int ld, int k0, unsigned char* ldst, int tid) {
#pragma unroll
  for (int p = 0; p < 4; ++p) {
    const int slot = p * 512 + tid;
    const int row = slot >> 3, kc = (slot & 7) ^ ((row >> 1) & 7);
    unsigned off = (unsigned)(row * ld + kc * 8);
    asm volatile("" : "+v"(off));
    __builtin_amdgcn_global_load_lds((const unsigned*)((g + k0) + off), (unsigned*)(ldst + slot * 16), 16, 0, 0);
  }
}

template <int MODE>
__device__ __forceinline__ void gemm_phase(const Params& P, const u16* __restrict__ A, int lda, const u16* __restrict__ Bt, int ldb,
                           int K, int nMt, int nNt, unsigned char* smem) {
  const int tid = opaque_tid(), lane = tid & 63, w = tid >> 6;
  const int r = lane & 31, h = lane >> 5;
  const int wm = w >> 2, wn = w & 3;
  unsigned char* As = smem;
  unsigned char* Bs = smem + 2 * 32768;
  const int KT = K / 64;
  const int sw = (r >> 1) & 7;
  const int nTiles = nMt * nNt;
  const int bslot = (blockIdx.x & 7) * (gridDim.x >> 3) + (blockIdx.x >> 3);
  for (int tile0 = 0; tile0 < nTiles; tile0 += gridDim.x) {
    const int T = tile0 + ((gridDim.x & 7) ? (int)blockIdx.x : bslot);
    if (T >= nTiles) break;
    int mt, nt;
    {
      const int nig = 8 * nNt, gid = T / nig, fm = gid * 8, gsz = min(nMt - fm, 8), within = T - gid * nig;
      mt = fm + within % gsz; nt = within / gsz;
    }
    int arow0 = mt * 256;
    const u16* Ap = A + (size_t)arow0 * lda;
    const u16* Bp = Bt + (size_t)(nt * 256) * ldb;
    f32x16 acc[4][2];
#pragma unroll
    for (int i = 0; i < 4; ++i)
#pragma unroll
      for (int j = 0; j < 2; ++j)
#pragma unroll
        for (int e = 0; e < 16; ++e) acc[i][j][e] = 0.f;
    __syncthreads();
    glds_tile(Ap, lda, 0, As, tid);
    glds_tile(Bp, ldb, 0, Bs, tid);
    asm volatile("s_waitcnt vmcnt(0)" ::: "memory");
    __syncthreads();
    for (int kt = 0; kt < KT; ++kt) {
      const int buf = kt & 1;
      const unsigned char* as = As + buf * 32768 + (wm * 128 + r) * 128;
      const unsigned char* bs = Bs + buf * 32768 + (wn * 64 + r) * 128;
      bf16x8 af[2][4], bfr[2][2];
      {
        const int o0 = ((0 * 2 + h) ^ sw) * 16;
#pragma unroll
        for (int i = 0; i < 4; ++i) af[0][i] = *(const bf16x8*)(as + i * 4096 + o0);
#pragma unroll
        for (int j = 0; j < 2; ++j) bfr[0][j] = *(const bf16x8*)(bs + j * 4096 + o0);
      }
#pragma unroll
      for (int ks = 0; ks < 4; ++ks) {
        if (ks + 1 < 4) {
          const int o1 = (((ks + 1) * 2 + h) ^ sw) * 16;
#pragma unroll
          for (int i = 0; i < 4; ++i) af[(ks + 1) & 1][i] = *(const bf16x8*)(as + i * 4096 + o1);
#pragma unroll
          for (int j = 0; j < 2; ++j) bfr[(ks + 1) & 1][j] = *(const bf16x8*)(bs + j * 4096 + o1);
        }
        __builtin_amdgcn_sched_barrier(0);
#pragma unroll
        for (int i = 0; i < 4; ++i)
#pragma unroll
          for (int j = 0; j < 2; ++j) acc[i][j] = MFMA(af[ks & 1][i], bfr[ks & 1][j], acc[i][j]);
        __builtin_amdgcn_sched_barrier(0);
        if (ks == 0 && kt + 1 < KT) glds_tile(Ap, lda, (kt + 1) * 64, As + (buf ^ 1) * 32768, tid);
        if (ks == 1 && kt + 1 < KT) glds_tile(Bp, ldb, (kt + 1) * 64, Bs + (buf ^ 1) * 32768, tid);
        __builtin_amdgcn_sched_barrier(0);
      }
      asm volatile("s_waitcnt vmcnt(0)" ::: "memory");
      __syncthreads();
    }
#pragma unroll
    for (int i = 0; i < 4; ++i)
#pragma unroll
      for (int j = 0; j < 2; ++j)
      {
        gemm_epilogue<MODE>(P, arow0 + wm * 128 + i * 32, nt * 256 + wn * 64 + j * 32, acc[i][j], (float*)smem + w * (32 * EP));
        __builtin_amdgcn_sched_barrier(0);
      }
  }
}

__device__ __forceinline__ void lds_wave_fence() { asm volatile("s_waitcnt lgkmcnt(0)" ::: "memory"); }
__device__ __forceinline__ void stage_rowmajor(float* wl, const f32x16& acc, int r, int h) {
#pragma unroll
  for (int j = 0; j < 16; ++j) wl[((j & 3) + 8 * (j >> 2) + 4 * h) * EP + r] = acc[j];
  lds_wave_fence();
}
__device__ __forceinline__ void stage_colmajor(float* wl, const f32x16& acc, int r, int h) {
#pragma unroll
  for (int g = 0; g < 4; ++g) *(float4*)(wl + r * EP + 8 * g + 4 * h) = make_float4(acc[4 * g], acc[4 * g + 1], acc[4 * g + 2], acc[4 * g + 3]);
  lds_wave_fence();
}
__device__ __forceinline__ u32x4 pack8(const float4& a, const float4& b) {
  u32x4 o; o[0] = pack2(a.x, a.y); o[1] = pack2(a.z, a.w); o[2] = pack2(b.x, b.y); o[3] = pack2(b.z, b.w); return o;
}

template <>
__device__ __forceinline__ void gemm_epilogue<0>(const Params& P, int row0, int col0, const f32x16& acc, float* wl) {
  const int lane = opaque_tid() & 63, r = lane & 31, h = lane >> 5;
  const int b = row0 / SS, s0 = row0 % SS;
  if (col0 < 1536 || (col0 >= 3072 && col0 < 3584)) {
    stage_colmajor(wl, acc, r, h);
#pragma unroll
    for (int k = 0; k < 2; ++k) {
      const int id = lane + 64 * k, col = id >> 2, rc = (id & 3) * 8;
      const float4 a = *(const float4*)(wl + col * EP + rc), c = *(const float4*)(wl + col * EP + rc + 4);
      const u32x4 pv8 = pack8(a, c);
      if (col0 < 1536) *(u32x4*)((u16*)(P.ws + OFF_HYT) + ((size_t)b * 1536 + col0 + col) * SS + s0 + rc) = pv8;
      else {
        const int cc = col0 + col - 3072;
        u16* dst = (u16*)(P.ws + OFF_VT) + ((size_t)(b * 4 + (cc >> 7)) * 128 + (cc & 127)) * SS + s0 + (rc & ~15);
        u32x2 lo, hi; lo[0] = pv8[0]; lo[1] = pv8[1]; hi[0] = pv8[2]; hi[1] = pv8[3];
        *(u32x2*)(dst + ((rc & 8) ? 4 : 0)) = lo;
        *(u32x2*)(dst + ((rc & 8) ? 12 : 8)) = hi;
      }
    }
  } else if (col0 < 2048 || col0 >= 3584) {
    stage_rowmajor(wl, acc, r, h);
    u16* base = (col0 < 2048) ? ((u16*)(P.ws + OFF_HG) + (col0 - 1536)) : ((u16*)(P.ws + OFF_AG) + (col0 - 3584));
#pragma unroll
    for (int k = 0; k < 2; ++k) {
      const int id = lane + 64 * k, row = id >> 2, c8 = (id & 3) * 8;
      const float4 a = *(const float4*)(wl + row * EP + c8), c = *(const float4*)(wl + row * EP + c8 + 4);
      *(u32x4*)(base + (size_t)(row0 + row) * 512 + c8) = pack8(a, c);
    }
  } else {
    stage_rowmajor(wl, acc, r, h);
    const bool isq = col0 < 2560;
    const int cc0 = col0 - (isq ? 2048 : 2560);
    const int head = cc0 >> 7, comp = (cc0 >> 6) & 1, dt0 = cc0 & 63;
    u16* base = (u16*)(P.ws + (isq ? OFF_Q : OFF_K)) + ((size_t)((b * 4 + head) * 2 + comp) * SS) * 64 + dt0;
    const float qs = isq ? (0.125f * 1.4426950408889634f) : 1.f;
#pragma unroll
    for (int k = 0; k < 2; ++k) {
      const int id = lane + 64 * k, row = id >> 2, c8 = (id & 3) * 8;
      const int s = s0 + row;
      float v[8], pv[8];
      *(float4*)&v[0] = *(const float4*)(wl + row * EP + c8); *(float4*)&v[4] = *(const float4*)(wl + row * EP + c8 + 4);
      *(float4*)&pv[0] = *(const float4*)(wl + row * EP + (c8 ^ 16)); *(float4*)&pv[4] = *(const float4*)(wl + row * EP + (c8 ^ 16) + 4);
      float o[8];
      if (s >= CT) {
        const int t = s - CT;
        const int pos = (dt0 == 0) ? (t >> 6) : (t & 63);
        const float4* rp = (const float4*)((const float2*)(P.ws + OFF_ROPE) + pos * 16 + (c8 & 15));
        float cs[8], sn[8];
#pragma unroll
        for (int i = 0; i < 4; ++i) { float4 q4 = rp[i]; cs[2 * i] = q4.x; sn[2 * i] = q4.y; cs[2 * i + 1] = q4.z; sn[2 * i + 1] = q4.w; }
        const bool hi16 = (c8 & 16) != 0;
#pragma unroll
        for (int i = 0; i < 8; ++i) o[i] = (hi16 ? (pv[i] * sn[i] + v[i] * cs[i]) : (v[i] * cs[i] - pv[i] * sn[i])) * qs;
      } else {
#pragma unroll
        for (int i = 0; i < 8; ++i) o[i] = v[i] * qs;
      }
      u32x4 ov; ov[0] = pack2(o[0], o[1]); ov[1] = pack2(o[2], o[3]); ov[2] = pack2(o[4], o[5]); ov[3] = pack2(o[6], o[7]);
      *(u32x4*)(base + (size_t)s * 64 + c8) = ov;
    }
  }
}
template <>
__device__ __forceinline__ void gemm_epilogue<1>(const Params& P, int row0, int col0, const f32x16& acc, float* wl) {
  const int lane = opaque_tid() & 63, r = lane & 31, h = lane >> 5;
  const int b = row0 / SS, s0 = row0 % SS;
  stage_rowmajor(wl, acc, r, h);
  const float* gp = (const float*)(P.ws + OFF_MODS) + ((s0 < CT) ? 2 : b) * 3072 + 2048 + col0;
  u16* base = (u16*)(P.ws + OFF_OUT0) + col0;
#pragma unroll
  for (int k = 0; k < 2; ++k) {
    const int id = lane + 64 * k, row = id >> 2, c8 = (id & 3) * 8;
    float4 a = *(const float4*)(wl + row * EP + c8), c = *(const float4*)(wl + row * EP + c8 + 4);
    const float4 g0 = *(const float4*)(gp + c8), g1 = *(const float4*)(gp + c8 + 4);
    a.x *= g0.x; a.y *= g0.y; a.z *= g0.z; a.w *= g0.w; c.x *= g1.x; c.y *= g1.y; c.z *= g1.z; c.w *= g1.w;
    *(u32x4*)(base + (size_t)(row0 + row) * DM + c8) = pack8(a, c);
  }
}
template <>
__device__ __forceinline__ void gemm_epilogue<2>(const Params& P, int row0, int col0, const f32x16& acc, float* wl) {
  const int lane = opaque_tid() & 63, r = lane & 31, h = lane >> 5;
  const int b = row0 / SS, s0 = row0 % SS;
  if (col0 >= 6208) return;
  if (col0 < 2048 && s0 < CT) return;
  stage_rowmajor(wl, acc, r, h);
  if (col0 < 2048) {
    u16* base = (u16*)(P.ws + OFF_ZB) + ((size_t)b * LL + (s0 - CT)) * 2048 + col0;
#pragma unroll
    for (int k = 0; k < 2; ++k) {
      const int id = lane + 64 * k, row = id >> 2, c8 = (id & 3) * 8;
      const float4 a = *(const float4*)(wl + row * EP + c8), c = *(const float4*)(wl + row * EP + c8 + 4);
      *(u32x4*)(base + (size_t)row * 2048 + c8) = pack8(a, c);
    }
  } else if (col0 < 6144) {
    const int cc0 = col0 - 2048;
    u16* base = (u16*)(P.ws + OFF_XBC) + cc0;
    u16* halo = (u16*)(P.ws + OFF_HALO) + cc0;
#pragma unroll
    for (int k = 0; k < 2; ++k) {
      const int id = lane + 64 * k, row = id >> 2, c8 = (id & 3) * 8;
      const float4 a = *(const float4*)(wl + row * EP + c8), c = *(const float4*)(wl + row * EP + c8 + 4);
      const u32x4 ov = pack8(a, c);
      const int tok = row0 + row;
      *(u32x4*)(base + (size_t)tok * 4096 + c8) = ov;
      const int m = tok & 127;
      if (m == 0) *(u32x4*)(halo + ((size_t)(tok >> 7) * 2 + 0) * 4096 + c8) = ov;
      if (m == 127) *(u32x4*)(halo + ((size_t)(tok >> 7) * 2 + 1) * 4096 + c8) = ov;
    }
  } else {
    const int cc0 = col0 - 6144;
    const float* bp = P.in[24] + cc0;
    float* base = (float*)(P.ws + OFF_DT) + cc0;
#pragma unroll
    for (int k = 0; k < 2; ++k) {
      const int id = lane + 64 * k, row = id >> 2, c8 = (id & 3) * 8;
      float4 a = *(const float4*)(wl + row * EP + c8), c = *(const float4*)(wl + row * EP + c8 + 4);
      const float4 b0 = *(const float4*)(bp + c8), b1 = *(const float4*)(bp + c8 + 4);
      a.x = softplus_f(a.x + b0.x); a.y = softplus_f(a.y + b0.y); a.z = softplus_f(a.z + b0.z); a.w = softplus_f(a.w + b0.w);
      c.x = softplus_f(c.x + b1.x); c.y = softplus_f(c.y + b1.y); c.z = softplus_f(c.z + b1.z); c.w = softplus_f(c.w + b1.w);
      float* d = base + (size_t)(row0 + row) * 64 + c8;
      *(float4*)d = a; *(float4*)(d + 4) = c;
    }
  }
}
template <>
__device__ __forceinline__ void gemm_epilogue<3>(const Params& P, int row0, int col0, const f32x16& acc, float* wl) {
  const int lane = opaque_tid() & 63, r = lane & 31, h = lane >> 5;
  const int b = row0 / LL, t0 = row0 % LL;
  stage_rowmajor(wl, acc, r, h);
  const float* gp = (const float*)(P.ws + OFF_MODS) + 3 * 3072 + b * 3072 + 2048 + col0;
  const u16* o0 = (const u16*)(P.ws + OFF_OUT0) + ((size_t)b * SS + CT + t0) * DM + col0;
  const float* xin = P.in[0] + (size_t)row0 * DM + col0;
  float* dst = P.out + (size_t)row0 * DM + col0;
#pragma unroll
  for (int k = 0; k < 4; ++k) {
    const int id = lane + 64 * k, row = id >> 3, c4 = (id & 7) * 4;
    const float4 a = *(const float4*)(wl + row * EP + c4);
    const float4 g = *(const float4*)(gp + c4);
    const float4 x = *(const float4*)(xin + (size_t)row * DM + c4);
    const u32x2 ob = *(const u32x2*)(o0 + (size_t)row * DM + c4);
    float4 o;
    o.x = x.x + bf2f((u16)(ob[0] & 0xffff)) + g.x * a.x;
    o.y = x.y + bf2f((u16)(ob[0] >> 16)) + g.y * a.y;
    o.z = x.z + bf2f((u16)(ob[1] & 0xffff)) + g.z * a.z;
    o.w = x.w + bf2f((u16)(ob[1] >> 16)) + g.w * a.w;
    *(float4*)(dst + (size_t)row * DM + c4) = o;
  }
}

__device__ __forceinline__ float2 cmul(float2 a, float2 b) { return make_float2(a.x * b.x - a.y * b.y, a.x * b.y + a.y * b.x); }

__device__ __forceinline__ void bf4_fwd(float2& a0, float2& a1, float2& a2, float2& a3) {
  float2 t0 = make_float2(a0.x + a2.x, a0.y + a2.y), t1 = make_float2(a0.x - a2.x, a0.y - a2.y);
  float2 t2 = make_float2(a1.x + a3.x, a1.y + a3.y), t3 = make_float2(a1.x - a3.x, a1.y - a3.y);
  a0 = make_float2(t0.x + t2.x, t0.y + t2.y); a2 = make_float2(t0.x - t2.x, t0.y - t2.y);
  a1 = make_float2(t1.x + t3.y, t1.y - t3.x);
  a3 = make_float2(t1.x - t3.y, t1.y + t3.x);
}
__device__ __forceinline__ void bf4_inv(float2& a0, float2& a1, float2& a2, float2& a3) {
  float2 t0 = make_float2(a0.x + a2.x, a0.y + a2.y), t1 = make_float2(a0.x - a2.x, a0.y - a2.y);
  float2 t2 = make_float2(a1.x + a3.x, a1.y + a3.y), t3 = make_float2(a1.x - a3.x, a1.y - a3.y);
  a0 = make_float2(t0.x + t2.x, t0.y + t2.y); a2 = make_float2(t0.x - t2.x, t0.y - t2.y);
  a1 = make_float2(t1.x - t3.y, t1.y + t3.x);
  a3 = make_float2(t1.x + t3.y, t1.y - t3.x);
}
template <bool INV>
__device__ __forceinline__ void fft_pass4(float2* X, const int lq, const int tid) {
  const int q = 1 << lq;
  for (int i = tid; i < 4096; i += NT) {
    int blk = i >> lq, j = i & (q - 1);
    int base = (blk << (lq + 2)) + j;
    float sn, cs;
    sincospif(2.f * (float)j / (float)(4 * q), &sn, &cs);
    const float2 w1 = make_float2(cs, INV ? sn : -sn);
    const float2 w2 = cmul(w1, w1), w3 = cmul(w2, w1);
    float2 a0 = X[base], a1 = X[base + q], a2 = X[base + 2 * q], a3 = X[base + 3 * q];
    if (!INV) { bf4_fwd(a0, a1, a2, a3); a1 = cmul(a1, w1); a2 = cmul(a2, w2); a3 = cmul(a3, w3); }
    else { a1 = cmul(a1, w1); a2 = cmul(a2, w2); a3 = cmul(a3, w3); bf4_inv(a0, a1, a2, a3); }
    X[base] = a0; X[base + q] = a1; X[base + 2 * q] = a2; X[base + 3 * q] = a3;
  }
}
template <bool INV>
__device__ __forceinline__ void fft_pass16(float2* X, const int lq, const int tid) {
  const int q = 1 << lq, qq = q >> 2, lqq = lq - 2;
  const float sg = INV ? 1.f : -1.f;
#pragma unroll 1
  for (int i = tid; i < 1024; i += NT) {
    const int blk = i >> lqq, jp = i & (qq - 1);
    const int base = (blk << (lq + 2)) + jp;
    float2 e[4][4];
#pragma unroll
    for (int a = 0; a < 4; ++a)
#pragma unroll
      for (int b = 0; b < 4; ++b) e[a][b] = X[base + a * q + b * qq];
    float sn, cs;
    sincospif(2.f * (float)jp / (float)(4 * q), &sn, &cs);
    const float2 wj = make_float2(cs, sg * sn);
    const float2 wj2 = cmul(wj, wj), w4 = cmul(wj2, wj2);
    const float2 w42 = cmul(w4, w4), w43 = cmul(w42, w4);
    const float2 c16[4] = {make_float2(1.f, 0.f), make_float2(0.92387953251128674f, sg * 0.38268343236508977f),
                           make_float2(0.70710678118654752f, sg * 0.70710678118654752f), make_float2(0.38268343236508977f, sg * 0.92387953251128674f)};
    if (!INV) {
#pragma unroll
      for (int b = 0; b < 4; ++b) {
        const float2 w1 = cmul(wj, c16[b]), w2 = cmul(w1, w1), w3 = cmul(w2, w1);
        bf4_fwd(e[0][b], e[1][b], e[2][b], e[3][b]);
        e[1][b] = cmul(e[1][b], w1); e[2][b] = cmul(e[2][b], w2); e[3][b] = cmul(e[3][b], w3);
      }
#pragma unroll
      for (int a = 0; a < 4; ++a) {
        bf4_fwd(e[a][0], e[a][1], e[a][2], e[a][3]);
        e[a][1] = cmul(e[a][1], w4); e[a][2] = cmul(e[a][2], w42); e[a][3] = cmul(e[a][3], w43);
      }
    } else {
#pragma unroll
      for (int a = 0; a < 4; ++a) {
        e[a][1] = cmul(e[a][1], w4); e[a][2] = cmul(e[a][2], w42); e[a][3] = cmul(e[a][3], w43);
        bf4_inv(e[a][0], e[a][1], e[a][2], e[a][3]);
      }
#pragma unroll
      for (int b = 0; b < 4; ++b) {
        const float2 w1 = cmul(wj, c16[b]), w2 = cmul(w1, w1), w3 = cmul(w2, w1);
        e[1][b] = cmul(e[1][b], w1); e[2][b] = cmul(e[2][b], w2); e[3][b] = cmul(e[3][b], w3);
        bf4_inv(e[0][b], e[1][b], e[2][b], e[3][b]);
      }
    }
#pragma unroll
    for (int a = 0; a < 4; ++a)
#pragma unroll
      for (int b = 0; b < 4; ++b) X[base + a * q + b * qq] = e[a][b];
  }
}
__device__ __forceinline__ void fft_fwd(float2* X) {
  const int tid = opaque_tid();
  __syncthreads(); fft_pass16<false>(X, 12, tid);
  __syncthreads(); fft_pass16<false>(X, 8, tid);
  __syncthreads(); fft_pass16<false>(X, 4, tid);
  __syncthreads(); fft_pass4<false>(X, 0, tid);
  __syncthreads();
}
__device__ __forceinline__ void fft_fwd_noq1(float2* X) {
  const int tid = opaque_tid();
  __syncthreads(); fft_pass16<false>(X, 12, tid);
  __syncthreads(); fft_pass16<false>(X, 8, tid);
  __syncthreads(); fft_pass16<false>(X, 4, tid);
  __syncthreads();
}
__device__ __forceinline__ void fft_inv_noq1(float2* X) {
  const int tid = opaque_tid();
  __syncthreads(); fft_pass16<true>(X, 4, tid);
  __syncthreads(); fft_pass16<true>(X, 8, tid);
  __syncthreads(); fft_pass16<true>(X, 12, tid);
  __syncthreads();
}
__device__ __forceinline__ void fft_inv(float2* X) {
  const int tid = opaque_tid();
  __syncthreads(); fft_pass4<true>(X, 0, tid);
  __syncthreads(); fft_pass16<true>(X, 4, tid);
  __syncthreads(); fft_pass16<true>(X, 8, tid);
  __syncthreads(); fft_pass16<true>(X, 12, tid);
  __syncthreads();
}

__device__ __forceinline__ float conv3(const u16* row, int n, int Ls, float w0, float w1, float w2, float bias) {
  float a = bias + w1 * bf2f(row[n]);
  if (n > 0) a += w0 * bf2f(row[n - 1]);
  if (n + 1 < Ls) a += w2 * bf2f(row[n + 1]);
  return a;
}

__device__ __forceinline__ void conv3x4(const u16* __restrict__ row, int n, int Ls, float w0, float w1, float w2, float bias, float out[4]) {
  const u32x2 v = *(const u32x2*)(row + n);
  const float x0 = bf2f((u16)(v[0] & 0xffff)), x1 = bf2f((u16)(v[0] >> 16)), x2 = bf2f((u16)(v[1] & 0xffff)), x3 = bf2f((u16)(v[1] >> 16));
  const float xm = (n > 0) ? bf2f(row[n - 1]) : 0.f;
  const float xp = (n + 4 < Ls) ? bf2f(row[n + 4]) : 0.f;
  out[0] = bias + w0 * xm + w1 * x0 + w2 * x1;
  out[1] = bias + w0 * x0 + w1 * x1 + w2 * x2;
  out[2] = bias + w0 * x1 + w1 * x2 + w2 * x3;
  out[3] = bias + w0 * x2 + w1 * x3 + w2 * xp;
}
__device__ __forceinline__ void ld4c(const float2* p, float2 o[4]) {
  const float4 a = *(const float4*)p, b = *(const float4*)(p + 2);
  o[0] = make_float2(a.x, a.y); o[1] = make_float2(a.z, a.w); o[2] = make_float2(b.x, b.y); o[3] = make_float2(b.z, b.w);
}
__device__ __forceinline__ void st4c(float2* p, const float2 o[4]) {
  *(float4*)p = make_float4(o[0].x, o[0].y, o[1].x, o[1].y);
  *(float4*)(p + 2) = make_float4(o[2].x, o[2].y, o[3].x, o[3].y);
}

__device__ __forceinline__ void hyena_latent_item(const Params& P, int c, unsigned char* smem) {
  const int tid = opaque_tid();
  float2* X = (float2*)smem;
  float* red = (float*)(smem + 131072);
  unsigned char* scr = P.ws + OFF_FFTS + (size_t)blockIdx.x * (512 * 1024);
  float2* ABUF = (float2*)scr; float2* ZBUF = ABUF + LL;
  u16* hyt = (u16*)(P.ws + OFF_HYT);
  const float* sw = P.in[9]; const float* sb = P.in[10];
  const float* kraw = P.out;
  const float invL = 1.f / (float)LL;
  for (int rep = 0; rep < HYL_REP; ++rep)
  for (int o = 0; o < 2; ++o) {
    const float* hf = kraw + (size_t)((0 * 2 + o) * 512 + c) * LL;
    const float* hb = kraw + (size_t)((1 * 2 + o) * 512 + c) * LL;
    float2 E[32];
    __syncthreads();
    if (o == 0) {
      const float v0w = sw[0 * 1536 + c], v1w = sw[1 * 1536 + c], v2w = sw[2 * 1536 + c], vbs = sb[c];
      const u16* r0 = hyt + ((size_t)0 * 1536 + c) * SS + CT;
      const u16* r1 = hyt + ((size_t)1 * 1536 + c) * SS + CT;
      for (int n = opaque_tid() * 4; n < LL; n += NT * 4) {
        float a[4], b4[4]; float2 xv[4];
        conv3x4(r0, n, LL, v0w, v1w, v2w, vbs, a);
        conv3x4(r1, n, LL, v0w, v1w, v2w, vbs, b4);
#pragma unroll
        for (int i = 0; i < 4; ++i) xv[i] = make_float2(a[i], b4[i]);
        st4c(ZBUF + n, xv);
        st4c(X + n, xv);
      }
    } else {
      for (int n = opaque_tid() * 4; n < LL; n += NT * 4) { float2 xv[4]; ld4c(ZBUF + n, xv); st4c(X + n, xv); }
    }
    fft_fwd_noq1(X);
#pragma unroll
    for (int k = 0; k < 8; ++k) {
      ld4c(X + (tid + k * NT) * 4, &E[4 * k]);
      bf4_fwd(E[4 * k], E[4 * k + 1], E[4 * k + 2], E[4 * k + 3]);
    }
    float ns = 0.f;
    for (int n = opaque_tid() * 4; n < LL; n += NT * 4) {
      const float4 f4 = *(const float4*)(hf + n), b4 = *(const float4*)(hb + LL - n - 4);
      const float kf[4] = {f4.x, f4.y, f4.z, f4.w};
      const float kb[4] = {(n > 0) ? hb[LL - n] : 0.f, b4.w, b4.z, b4.y};
      float2 xv[4];
#pragma unroll
      for (int i = 0; i < 4; ++i) { ns += fabsf(kf[i]) + fabsf(kb[i]); xv[i] = make_float2(kf[i] + kb[i], 0.f); }
      st4c(X + n, xv);
    }
    const float inn = 1.f / block_sum(ns, red);
    fft_fwd_noq1(X);
#pragma unroll
    for (int k = 0; k < 8; ++k) {
      float2 xv[4]; ld4c(X + (tid + k * NT) * 4, xv);
      bf4_fwd(xv[0], xv[1], xv[2], xv[3]);
#pragma unroll
      for (int i = 0; i < 4; ++i) { float2 v = cmul(xv[i], E[4 * k + i]); xv[i] = make_float2(v.x * inn, v.y * inn); }
      bf4_inv(xv[0], xv[1], xv[2], xv[3]);
      st4c(X + (tid + k * NT) * 4, xv);
    }
    fft_inv_noq1(X);
    for (int n = opaque_tid() * 4; n < LL; n += NT * 4) {
      float2 xa[4], zv[4];
      ld4c(X + n, xa);
      st4c(ABUF + n, xa);
      ld4c(ZBUF + n, zv);
#pragma unroll
      for (int i = 0; i < 4; ++i) {
        float sn, cs; sincospif((float)(n + i) * invL, &sn, &cs);
        xa[i] = cmul(zv[i], make_float2(cs, -sn));
      }
      st4c(X + n, xa);
    }
    fft_fwd_noq1(X);
#pragma unroll
    for (int k = 0; k < 8; ++k) {
      ld4c(X + (tid + k * NT) * 4, &E[4 * k]);
      bf4_fwd(E[4 * k], E[4 * k + 1], E[4 * k + 2], E[4 * k + 3]);
    }
    for (int n = opaque_tid() * 4; n < LL; n += NT * 4) {
      const float4 f4 = *(const float4*)(hf + n), b4 = *(const float4*)(hb + LL - n - 4);
      const float kf[4] = {f4.x, f4.y, f4.z, f4.w};
      const float kb[4] = {(n > 0) ? hb[LL - n] : 0.f, b4.w, b4.z, b4.y};
      float2 xv[4];
#pragma unroll
      for (int i = 0; i < 4; ++i) {
        float sn, cs; sincospif((float)(n + i) * invL, &sn, &cs);
        const float d = kf[i] - kb[i];
        xv[i] = make_float2(d * cs, -d * sn);
      }
      st4c(X + n, xv);
    }
    fft_fwd_noq1(X);
#pragma unroll
    for (int k = 0; k < 8; ++k) {
      float2 xv[4]; ld4c(X + (tid + k * NT) * 4, xv);
      bf4_fwd(xv[0], xv[1], xv[2], xv[3]);
#pragma unroll
      for (int i = 0; i < 4; ++i) { float2 v = cmul(xv[i], E[4 * k + i]); xv[i] = make_float2(v.x * inn, v.y * inn); }
      bf4_inv(xv[0], xv[1], xv[2], xv[3]);
      st4c(X + (tid + k * NT) * 4, xv);
    }
    fft_inv_noq1(X);
    const int colg = (o == 0 ? 512 : 1024) + c;
    const float g0w = sw[0 * 1536 + colg], g1w = sw[1 * 1536 + colg], g2w = sw[2 * 1536 + colg], gbs = sb[colg];
    const u16* q0 = hyt + ((size_t)0 * 1536 + colg) * SS + CT;
    const u16* q1 = hyt + ((size_t)1 * 1536 + colg) * SS + CT;
    const float hbias = P.in[18][o * 512 + c];
    const float sc = 0.5f * invL;
    for (int n = opaque_tid() * 4; n < LL; n += NT * 4) {
      float2 bx[4], av[4], xv[4];
      float ga[4], gb[4];
      ld4c(X + n, bx); ld4c(ABUF + n, av); ld4c(ZBUF + n, xv);
      conv3x4(q0, n, LL, g0w, g1w, g2w, gbs, ga);
      conv3x4(q1, n, LL, g0w, g1w, g2w, gbs, gb);
#pragma unroll
      for (int i = 0; i < 4; ++i) {
        float sn, cs; sincospif((float)(n + i) * invL, &sn, &cs);
        const float2 bv = cmul(bx[i], make_float2(cs, sn));
        const float y0 = ((av[i].x + bv.x) * sc + xv[i].x * hbias) * ga[i];
        const float y1 = ((av[i].y + bv.y) * sc + xv[i].y * hbias) * gb[i];
        bx[i] = make_float2(y0, y1);
      }
      if (o == 0) st4c(ZBUF + n, bx);
      else st4c(X + n, bx);
    }
    __syncthreads();
  }
  {
    u16* w0 = hyt + ((size_t)0 * 1536 + c) * SS + CT;
    u16* w1 = hyt + ((size_t)1 * 1536 + c) * SS + CT;
    for (int n = opaque_tid() * 4; n < LL; n += NT * 4) {
      float2 v[4]; ld4c(X + n, v);
      u32x2 o0, o1;
      o0[0] = pack2(v[0].x, v[1].x); o0[1] = pack2(v[2].x, v[3].x);
      o1[0] = pack2(v[0].y, v[1].y); o1[1] = pack2(v[2].y, v[3].y);
      *(u32x2*)(w0 + n) = o0; *(u32x2*)(w1 + n) = o1;
    }
  }
  __syncthreads();
}

__device__ __forceinline__ void hyena_ctx_item(const Params& P, int c, unsigned char* smem) {
  const int tid = opaque_tid();
  const int b = tid >> 8, t = tid & 255;
  float* vs = (float*)smem;
  float* kf = vs + 512;
  float* kb = kf + 256;
  float* red = kb + 256;
  u16* hyt = (u16*)(P.ws + OFF_HYT);
  const float* sw = P.in[9]; const float* sb = P.in[10];
  const float* k256 = (const float*)(P.ws + OFF_KRAW256);
  float cur, x1, x2;
  {
    const u16* rv = hyt + ((size_t)b * 1536 + c) * SS;
    const u16* ra = hyt + ((size_t)b * 1536 + 512 + c) * SS;
    const u16* rb = hyt + ((size_t)b * 1536 + 1024 + c) * SS;
    cur = conv3(rv, t, CT, sw[c], sw[1536 + c], sw[3072 + c], sb[c]);
    x1 = conv3(ra, t, CT, sw[512 + c], sw[1536 + 512 + c], sw[3072 + 512 + c], sb[512 + c]);
    x2 = conv3(rb, t, CT, sw[1024 + c], sw[1536 + 1024 + c], sw[3072 + 1024 + c], sb[1024 + c]);
  }
  for (int o = 0; o < 2; ++o) {
    __syncthreads();
    float kv;
    if (b == 0) { kv = k256[(size_t)((0 * 2 + o) * 512 + c) * CT + t]; kf[t] = kv; }
    else { kv = k256[(size_t)((1 * 2 + o) * 512 + c) * CT + t]; kb[t] = kv; if (t == 0) kv = 0.f; }
    vs[b * 256 + t] = cur;
    float nrm = block_sum(fabsf(kv), red);
    float y = 0.f;
    for (int s = 0; s <= t; ++s) y += kf[t - s] * vs[b * 256 + s];
    for (int s = t + 1; s < CT; ++s) y += kb[s - t] * vs[b * 256 + s];
    y = y / nrm + cur * P.in[18][o * 512 + c];
    cur = y * (o == 0 ? x1 : x2);
  }
  __syncthreads();
  hyt[((size_t)b * 1536 + c) * SS + t] = f2bf(cur);
  __syncthreads();
}

__device__ __forceinline__ void attn_item(const Params& P, int b, int head, int qb, unsigned char* smem) {
  f32x16 O[4];
  float lrun = 0.f;
  {
  const int tid = opaque_tid(), lane = tid & 63, w = tid >> 6;
  const int r = lane & 31, h = lane >> 5;
  const int m = w & 1, wq = w >> 1;
  constexpr int KP = 72;
  unsigned char* kst = smem;
  unsigned char* vst = smem + 32768;
  u16* qs = (u16*)(smem + 65536);
  const u16* Qg = (const u16*)(P.ws + OFF_Q);
  const u16* Kg = (const u16*)(P.ws + OFF_K);
  const u16* Vg = (const u16*)(P.ws + OFF_VT);
  const int ntiles = (qb < 2) ? (CT / 64) : (SS / 64);
  const u16* K1p = Kg + ((size_t)((b * 4 + head) * 2 + 0) * SS) * 64;
  const u16* K2p = Kg + ((size_t)((b * 4 + head) * 2 + 1) * SS) * 64;
  const u16* Vp = Vg + ((size_t)(b * 4 + head) * 128) * SS;
  const int krow = tid >> 3, kkc = (tid & 7) ^ ((krow >> 1) & 7);
  unsigned koff = (unsigned)(krow * 64 + kkc * 8);
  const int e0 = tid >> 3, e1 = 64 + (tid >> 3);
  unsigned voff0 = (unsigned)(e0 * SS + ((tid & 7) ^ ((e0 >> 1) & 7)) * 8);
  unsigned voff1 = (unsigned)(e1 * SS + ((tid & 7) ^ ((e1 >> 1) & 7)) * 8);
#define GLDS16(gp, lp) __builtin_amdgcn_global_load_lds((const unsigned*)(gp), (unsigned*)(lp), 16, 0, 0)
  __syncthreads();
#pragma unroll
  for (int i = 0; i < 4; ++i) {
    int id = tid + i * NT;
    int mm = id >> 10, q = (id >> 3) & 127, ch = (id & 7) * 8;
    *(u32x4*)(qs + (mm * 128 + q) * KP + ch) = *(const u32x4*)(Qg + ((size_t)((b * 4 + head) * 2 + mm) * SS + qb * 128 + q) * 64 + ch);
  }
  GLDS16(K1p + koff, kst + tid * 16);
  GLDS16(K2p + koff, kst + 8192 + tid * 16);
  GLDS16(Vp + voff0, vst + tid * 16);
  GLDS16(Vp + voff1, vst + 8192 + tid * 16);
  if (ntiles > 1) {
    GLDS16(K1p + 64 * 64 + koff, kst + 16384 + tid * 16);
    GLDS16(K2p + 64 * 64 + koff, kst + 16384 + 8192 + tid * 16);
  }
  asm volatile("s_waitcnt vmcnt(0)" ::: "memory");
#pragma unroll
  for (int e = 0; e < 4; ++e)
#pragma unroll
    for (int j = 0; j < 16; ++j) O[e][j] = 0.f;
  float mrun;
  __syncthreads();
  const int sw = (r >> 1) & 7;
  const u16* qrow = qs + (m * 128 + wq * 32 + r) * KP + h * 8;
  f32x16 c0, c1;
  bf16x8 qf[4];
#pragma unroll
  for (int sl = 0; sl < 4; ++sl) qf[sl] = *(const bf16x8*)(qrow + sl * 16);
  {
    const unsigned char* ks_ = kst + m * 8192 + r * 128;
#pragma unroll
    for (int j = 0; j < 16; ++j) { c0[j] = 0.f; c1[j] = 0.f; }
#pragma unroll
    for (int sl = 0; sl < 4; ++sl) {
      const int o = ((sl * 2 + h) ^ sw) * 16;
      c0 = MFMA(*(const bf16x8*)(ks_ + o), qf[sl], c0);
      c1 = MFMA(*(const bf16x8*)(ks_ + 32 * 128 + o), qf[sl], c1);
    }
    float tm = fmaxf(c0[0], c1[0]);
#pragma unroll
    for (int j = 1; j < 16; ++j) tm = fmaxf(tm, fmaxf(c0[j], c1[j]));
    mrun = fmaxf(tm, __shfl_xor(tm, 32));
#pragma unroll
    for (int j = 0; j < 16; ++j) { c0[j] -= mrun; c1[j] -= mrun; }
  }
  float tmax = 0.f;
#define SB_() __builtin_amdgcn_sched_barrier(0)
  f32x16 n0, n1, ninit;
#pragma unroll
  for (int j = 0; j < 16; ++j) ninit[j] = -mrun;
  auto att_step = [&](f32x16& C0, f32x16& C1, f32x16& N0, f32x16& N1, const int kt, const int PAR) __attribute__((always_inline)) {
    const bool has1 = kt + 1 < ntiles, has2 = kt + 2 < ntiles;
    if (__any(tmax > 16.f)) {
      const float d = fmaxf(tmax, 0.f);
      const float alpha = __builtin_amdgcn_exp2f(-d);
      mrun += d;
      lrun *= alpha;
#pragma unroll
      for (int e = 0; e < 4; ++e)
#pragma unroll
        for (int j = 0; j < 16; ++j) O[e][j] *= alpha;
#pragma unroll
      for (int j = 0; j < 16; ++j) { C0[j] -= d; C1[j] -= d; ninit[j] = -mrun; }
    }
    if (has2) {
      const int k0 = (kt + 2) * 64;
      GLDS16(K1p + (size_t)k0 * 64 + koff, kst + PAR * 16384 + tid * 16);
      GLDS16(K2p + (size_t)k0 * 64 + koff, kst + PAR * 16384 + 8192 + tid * 16);
    }
    if (has1) {
      const int k0 = (kt + 1) * 64;
      GLDS16(Vp + k0 + voff0, vst + (PAR ^ 1) * 16384 + tid * 16);
      GLDS16(Vp + k0 + voff1, vst + (PAR ^ 1) * 16384 + 8192 + tid * 16);
    }
    const unsigned char* ks_ = kst + (PAR ^ 1) * 16384 + m * 8192 + r * 128;
    const unsigned char* vts = vst + PAR * 16384 + r * 128;
    bf16x8 kf[8];
#pragma unroll
    for (int sl = 0; sl < 4; ++sl) {
      const int o = ((sl * 2 + h) ^ sw) * 16;
      kf[2 * sl] = *(const bf16x8*)(ks_ + o); kf[2 * sl + 1] = *(const bf16x8*)(ks_ + 32 * 128 + o);
    }
    SB_();
    N0 = MFMA(kf[0], qf[0], ninit);
    N1 = MFMA(kf[1], qf[0], ninit);
#pragma unroll
    for (int sl = 1; sl < 4; ++sl) { N0 = MFMA(kf[2 * sl], qf[sl], N0); N1 = MFMA(kf[2 * sl + 1], qf[sl], N1); }
    float psum = 0.f;
#pragma unroll
    for (int j = 0; j < 16; ++j) { C0[j] = __builtin_amdgcn_exp2f(C0[j]); psum += C0[j]; }
    bf16x8 pf[4];
#pragma unroll
    for (int q2 = 0; q2 < 2; ++q2) {
      u32x4 pk;
      pk[0] = pack2(C0[8 * q2 + 0], C0[8 * q2 + 1]); pk[1] = pack2(C0[8 * q2 + 2], C0[8 * q2 + 3]);
      pk[2] = pack2(C0[8 * q2 + 4], C0[8 * q2 + 5]); pk[3] = pack2(C0[8 * q2 + 6], C0[8 * q2 + 7]);
      pf[q2] = __builtin_bit_cast(bf16x8, pk);
    }
    SB_();
    bf16x8 vf[8];
#pragma unroll
    for (int q2 = 0; q2 < 2; ++q2)
#pragma unroll
      for (int e = 0; e < 4; ++e) vf[q2 * 4 + e] = *(const bf16x8*)(vts + e * 4096 + (((q2 * 2 + h) ^ sw) * 16));
    SB_();
#pragma unroll
    for (int q2 = 0; q2 < 2; ++q2)
#pragma unroll
      for (int e = 0; e < 4; ++e) O[e] = MFMA(vf[q2 * 4 + e], pf[q2], O[e]);
#pragma unroll
    for (int j = 0; j < 16; ++j) { C1[j] = __builtin_amdgcn_exp2f(C1[j]); psum += C1[j]; }
    lrun += psum;
#pragma unroll
    for (int q2 = 0; q2 < 2; ++q2) {
      u32x4 pk;
      pk[0] = pack2(C1[8 * q2 + 0], C1[8 * q2 + 1]); pk[1] = pack2(C1[8 * q2 + 2], C1[8 * q2 + 3]);
      pk[2] = pack2(C1[8 * q2 + 4], C1[8 * q2 + 5]); pk[3] = pack2(C1[8 * q2 + 6], C1[8 * q2 + 7]);
      pf[2 + q2] = __builtin_bit_cast(bf16x8, pk);
    }
    SB_();
#pragma unroll
    for (int q2 = 0; q2 < 2; ++q2)
#pragma unroll
      for (int e = 0; e < 4; ++e) vf[q2 * 4 + e] = *(const bf16x8*)(vts + e * 4096 + (((4 + q2 * 2 + h) ^ sw) * 16));
    SB_();
#pragma unroll
    for (int q2 = 0; q2 < 2; ++q2)
#pragma unroll
      for (int e = 0; e < 4; ++e) O[e] = MFMA(vf[q2 * 4 + e], pf[2 + q2], O[e]);
    {
      int mi = max(__builtin_bit_cast(int, N0[0]), __builtin_bit_cast(int, N1[0]));
#pragma unroll
      for (int j = 1; j < 16; ++j) mi = max(mi, max(__builtin_bit_cast(int, N0[j]), __builtin_bit_cast(int, N1[j])));
      mi = max(mi, __shfl_xor(mi, 32));
      tmax = __builtin_bit_cast(float, mi);
    }
    SB_();
    asm volatile("s_waitcnt vmcnt(0)" ::: "memory");
    __syncthreads();
  };
  for (int kt2 = 0; kt2 < ntiles; kt2 += 2) {
    att_step(c0, c1, n0, n1, kt2, 0);
    att_step(n0, n1, c0, c1, kt2 + 1, 1);
  }
#undef SB_
#undef GLDS16
  }
  const int tid_e = opaque_tid();
  const int lane = tid_e & 63, w = tid_e >> 6, r = lane & 31, h = lane >> 5, m = w & 1, wq = w >> 1;
  const int sq = qb * 128 + wq * 32 + r;
  const float lam = ((const float*)(P.ws + OFF_CNT))[1];
  const float lt = lrun + __shfl_xor(lrun, 32);
  float* xch = (float*)smem + wq * 4096;
  if (m == 1) {
    const float i2 = lam / lt;
#pragma unroll
    for (int e = 0; e < 4; ++e)
#pragma unroll
      for (int j = 0; j < 16; ++j) xch[(e * 16 + j) * 64 + lane] = O[e][j] * i2;
  }
  __syncthreads();
  if (m == 0) {
    const float i1 = 1.f / lt;
    float ssq = 0.f;
#pragma unroll
    for (int e = 0; e < 4; ++e)
#pragma unroll
      for (int j = 0; j < 16; ++j) { float a = O[e][j] * i1 - xch[(e * 16 + j) * 64 + lane]; O[e][j] = a; ssq += a * a; }
    ssq += __shfl_xor(ssq, 32);
    const float rstd = rsqrtf(ssq * (1.f / 128.f) + EPSN) * 0.8f;
    const size_t tok = (size_t)b * SS + sq;
    const u16* agp = (const u16*)(P.ws + OFF_AG) + tok * 512 + head * 128;
    u16* mixp = (u16*)(P.ws + OFF_XN) + tok * DM + 512 + head * 128;
    const float* sw = P.in[20];
#pragma unroll
    for (int e = 0; e < 4; ++e)
#pragma unroll
      for (int g = 0; g < 4; ++g) {
        const int e0 = e * 32 + 8 * g + 4 * h;
        u32x2 ag = *(const u32x2*)(agp + e0);
        float a0 = O[e][4 * g + 0] * rstd * sw[e0 + 0] * silu_f(bf2f((u16)(ag[0] & 0xffff)));
        float a1 = O[e][4 * g + 1] * rstd * sw[e0 + 1] * silu_f(bf2f((u16)(ag[0] >> 16)));
        float a2 = O[e][4 * g + 2] * rstd * sw[e0 + 2] * silu_f(bf2f((u16)(ag[1] & 0xffff)));
        float a3 = O[e][4 * g + 3] * rstd * sw[e0 + 3] * silu_f(bf2f((u16)(ag[1] >> 16)));
        u32x2 o; o[0] = pack2(a0, a1); o[1] = pack2(a2, a3);
        *(u32x2*)(mixp + e0) = o;
      }
  }
  __syncthreads();
}

__device__ __forceinline__ void phase_mixers(const Params& P, unsigned char* smem) {
  int* cnt = (int*)(P.ws + OFF_CNT);
  __shared__ int s_item;
  const int n_attl = NB * 4 * 128, n_hyl = 512, n_attc = NB * 4 * 2, n_hyc = 512;
  const int total = n_attl + n_hyl + n_attc + n_hyc;
  for (;;) {
    __syncthreads();
    if (threadIdx.x == 0) s_item = atomicAdd(cnt, 1);
    __syncthreads();
    int it = s_item;
    if (it >= total) break;
    const bool attc = (it >= n_attl + n_hyl) && (it < n_attl + n_hyl + n_attc);
    const bool attl = (it >= n_hyl) && (it < n_attl + n_hyl);
    if (attl || attc) {
      int bh = attc ? ((it - n_attl - n_hyl) >> 1) : (it - n_hyl) / 128;
      int qb = attc ? ((it - n_attl - n_hyl) & 1) : 2 + (it - n_hyl) % 128;
      for (int rep = 0; rep < ATT_REP; ++rep) attn_item(P, bh >> 2, bh & 3, qb, smem);
    }
#ifndef NO_HYL
    else if (it < n_hyl) hyena_latent_item(P, it, smem);
#endif
#ifndef NO_HYC
    else if (it >= n_attl + n_hyl + n_attc) hyena_ctx_item(P, it - n_attl - n_hyl - n_attc, smem);
#endif
  }
}

__device__ __forceinline__ void phase_hygate(const Params& P, unsigned char* smem) {
  const int tid = opaque_tid();
  float* tile = (float*)smem;
  const u16* hyt = (const u16*)(P.ws + OFF_HYT);
  const u16* hg = (const u16*)(P.ws + OFF_HG);
  u16* mix = (u16*)(P.ws + OFF_XN);
  for (int it = blockIdx.x; it < NB * 260 * 8; it += gridDim.x) {
    int ct = it & 7, stile = (it >> 3) % 260, b = it / (8 * 260);
    __syncthreads();
    {
      int ci = tid >> 3, sg = (tid & 7) * 8;
      u32x4 v = *(const u32x4*)(hyt + ((size_t)b * 1536 + ct * 64 + ci) * SS + stile * 64 + sg);
#pragma unroll
      for (int i = 0; i < 4; ++i) { tile[ci * 65 + sg + 2 * i] = bf2f((u16)(v[i] & 0xffff)); tile[ci * 65 + sg + 2 * i + 1] = bf2f((u16)(v[i] >> 16)); }
    }
    __syncthreads();
    {
      int si = tid >> 3, cg8 = (tid & 7) * 8;
      size_t tok = (size_t)b * SS + stile * 64 + si;
      u32x4 g = *(const u32x4*)(hg + tok * 512 + ct * 64 + cg8);
      u32x4 o;
#pragma unroll
      for (int i = 0; i < 4; ++i) {
        float a0 = tile[(cg8 + 2 * i) * 65 + si] * silu_f(bf2f((u16)(g[i] & 0xffff)));
        float a1 = tile[(cg8 + 2 * i + 1) * 65 + si] * silu_f(bf2f((u16)(g[i] >> 16)));
        o[i] = pack2(a0, a1);
      }
      *(u32x4*)(mix + tok * DM + ct * 64 + cg8) = o;
    }
  }
}

__device__ __forceinline__ void phase_conv(const Params& P, bool do_store) {
  const int tid = opaque_tid();
  u16* xbc = (u16*)(P.ws + OFF_XBC);
  const u16* halo = (const u16*)(P.ws + OFF_HALO);
  const float* cw = P.in[22]; const float* cb = P.in[23];
  for (int it = blockIdx.x; it < 260 * 16; it += gridDim.x) {
    const int tile = it >> 4, chunk = it & 15;
    const int sub = tid >> 5, cg8 = tid & 31;
    const int ch = chunk * 256 + cg8 * 8;
    const int row0 = tile * 128 + sub * 8;
    const int s_first = (tile * 128) % SS;
    u32x4 rows[10];
    u32 zz = 0; asm volatile("" : "+v"(zz));
    __syncthreads();
#pragma unroll
    for (int i = 0; i < 10; ++i) {
      int row = row0 - 1 + i;
      u32x4 v = {zz, zz, zz, zz};
      if (row < tile * 128) {
        if (!(s_first == 0 || s_first == CT)) v = *(const u32x4*)(halo + ((size_t)(tile - 1) * 2 + 1) * 4096 + ch);
      } else if (row >= tile * 128 + 128) {
        int s_last = s_first + 127;
        if (!(s_last == CT - 1 || s_last == SS - 1)) v = *(const u32x4*)(halo + ((size_t)(tile + 1) * 2 + 0) * 4096 + ch);
      } else v = *(const u32x4*)(xbc + (size_t)row * 4096 + ch);
      rows[i] = v;
    }
    __syncthreads();
    float w0[8], w1[8], w2[8], bb[8];
#pragma unroll
    for (int e = 0; e < 8; ++e) { w0[e] = cw[ch + e]; w1[e] = cw[4096 + ch + e]; w2[e] = cw[8192 + ch + e]; bb[e] = cb[ch + e]; }
#pragma unroll
    for (int i = 0; i < 8; ++i) {
      u32x4 o;
#pragma unroll
      for (int e2 = 0; e2 < 4; ++e2) {
        float r[2];
#pragma unroll
        for (int p = 0; p < 2; ++p) {
          int e = e2 * 2 + p;
          u32 a = rows[i][e2], bq = rows[i + 1][e2], cq = rows[i + 2][e2];
          float xa = p ? bf2f((u16)(a >> 16)) : bf2f((u16)(a & 0xffff));
          float xb = p ? bf2f((u16)(bq >> 16)) : bf2f((u16)(bq & 0xffff));
          float xc = p ? bf2f((u16)(cq >> 16)) : bf2f((u16)(cq & 0xffff));
          r[p] = silu_f(w0[e] * xa + w1[e] * xb + w2[e] * xc + bb[e]);
        }
        o[e2] = pack2(r[0], r[1]);
      }
      if (do_store) *(u32x4*)(xbc + (size_t)(row0 + i) * 4096 + ch) = o;
    }
  }
}

__device__ __forceinline__ void wave_scan4(float a[4], float& total) {
  a[1] += a[0]; a[2] += a[1]; a[3] += a[2];
  float t = a[3];
  const int lane = threadIdx.x & 63;
#pragma unroll
  for (int o = 1; o < 64; o <<= 1) { float u = __shfl_up(t, o); if (lane >= o) t += u; }
  float excl = t - a[3];
  a[0] += excl; a[1] += excl; a[2] += excl; a[3] += excl;
  total = __shfl(t, 63);
}

constexpr int XP = 136;

__device__ __forceinline__ void stage_xt(const u16* __restrict__ xbc, size_t tok0, int g, u16* XT) {
  const int tid_ = opaque_tid(); const int lane = tid_ & 63, w = tid_ >> 6;
  const int tg = w & 1, hh = w >> 1;
  const int s = tg * 64 + lane;
  const u16* src = xbc + (tok0 + s) * 4096 + g * 256 + hh * 64;
#pragma unroll
  for (int it = 0; it < 8; ++it) {
    u32x4 v = *(const u32x4*)(src + it * 8);
#pragma unroll
    for (int i = 0; i < 4; ++i) {
      XT[(hh * 64 + it * 8 + 2 * i) * XP + s] = (u16)(v[i] & 0xffff);
      XT[(hh * 64 + it * 8 + 2 * i + 1) * XP + s] = (u16)(v[i] >> 16);
    }
  }
}
__device__ __forceinline__ void stage_rows(const u16* __restrict__ xbc, size_t tok0, int coloff, u16* R) {
  const int tid = opaque_tid();
#pragma unroll
  for (int i = 0; i < 4; ++i) {
    int id = tid + i * NT;
    int s = id >> 4, c8 = (id & 15) * 8;
    *(u32x4*)(R + s * XP + c8) = *(const u32x4*)(xbc + (tok0 + s) * 4096 + coloff + c8);
  }
}

__device__ __forceinline__ void phase_ssd1(const Params& P, unsigned char* smem) {
  const int tid = opaque_tid(), lane = tid & 63, w = tid >> 6;
  const int r = lane & 31, h = lane >> 5;
  u16* XT = (u16*)smem;
  u16* BT = XT + 256 * XP;
  float* wgt = (float*)(BT + 128 * XP);
  const u16* xbc = (const u16*)(P.ws + OFF_XBC);
  const float* dt = (const float*)(P.ws + OFF_DT);
  float* dec = (float*)(P.ws + OFF_DEC);
  const int dir = w >> 2, hh = w & 3;
  for (int it = blockIdx.x; it < NB * 65 * 8; it += gridDim.x) {
    const int g = it & 7, c = (it >> 3) % 65, b = it / (8 * 65);
    const int head = g * 4 + hh;
    const size_t tok0 = (size_t)b * SS + (size_t)c * 256;
    const float Ah = -expf(P.in[25][dir * 32 + head]);
    __syncthreads();
    {
      float a[4], d4[4], tot;
#pragma unroll
      for (int i = 0; i < 4; ++i) { d4[i] = dt[(tok0 + lane * 4 + i) * 64 + dir * 32 + head]; a[i] = d4[i] * Ah; }
      float a_raw[4] = {a[0], a[1], a[2], a[3]};
      wave_scan4(a, tot);
#pragma unroll
      for (int i = 0; i < 4; ++i) {
        float te = (dir == 0) ? __expf(tot - a[i]) : __expf(a[i] - a_raw[i]);
        wgt[w * 256 + lane * 4 + i] = d4[i] * te;
      }
      if (lane == 0) dec[((dir * 2 + b) * 65 + c) * 32 + head] = __expf(tot);
    }
    f32x16 acc[2][4];
#pragma unroll
    for (int i = 0; i < 2; ++i)
#pragma unroll
      for (int j = 0; j < 4; ++j)
#pragma unroll
        for (int e = 0; e < 16; ++e) acc[i][j][e] = 0.f;
    for (int half = 0; half < 2; ++half) {
      __syncthreads();
      stage_xt(xbc, tok0 + half * 128, g, XT);
      {
        const int tg = w & 1, nq = w >> 1;
        const int s = tg * 64 + lane;
        const u16* src = xbc + (tok0 + half * 128 + s) * 4096 + 2048 + g * 128 + nq * 32;
#pragma unroll
        for (int i4 = 0; i4 < 4; ++i4) {
          u32x4 v = *(const u32x4*)(src + i4 * 8);
#pragma unroll
          for (int i = 0; i < 4; ++i) {
            BT[(nq * 32 + i4 * 8 + 2 * i) * XP + s] = (u16)(v[i] & 0xffff);
            BT[(nq * 32 + i4 * 8 + 2 * i + 1) * XP + s] = (u16)(v[i] >> 16);
          }
        }
      }
      __syncthreads();
#pragma unroll 2
      for (int sl = 0; sl < 8; ++sl) {
        const float* wp = wgt + w * 256 + half * 128 + sl * 16 + h * 8;
        float wv[8];
#pragma unroll
        for (int j = 0; j < 8; ++j) wv[j] = wp[j];
        bf16x8 af[2];
#pragma unroll
        for (int pt = 0; pt < 2; ++pt) {
          u32x4 xv = *(const u32x4*)(XT + (hh * 64 + pt * 32 + r) * XP + sl * 16 + h * 8);
          u32x4 sv;
#pragma unroll
          for (int i = 0; i < 4; ++i)
            sv[i] = pack2(bf2f((u16)(xv[i] & 0xffff)) * wv[2 * i], bf2f((u16)(xv[i] >> 16)) * wv[2 * i + 1]);
          af[pt] = __builtin_bit_cast(bf16x8, sv);
        }
#pragma unroll
        for (int nt = 0; nt < 4; ++nt) {
          bf16x8 bfr = *(const bf16x8*)(BT + (nt * 32 + r) * XP + sl * 16 + h * 8);
#pragma unroll
          for (int pt = 0; pt < 2; ++pt) acc[pt][nt] = MFMA(af[pt], bfr, acc[pt][nt]);
        }
      }
    }
    u16* G = (c == 0) ? ((u16*)(P.ws + OFF_GCTX) + (size_t)((dir * 2 + b) * 32 + head) * 8192)
                      : ((u16*)P.out + ((size_t)((dir * 2 + b) * 64 + (c - 1)) * 32 + head) * 8192);
#pragma unroll
    for (int pt = 0; pt < 2; ++pt)
#pragma unroll
      for (int nt = 0; nt < 4; ++nt)
#pragma unroll
        for (int j = 0; j < 16; ++j) {
          int p = pt * 32 + (j & 3) + 8 * (j >> 2) + 4 * h;
          G[p * 128 + nt * 32 + r] = f2bf(acc[pt][nt][j]);
        }
  }
}

__device__ __forceinline__ void phase_scan(const Params& P, bool do_store) {
  const float* dec = (const float*)(P.ws + OFF_DEC);
  const u16* gctx = (const u16*)(P.ws + OFF_GCTX);
  u16* st = (u16*)P.out;
  for (int v = blockIdx.x * NT + opaque_tid(); v < 131072; v += gridDim.x * NT) {
    const int pn8 = v & 1023, hd = (v >> 10) & 31, db = v >> 15;
    const int dir = db >> 1;
    float S[8];
    {
      u32x4 gv = *(const u32x4*)(gctx + ((size_t)db * 32 + hd) * 8192 + pn8 * 8);
#pragma unroll
      for (int i = 0; i < 4; ++i) { S[2 * i] = bf2f((u16)(gv[i] & 0xffff)); S[2 * i + 1] = bf2f((u16)(gv[i] >> 16)); }
    }
    u16* base = st + ((size_t)db * 64 * 32 + hd) * 8192 + pn8 * 8;
    const float* dbase = dec + (db * 65 + 1) * 32 + hd;
    for (int k0 = 0; k0 < 64; k0 += 8) {
      u32x4 gv[8]; float dd[8];
#pragma unroll
      for (int u = 0; u < 8; ++u) {
        const int ci = (dir == 0) ? (k0 + u) : 63 - (k0 + u);
        gv[u] = *(const u32x4*)(base + (size_t)ci * 32 * 8192);
        dd[u] = dbase[ci * 32];
      }
#pragma unroll
      for (int u = 0; u < 8; ++u) {
        const int ci = (dir == 0) ? (k0 + u) : 63 - (k0 + u);
        u32x4 sv;
#pragma unroll
        for (int i = 0; i < 4; ++i) sv[i] = pack2(S[2 * i], S[2 * i + 1]);
        if (do_store) *(u32x4*)(base + (size_t)ci * 32 * 8192) = sv;
#pragma unroll
        for (int i = 0; i < 4; ++i) {
          S[2 * i] = dd[u] * S[2 * i] + bf2f((u16)(gv[u][i] & 0xffff));
          S[2 * i + 1] = dd[u] * S[2 * i + 1] + bf2f((u16)(gv[u][i] >> 16));
        }
      }
    }
  }
}

__device__ __forceinline__ void phase_ssd3(const Params& P, unsigned char* smem, bool do_store) {
  const int tid = opaque_tid(), lane = tid & 63, w = tid >> 6;
  const int r = lane & 31, h = lane >> 5;
  u16* CS = (u16*)smem;
  u16* BS = CS + 128 * XP;
  u16* XT = BS + 128 * XP;
  float* cum = (float*)(XT + 256 * XP);
  float* dtl = cum + 8 * 256;
  float* red = (float*)BS;
  const u16* xbc = (const u16*)(P.ws + OFF_XBC);
  const float* dt = (const float*)(P.ws + OFF_DT);
  const u16* states = (const u16*)P.out;
  u16* zb = (u16*)(P.ws + OFF_ZB);
  const int hh = w & 3, lh = w >> 2;
  for (int it = blockIdx.x; it < NB * 128 * 8; it += gridDim.x) {
    const int g = it & 7, rblk = (it >> 3) & 127, b = it >> 10;
    const int c = rblk >> 1, rb = rblk & 1;
    const size_t tokc = (size_t)b * SS + CT + (size_t)c * 256;
    const int head = g * 4 + hh;
    __syncthreads();
    {
      const int dir = w >> 2;
      const int hd = g * 4 + (w & 3);
      const float Ah = -expf(P.in[25][dir * 32 + hd]);
      float a[4], d4[4], tot;
#pragma unroll
      for (int i = 0; i < 4; ++i) { d4[i] = dt[(tokc + lane * 4 + i) * 64 + dir * 32 + hd]; a[i] = d4[i] * Ah; }
      float a_raw[4] = {a[0], a[1], a[2], a[3]};
      wave_scan4(a, tot);
#pragma unroll
      for (int i = 0; i < 4; ++i) {
        cum[w * 256 + lane * 4 + i] = (dir == 0) ? a[i] : (tot - a[i] + a_raw[i]);
        dtl[w * 256 + lane * 4 + i] = d4[i];
      }
    }
    stage_rows(xbc, tokc + rb * 128, 3072 + g * 128, CS);
    __syncthreads();
    f32x16 acc[2][2];
#pragma unroll
    for (int i = 0; i < 2; ++i)
#pragma unroll
      for (int j = 0; j < 2; ++j)
#pragma unroll
        for (int e = 0; e < 16; ++e) acc[i][j][e] = 0.f;
#pragma unroll 1
    for (int dir = 0; dir < 2; ++dir) {
      const u16* Sp = states + (((size_t)(dir * 2 + b) * 64 + c) * 32 + head) * 8192;
      f32x16 tmp[2][2];
#pragma unroll
      for (int i = 0; i < 2; ++i)
#pragma unroll
        for (int j = 0; j < 2; ++j)
#pragma unroll
          for (int e = 0; e < 16; ++e) tmp[i][j][e] = 0.f;
#pragma unroll
      for (int sb4 = 0; sb4 < 2; ++sb4) {
        bf16x8 sf[4][2];
#pragma unroll
        for (int s4 = 0; s4 < 4; ++s4)
#pragma unroll
          for (int pt = 0; pt < 2; ++pt) sf[s4][pt] = *(const bf16x8*)(Sp + (pt * 32 + r) * 128 + (sb4 * 4 + s4) * 16 + h * 8);
        __builtin_amdgcn_sched_barrier(0);
#pragma unroll
        for (int s4 = 0; s4 < 4; ++s4) {
          bf16x8 cf[2];
#pragma unroll
          for (int li = 0; li < 2; ++li) cf[li] = *(const bf16x8*)(CS + ((lh * 2 + li) * 32 + r) * XP + (sb4 * 4 + s4) * 16 + h * 8);
#pragma unroll
          for (int pt = 0; pt < 2; ++pt)
#pragma unroll
            for (int li = 0; li < 2; ++li) tmp[pt][li] = MFMA(sf[s4][pt], cf[li], tmp[pt][li]);
        }
      }
#pragma unroll
      for (int li = 0; li < 2; ++li) {
        const float sc = __expf(cum[(dir * 4 + hh) * 256 + rb * 128 + (lh * 2 + li) * 32 + r]);
#pragma unroll
        for (int pt = 0; pt < 2; ++pt)
#pragma unroll
          for (int e = 0; e < 16; ++e) acc[pt][li][e] += tmp[pt][li][e] * sc;
      }
    }
#pragma unroll 1
    for (int sb = 0; sb < 2; ++sb) {
      __syncthreads();
      stage_rows(xbc, tokc + sb * 128, 2048 + g * 128, BS);
      stage_xt(xbc, tokc + sb * 128, g, XT);
      __syncthreads();
#pragma unroll 1
      for (int st = 0; st < 4; ++st) {
#pragma unroll
        for (int li = 0; li < 2; ++li) {
          const int lt = lh * 2 + li;
          const bool needf = (sb < rb) || (sb == rb && st <= lt);
          const bool needb = (sb > rb) || (sb == rb && st >= lt);
          if (!needf && !needb) continue;
          f32x16 cbt;
#pragma unroll
          for (int e = 0; e < 16; ++e) cbt[e] = 0.f;
#pragma unroll
          for (int sl = 0; sl < 8; ++sl) {
            bf16x8 bfr = *(const bf16x8*)(BS + (st * 32 + r) * XP + sl * 16 + h * 8);
            bf16x8 cfr = *(const bf16x8*)(CS + (lt * 32 + r) * XP + sl * 16 + h * 8);
            cbt = MFMA(bfr, cfr, cbt);
          }
          const int lidx = rb * 128 + lt * 32 + r;
#pragma unroll 1
          for (int dir = 0; dir < 2; ++dir) {
            if (dir == 0 ? !needf : !needb) continue;
            const float* cu = cum + (dir * 4 + hh) * 256;
            const float* dl = dtl + (dir * 4 + hh) * 256;
            const float cl = cu[lidx];
            float mv[16];
#pragma unroll
            for (int j = 0; j < 16; ++j) {
              const int sidx = sb * 128 + st * 32 + (j & 3) + 8 * (j >> 2) + 4 * h;
              const bool valid = (dir == 0) ? (sidx <= lidx) : (sidx >= lidx);
              const float e = __expf(fminf(cl - cu[sidx], 0.f));
              mv[j] = valid ? cbt[j] * e * dl[sidx] : 0.f;
            }
#pragma unroll
            for (int q2 = 0; q2 < 2; ++q2) {
              u32x4 pk;
#pragma unroll
              for (int i = 0; i < 4; ++i) pk[i] = pack2(mv[8 * q2 + 2 * i], mv[8 * q2 + 2 * i + 1]);
              bf16x8 mf = __builtin_bit_cast(bf16x8, pk);
              const int kb = st * 32 + q2 * 16 + 4 * h;
#pragma unroll
              for (int pt = 0; pt < 2; ++pt) {
                u32x2 lo = *(const u32x2*)(XT + (hh * 64 + pt * 32 + r) * XP + kb);
                u32x2 hi = *(const u32x2*)(XT + (hh * 64 + pt * 32 + r) * XP + kb + 8);
                u32x4 vv; vv[0] = lo[0]; vv[1] = lo[1]; vv[2] = hi[0]; vv[3] = hi[1];
                acc[pt][li] = MFMA(__builtin_bit_cast(bf16x8, vv), mf, acc[pt][li]);
              }
            }
          }
        }
      }
    }
    __syncthreads();
    const float Dsum = P.in[26][head] + P.in[26][32 + head];
    float ssq[2] = {0.f, 0.f};
#pragma unroll
    for (int li = 0; li < 2; ++li) {
      const int l = rb * 128 + (lh * 2 + li) * 32 + r;
      const size_t tok = tokc + l;
      const size_t zrow = ((size_t)b * LL + (size_t)c * 256 + l) * 2048 + head * 64;
#pragma unroll
      for (int pt = 0; pt < 2; ++pt)
#pragma unroll
        for (int gq = 0; gq < 4; ++gq) {
          const int p0 = pt * 32 + 8 * gq + 4 * h;
          u32x2 xv = *(const u32x2*)(xbc + tok * 4096 + head * 64 + p0);
          u32x2 zv = *(const u32x2*)(zb + zrow + p0);
          float xs[4] = {bf2f((u16)(xv[0] & 0xffff)), bf2f((u16)(xv[0] >> 16)), bf2f((u16)(xv[1] & 0xffff)), bf2f((u16)(xv[1] >> 16))};
          float zs[4] = {bf2f((u16)(zv[0] & 0xffff)), bf2f((u16)(zv[0] >> 16)), bf2f((u16)(zv[1] & 0xffff)), bf2f((u16)(zv[1] >> 16))};
#pragma unroll
          for (int i = 0; i < 4; ++i) {
            float y = (acc[pt][li][4 * gq + i] + Dsum * xs[i]) * silu_f(zs[i]);
            acc[pt][li][4 * gq + i] = y;
            ssq[li] += y * y;
          }
        }
      ssq[li] += __shfl_xor(ssq[li], 32);
      if (h == 0) red[hh * 128 + (lh * 2 + li) * 32 + r] = ssq[li];
    }
    __syncthreads();
    const float* gw = P.in[27];
#pragma unroll
    for (int li = 0; li < 2; ++li) {
      const int ll = (lh * 2 + li) * 32 + r;
      const float tot = red[ll] + red[128 + ll] + red[256 + ll] + red[384 + ll];
      const float rstd = rsqrtf(tot * (1.f / 256.f) + EPSN);
      const int l = rb * 128 + ll;
      const size_t zrow = ((size_t)b * LL + (size_t)c * 256 + l) * 2048 + head * 64;
#pragma unroll
      for (int pt = 0; pt < 2; ++pt)
#pragma unroll
        for (int gq = 0; gq < 4; ++gq) {
          const int p0 = pt * 32 + 8 * gq + 4 * h;
          const float* gp = gw + head * 64 + p0;
          u32x2 o;
          o[0] = pack2(acc[pt][li][4 * gq + 0] * rstd * gp[0], acc[pt][li][4 * gq + 1] * rstd * gp[1]);
          o[1] = pack2(acc[pt][li][4 * gq + 2] * rstd * gp[2], acc[pt][li][4 * gq + 3] * rstd * gp[3]);
          if (do_store) *(u32x2*)(zb + zrow + p0) = o;
        }
    }
  }
}

__device__ __forceinline__ void phase_final(const Params& P) {
  const int tid_ = opaque_tid(); const int lane = tid_ & 63, wv = tid_ >> 6;
  const float* nw = P.in[29];
  for (int it = blockIdx.x; it < NB * LL / 8; it += gridDim.x) {
    float* row = P.out + (size_t)(it * 8 + wv) * DM;
    float4 v[4];
    float ss = 0.f;
#pragma unroll
    for (int i = 0; i < 4; ++i) {
      v[i] = *(const float4*)(row + i * 256 + lane * 4);
      ss += v[i].x * v[i].x + v[i].y * v[i].y + v[i].z * v[i].z + v[i].w * v[i].w;
    }
    ss = wave_sum(ss);
    float rstd = rsqrtf(ss * (1.f / DM) + EPSN);
#pragma unroll
    for (int i = 0; i < 4; ++i) {
      float4 w = *(const float4*)(nw + i * 256 + lane * 4);
      float4 o = make_float4(v[i].x * rstd * w.x, v[i].y * rstd * w.y, v[i].z * rstd * w.z, v[i].w * rstd * w.w);
      *(float4*)(row + i * 256 + lane * 4) = o;
    }
  }
}


#define XB_TMO      128
#define XB_XCNT(j)  (256  + 64 * (j))
#define XB_XSUB(j)  (1280 + 64 * (j))
#define XB_XGEN(j)  (2304 + 64 * (j))
#define XB_TOP      3328
#define XB_TOPGEN   3392
#define XCD_BAR_WORDS 3456
#define XB_SPIN_CAP (1u << 18)
#define LAS __attribute__((address_space(3)))
__device__ __forceinline__ unsigned xb_ld(unsigned* p)              { return __hip_atomic_load(p, __ATOMIC_RELAXED, __HIP_MEMORY_SCOPE_AGENT); }
__device__ __forceinline__ unsigned xb_add(unsigned* p, unsigned v) { return __hip_atomic_fetch_add(p, v, __ATOMIC_RELAXED, __HIP_MEMORY_SCOPE_AGENT); }
__device__ __forceinline__ unsigned xb_xcc_id() { return (unsigned)__builtin_amdgcn_s_getreg((3 << 11) | 20) & 0xFu; }
#define XB_SPIN(cond, bar) do { unsigned _sp = 0; while (cond) { __builtin_amdgcn_s_sleep(1); \
    if ((++_sp & 255u) == 0u) { if (xb_ld(&(bar)[XB_TMO])) break; if (_sp > XB_SPIN_CAP) { atomicAdd(&(bar)[XB_TMO], 1u); break; } } } } while (0)
struct XcdBarrier { unsigned* bar; unsigned x; volatile LAS unsigned* st; };
__device__ __forceinline__ XcdBarrier xcd_barrier_post(unsigned* bar, volatile LAS unsigned* st) {
  XcdBarrier b; b.bar = bar; b.x = xb_xcc_id(); b.st = st;
  if (threadIdx.x == 0) (void)xb_add(&bar[XB_XCNT(b.x)], 1u);
  return b;
}
__device__ __forceinline__ void xcd_barrier_complete(unsigned* bar, unsigned x, unsigned& nloc, unsigned& nx) {
  const unsigned G = gridDim.x * gridDim.y * gridDim.z;
  unsigned sum, cnt, mine, sp = 0u;
  for (;;) {
    sum = 0u; cnt = 0u; mine = 0u;
#pragma unroll
    for (unsigned j = 0; j < 16; ++j) { const unsigned c = xb_ld(&bar[XB_XCNT(j)]); sum += c; cnt += (c > 0u) ? 1u : 0u; mine = (j == x) ? c : mine; }
    if (sum == G) break;
    __builtin_amdgcn_s_sleep(1);
    if ((++sp & 255u) == 0u) { if (xb_ld(&bar[XB_TMO])) break; if (sp > XB_SPIN_CAP) { atomicAdd(&bar[XB_TMO], 1u); break; } }
  }
  nloc = mine > 0u ? mine : 1u; nx = cnt > 0u ? cnt : 1u;
}
__device__ __forceinline__ void xcd_barrier(const XcdBarrier& b) {
  asm volatile("s_waitcnt vmcnt(0)" ::: "memory");
  __syncthreads();
  if (threadIdx.x == 0) {
    unsigned* bar = b.bar;
    __builtin_amdgcn_s_waitcnt(0);
    unsigned nloc = b.st[0], nx = b.st[1];
    if (nloc == 0u) { xcd_barrier_complete(bar, b.x, nloc, nx); b.st[0] = nloc; b.st[1] = nx; }
    const unsigned old = xb_add(&bar[XB_XSUB(b.x)], 1u);
    const unsigned gen = old / nloc;
    if (old + 1u == (gen + 1u) * nloc) {
      __builtin_amdgcn_fence(__ATOMIC_RELEASE, "agent");
      asm volatile("s_waitcnt vmcnt(0)" ::: "memory");
      const unsigned og = xb_add(&bar[XB_TOP], 1u);
      const unsigned tg = og / nx;
      if (og + 1u == (tg + 1u) * nx) xb_add(&bar[XB_TOPGEN], 1u);
      else XB_SPIN(xb_ld(&bar[XB_TOPGEN]) == tg, bar);
      __builtin_amdgcn_fence(__ATOMIC_ACQUIRE, "agent");
      xb_add(&bar[XB_XGEN(b.x)], 1u);
      asm volatile("s_waitcnt vmcnt(0)" ::: "memory");
    } else {
      XB_SPIN(xb_ld(&bar[XB_XGEN(b.x)]) == gen, bar);
      __builtin_amdgcn_fence(__ATOMIC_ACQUIRE, "agent");
      asm volatile("s_waitcnt vmcnt(0)" ::: "memory");
    }
  }
  __syncthreads();
}

__global__ void __launch_bounds__(NT) fwd_kernel(Params P) {
  extern __shared__ __attribute__((aligned(16))) unsigned char smem[];
  __shared__ uint4 xb_words;
  if (threadIdx.x == 0) xb_words = make_uint4(0u, 0u, 0u, 0u);
  __syncthreads();
  XcdBarrier xb = xcd_barrier_post((unsigned*)(P.ws + OFF_BAR), (volatile LAS unsigned*)&xb_words);
  for (int ph = P.ph_lo; ph < P.ph_hi; ++ph) {
    switch (ph) {
#if !defined(PHASE_ONLY) || PHASE_ONLY == 0
      case 0: for (int rep = 0; rep < MISC_REP; ++rep) phase_prep(P, smem); break;
#endif
#if !defined(PHASE_ONLY) || PHASE_ONLY == 1
      case 1: for (int rep = 0; rep < MISC_REP; ++rep) { phase_norm(P, 0, (u16*)(P.ws + OFF_XN)); phase_filter(P, smem); } break;
#endif
#if !defined(PHASE_ONLY) || PHASE_ONLY == 2
      case 2: for (int rep = 0; rep < GEMM_REP; ++rep) gemm_phase<0>(P, (const u16*)(P.ws + OFF_XN), DM, (const u16*)(P.ws + OFF_WEIN), DM, DM, NTOK / 256, 16, smem); break;
#endif
#if !defined(PHASE_ONLY) || PHASE_ONLY == 3
      case 3: phase_mixers(P, smem); break;
#endif
#if !defined(PHASE_ONLY) || PHASE_ONLY == 4
      case 4: phase_hygate(P, smem); break;
#endif
#if !defined(PHASE_ONLY) || PHASE_ONLY == 5
      case 5: for (int rep = 0; rep < GEMM_REP; ++rep) gemm_phase<1>(P, (const u16*)(P.ws + OFF_XN), DM, (const u16*)(P.ws + OFF_WEOUT), DM, DM, NTOK / 256, 4, smem); break;
#endif
#if !defined(PHASE_ONLY) || PHASE_ONLY == 6
      case 6: phase_norm(P, 1, (u16*)P.out); break;
#endif
#if !defined(PHASE_ONLY) || PHASE_ONLY == 7
      case 7: for (int rep = 0; rep < GEMM_REP; ++rep) gemm_phase<2>(P, (const u16*)P.out, DM, (const u16*)(P.ws + OFF_WOIN), DM, DM, NTOK / 256, 25, smem); break;
#endif
#if !defined(PHASE_ONLY) || PHASE_ONLY == 8
      case 8: for (int rep = 0; rep < TAIL_REP; ++rep) phase_conv(P, rep == TAIL_REP - 1); break;
#endif
#if !defined(PHASE_ONLY) || PHASE_ONLY == 9
      case 9: for (int rep = 0; rep < SSD1_REP; ++rep) phase_ssd1(P, smem); break;
#endif
#if !defined(PHASE_ONLY) || PHASE_ONLY == 10
      case 10: for (int rep = 0; rep < TAIL_REP; ++rep) phase_scan(P, rep == TAIL_REP - 1); break;
#endif
#if !defined(PHASE_ONLY) || PHASE_ONLY == 11
      case 11: for (int rep = 0; rep < TAIL_REP; ++rep) phase_ssd3(P, smem, rep == TAIL_REP - 1); break;
#endif
#if !defined(PHASE_ONLY) || PHASE_ONLY == 12
      case 12: for (int rep = 0; rep < GEMM_REP; ++rep) gemm_phase<3>(P, (const u16*)(P.ws + OFF_ZB), 2048, (const u16*)(P.ws + OFF_WOOUT), 2048, 2048, NB * LL / 256, 4, smem); break;
#endif
#if !defined(PHASE_ONLY) || PHASE_ONLY == 13
      case 13: phase_final(P); break;
#endif
    }
    if (ph + 1 < P.ph_hi) {
      if (P.ph_lo < 0) cg::this_grid().sync();
      xcd_barrier(xb);
    }
  }
}

extern "C" void kernel_launch(void* const* d_in, const int* in_sizes, int n_in, void* d_out, int out_size,
                              void* d_ws, size_t ws_size, hipStream_t stream) {
  static int grid = 0;
  if (grid == 0) {
    if (n_in != 30 || ws_size < OFF_END) { fprintf(stderr, "kernel_launch: unexpected n_in %d / ws %zu\n", n_in, ws_size); grid = -1; return; }
    int dev = 0, cus = 0, per_cu = 0;
    hipGetDevice(&dev);
    hipDeviceGetAttribute(&cus, hipDeviceAttributeMultiprocessorCount, dev);
    if (hipFuncSetAttribute((const void*)fwd_kernel, hipFuncAttributeMaxDynamicSharedMemorySize, LDS_BYTES) != hipSuccess) {
      fprintf(stderr, "kernel_launch: hipFuncSetAttribute failed\n"); grid = -1; return; }
    hipOccupancyMaxActiveBlocksPerMultiprocessor(&per_cu, (const void*)fwd_kernel, NT, LDS_BYTES);
    if (per_cu < 1) { fprintf(stderr, "kernel_launch: occupancy query says %d\n", per_cu); per_cu = 1; }
    (void)hipGetLastError();
    grid = cus * 1;
  }
  if (grid < 0) return;
  Params p{};
  for (int i = 0; i < 30; ++i) p.in[i] = (const float*)d_in[i];
  p.out = (float*)d_out;
  p.ws = (unsigned char*)d_ws;
#if ONE_LAUNCH
  (void)hipMemsetAsync((unsigned char*)d_ws + OFF_BAR, 0, XCD_BAR_WORDS * 4, stream);
  p.ph_lo = 0; p.ph_hi = NPH;
  void* args[] = {&p};
  hipError_t e = hipLaunchCooperativeKernel((const void*)fwd_kernel, dim3(grid), dim3(NT), args, LDS_BYTES, stream);
  if (e != hipSuccess) fprintf(stderr, "cooperative launch failed: %s (grid %d)\n", hipGetErrorString(e), grid);
#else
  for (int ph = 0; ph < NPH; ++ph) {
    p.ph_lo = ph; p.ph_hi = ph + 1;
    hipLaunchKernelGGL(fwd_kernel, dim3(grid), dim3(NT), LDS_BYTES, stream, p);
  }
#endif
}
```
